# Optimizing an MI355X kernel written in HIP

```python
import jax, jax.numpy as jnp
from jax import lax
import numpy as np

D_MODEL = 1024
BATCH = 2
SEQ = 8192
DEPTH = 2
DEC_BATCH = 16
DEC_SEQ = 32
PAST_LEN = 2048

CHUNK = 64
NORM_EPS = 1e-6

SSD_EXPAND = 2
SSD_D_INNER = SSD_EXPAND * D_MODEL
SSD_HEAD_DIM = 64
SSD_N_HEADS = SSD_D_INNER // SSD_HEAD_DIM
SSD_N_GROUPS = 4
SSD_HEADS_PER_GROUP = SSD_N_HEADS // SSD_N_GROUPS
SSD_D_STATE = 128
SSD_CONV_W = 4
SSD_CONV_DIM = SSD_D_INNER + 2 * SSD_N_GROUPS * SSD_D_STATE
SSD_IN_DIM = SSD_D_INNER + SSD_CONV_DIM + SSD_N_HEADS
SSD_NORM_GROUP = SSD_D_INNER // SSD_N_GROUPS
SSD_DT_MIN = 1e-3
SSD_DT_MAX = 1e-1

HGRN_DIM = D_MODEL
HGRN_HEAD_DIM = 128
HGRN_N_HEADS = HGRN_DIM // HGRN_HEAD_DIM

FFN_HIDDEN = -(-(8 * D_MODEL) // (3 * 256)) * 256

N_SSD_LAYERS = (DEPTH + 1) // 2
N_HGRN_LAYERS = DEPTH // 2

kernel_name = "hybrid_ssd_hgrn2_streaming_step"


def rmsnorm(x, w):
    xf = x.astype(jnp.float32)
    y = xf * lax.rsqrt(jnp.mean(xf * xf, axis=-1, keepdims=True) + NORM_EPS)
    return (y * w.astype(jnp.float32)).astype(x.dtype)


def _chunkify(a, n_chunks):
    pad = n_chunks * CHUNK - a.shape[1]
    a = jnp.pad(a, [(0, 0), (0, pad)] + [(0, 0)] * (a.ndim - 2))
    a = a.reshape((a.shape[0], n_chunks, CHUNK) + a.shape[2:])
    return jnp.moveaxis(a, 1, 0)


def _unchunkify(a, length):
    a = jnp.moveaxis(a, 0, 1)
    a = a.reshape((a.shape[0], -1) + a.shape[3:])
    return a[:, :length]


def ssd_scan(x, dt, A, Bm, Cm, S0):
    Bsz, L = x.shape[0], x.shape[1]
    G, Hg, P, N = SSD_N_GROUPS, SSD_HEADS_PER_GROUP, SSD_HEAD_DIM, SSD_D_STATE
    n = -(-L // CHUNK)
    xs = _chunkify(x.reshape(Bsz, L, G, Hg, P), n)
    dts = _chunkify(dt.reshape(Bsz, L, G, Hg), n)
    Bs = _chunkify(Bm, n)
    Cs = _chunkify(Cm, n)
    Ag = A.reshape(G, Hg)
    mask = jnp.tril(jnp.ones((CHUNK, CHUNK), dtype=bool))[None, :, :, None, None]

    def step(S, inp):
        xc, dtc, Bc, Cc = inp
        cum = jnp.cumsum(dtc * Ag, axis=1)
        seg = cum[:, :, None] - cum[:, None, :]
        decay = jnp.where(mask, jnp.exp(jnp.where(mask, seg, 0.0)), 0.0)
        xdt = xc * dtc[..., None]
        cb = jnp.einsum('btgn,bsgn->btsg', Cc, Bc)
        y = jnp.einsum('btsg,btsgh,bsghp->btghp', cb, decay, xdt)
        y = y + jnp.einsum('btgn,bghpn->btghp', Cc, S) * jnp.exp(cum)[..., None]
        last = cum[:, -1]
        w_end = jnp.exp(last[:, None] - cum)
        S = jnp.exp(last)[..., None, None] * S + jnp.einsum('bsgh,bsghp,bsgn->bghpn', w_end, xdt, Bc)
        return S, y

    S, ys = lax.scan(step, S0.reshape(Bsz, G, Hg, P, N), (xs, dts, Bs, Cs))
    y = _unchunkify(ys, L).reshape(Bsz, L, G * Hg, P)
    return y, S.reshape(Bsz, G * Hg, P, N)


def gla_scan(q, k, v, logg, S0):
    L = q.shape[1]
    n = -(-L // CHUNK)
    qs, ks, vs, gs = (_chunkify(a, n) for a in (q, k, v, logg))
    mask = jnp.tril(jnp.ones((CHUNK, CHUNK), dtype=bool))[None, None]

    def step(S, inp):
        qc, kc, vc, gc = inp
        b = jnp.cumsum(gc, axis=1)
        qe = qc * jnp.exp(b)
        ke = kc * jnp.exp(-b)
        sc = jnp.where(mask, jnp.einsum('bthk,bshk->bhts', qe, ke), 0.0)
        o = jnp.einsum('bhts,bshv->bthv', sc, vc) + jnp.einsum('bthk,bhkv->bthv', qe, S)
        last = b[:, -1]
        S = jnp.exp(last)[..., None] * S + jnp.einsum('bshk,bshv->bhkv', kc * jnp.exp(last[:, None] - b), vc)
        return S, o

    S, os_ = lax.scan(step, S0, (qs, ks, vs, gs))
    return _unchunkify(os_, L), S


def ssd_mixer(h, conv_buf, ssm_state, in_w, conv_w, conv_b, dt_bias, A_log, D_skip, gnorm_w, out_w):
    Bsz, L, _ = h.shape
    proj = h @ in_w
    z = proj[..., :SSD_D_INNER]
    xbc = proj[..., SSD_D_INNER:SSD_D_INNER + SSD_CONV_DIM]
    dt_raw = proj[..., SSD_D_INNER + SSD_CONV_DIM:]
    xpad = jnp.concatenate([conv_buf.astype(xbc.dtype), xbc], axis=1)
    new_conv = xpad[:, -(SSD_CONV_W - 1):]
    acc = conv_b.astype(jnp.float32)
    for tap in range(SSD_CONV_W):
        acc = acc + xpad[:, tap:tap + L].astype(jnp.float32) * conv_w[tap].astype(jnp.float32)
    xbc = jax.nn.silu(acc)
    xs = xbc[..., :SSD_D_INNER].reshape(Bsz, L, SSD_N_HEADS, SSD_HEAD_DIM)
    Bm = xbc[..., SSD_D_INNER:SSD_D_INNER + SSD_N_GROUPS * SSD_D_STATE].reshape(Bsz, L, SSD_N_GROUPS, SSD_D_STATE)
    Cm = xbc[..., SSD_D_INNER + SSD_N_GROUPS * SSD_D_STATE:].reshape(Bsz, L, SSD_N_GROUPS, SSD_D_STATE)
    dt = jax.nn.softplus(dt_raw.astype(jnp.float32) + dt_bias.astype(jnp.float32))
    A = -jnp.exp(A_log.astype(jnp.float32))
    y, S = ssd_scan(xs, dt, A, Bm, Cm, ssm_state.astype(jnp.float32))
    y = y + D_skip.astype(jnp.float32)[:, None] * xs
    yg = y.reshape(Bsz, L, SSD_D_INNER) * jax.nn.silu(z.astype(jnp.float32))
    yg = yg.reshape(Bsz, L, SSD_N_GROUPS, SSD_NORM_GROUP)
    yg = yg * lax.rsqrt(jnp.mean(yg * yg, axis=-1, keepdims=True) + NORM_EPS)
    yg = yg.reshape(Bsz, L, SSD_D_INNER) * gnorm_w.astype(jnp.float32)
    out = yg.astype(h.dtype) @ out_w
    return out, new_conv, S


def hgrn_mixer(h, state, lower_bound, in_w, gnorm_w, out_w):
    Bsz, L, _ = h.shape
    proj = h @ in_w
    q, f, i, g = jnp.split(proj.astype(jnp.float32), 4, axis=-1)
    heads = (Bsz, L, HGRN_N_HEADS, HGRN_HEAD_DIM)
    q = jax.nn.silu(q).reshape(heads)
    lb = lower_bound.astype(jnp.float32).reshape(HGRN_N_HEADS, HGRN_HEAD_DIM)
    forget = lb + (1.0 - lb) * jax.nn.sigmoid(f.reshape(heads))
    k = 1.0 - forget
    logg = jnp.log(forget)
    o, S = gla_scan(q, k, i.reshape(heads), logg, state.astype(jnp.float32))
    o = o * lax.rsqrt(jnp.mean(o * o, axis=-1, keepdims=True) + NORM_EPS) * gnorm_w.astype(jnp.float32)
    o = o.reshape(Bsz, L, HGRN_DIM) * jax.nn.silu(g)
    out = o.astype(h.dtype) @ out_w
    return out, S


def swiglu(h, w_gate, w_up, w_down):
    return (jax.nn.silu(h @ w_gate) * (h @ w_up)) @ w_down


def setup_inputs(seed: int = 0) -> dict:
    key = jax.random.key(seed)
    ks = jax.random.split(key, 24)
    f32 = jnp.float32

    def nrm(k, shape, scale):
        return jax.random.normal(k, shape, f32) * scale

    u = jax.random.uniform(ks[8], (N_SSD_LAYERS, SSD_N_HEADS), f32)
    dt0 = jnp.exp(u * (np.log(SSD_DT_MAX) - np.log(SSD_DT_MIN)) + np.log(SSD_DT_MIN))
    dt_bias = dt0 + jnp.log(-jnp.expm1(-dt0))
    A_log = jnp.log(jax.random.uniform(ks[9], (N_SSD_LAYERS, SSD_N_HEADS), f32, 1.0, 16.0))
    return {
        "x_prompt": nrm(ks[0], (BATCH, SEQ, D_MODEL), 1.0),
        "x_sample": nrm(ks[1], (DEC_BATCH, DEC_SEQ, D_MODEL), 1.0),
        "state_ssd": nrm(ks[2], (N_SSD_LAYERS, DEC_BATCH, SSD_N_HEADS, SSD_HEAD_DIM, SSD_D_STATE), 0.5),
        "cache_conv": nrm(ks[3], (N_SSD_LAYERS, DEC_BATCH, SSD_CONV_W - 1, SSD_CONV_DIM), 1.0),
        "state_hgrn": nrm(ks[4], (N_HGRN_LAYERS, DEC_BATCH, HGRN_N_HEADS, HGRN_HEAD_DIM, HGRN_HEAD_DIM), 0.5),
        "ssd_norm_w": 1.0 + nrm(ks[5], (N_SSD_LAYERS, D_MODEL), 0.02),
        "ssd_in_w": nrm(ks[6], (N_SSD_LAYERS, D_MODEL, SSD_IN_DIM), D_MODEL ** -0.5),
        "ssd_conv_w": nrm(ks[7], (N_SSD_LAYERS, SSD_CONV_W, SSD_CONV_DIM), SSD_CONV_W ** -0.5),
        "ssd_conv_b": nrm(ks[10], (N_SSD_LAYERS, SSD_CONV_DIM), 0.02),
        "ssd_dt_bias": dt_bias,
        "ssd_A_log": A_log,
        "ssd_D": 1.0 + nrm(ks[11], (N_SSD_LAYERS, SSD_N_HEADS), 0.1),
        "ssd_gnorm_w": 1.0 + nrm(ks[12], (N_SSD_LAYERS, SSD_D_INNER), 0.02),
        "ssd_out_w": nrm(ks[13], (N_SSD_LAYERS, SSD_D_INNER, D_MODEL), SSD_D_INNER ** -0.5),
        "hgrn_norm_w": 1.0 + nrm(ks[14], (N_HGRN_LAYERS, D_MODEL), 0.02),
        "hgrn_in_w": nrm(ks[15], (N_HGRN_LAYERS, D_MODEL, 4 * HGRN_DIM), D_MODEL ** -0.5),
        "hgrn_lower_bounds": nrm(ks[16], (DEPTH, HGRN_DIM), 0.1),
        "hgrn_gnorm_w": 1.0 + nrm(ks[17], (N_HGRN_LAYERS, HGRN_HEAD_DIM), 0.02),
        "hgrn_out_w": nrm(ks[18], (N_HGRN_LAYERS, HGRN_DIM, D_MODEL), HGRN_DIM ** -0.5),
        "ffn_norm_w": 1.0 + nrm(ks[19], (DEPTH, D_MODEL), 0.02),
        "ffn_w_gate": nrm(ks[20], (DEPTH, D_MODEL, FFN_HIDDEN), D_MODEL ** -0.5),
        "ffn_w_up": nrm(ks[21], (DEPTH, D_MODEL, FFN_HIDDEN), D_MODEL ** -0.5),
        "ffn_w_down": nrm(ks[22], (DEPTH, FFN_HIDDEN, D_MODEL), FFN_HIDDEN ** -0.5),
        "final_norm_w": 1.0 + nrm(ks[23], (D_MODEL,), 0.02),
    }


def reference(x_prompt, x_sample, state_ssd, cache_conv, state_hgrn,
              ssd_norm_w, ssd_in_w, ssd_conv_w, ssd_conv_b, ssd_dt_bias, ssd_A_log, ssd_D,
              ssd_gnorm_w, ssd_out_w, hgrn_norm_w, hgrn_in_w, hgrn_lower_bounds, hgrn_gnorm_w,
              hgrn_out_w, ffn_norm_w, ffn_w_gate, ffn_w_up, ffn_w_down, final_norm_w):
    lb_soft = jax.nn.softmax(hgrn_lower_bounds.astype(jnp.float32), axis=0)
    lbs = jnp.cumsum(lb_soft, axis=0) - lb_soft[0]

    def trunk(x, ssd_states, conv_bufs, hgrn_states):
        new_ssd, new_conv, new_hgrn = [], [], []
        for layer in range(DEPTH):
            j = layer // 2
            h = rmsnorm(x, ssd_norm_w[j] if layer % 2 == 0 else hgrn_norm_w[j])
            if layer % 2 == 0:
                out, cb, ss = ssd_mixer(h, conv_bufs[j], ssd_states[j], ssd_in_w[j], ssd_conv_w[j],
                                        ssd_conv_b[j], ssd_dt_bias[j], ssd_A_log[j], ssd_D[j],
                                        ssd_gnorm_w[j], ssd_out_w[j])
                new_conv.append(cb)
                new_ssd.append(ss)
            else:
                out, hs = hgrn_mixer(h, hgrn_states[j], lbs[layer], hgrn_in_w[j], hgrn_gnorm_w[j], hgrn_out_w[j])
                new_hgrn.append(hs)
            x = x + out.astype(x.dtype)
            x = x + swiglu(rmsnorm(x, ffn_norm_w[layer]), ffn_w_gate[layer], ffn_w_up[layer], ffn_w_down[layer])
        y = rmsnorm(x, final_norm_w)
        return y, jnp.stack(new_ssd), jnp.stack(new_conv), jnp.stack(new_hgrn)

    bp = x_prompt.shape[0]
    zero_ssd = jnp.zeros((N_SSD_LAYERS, bp, SSD_N_HEADS, SSD_HEAD_DIM, SSD_D_STATE), jnp.float32)
    zero_conv = jnp.zeros((N_SSD_LAYERS, bp, SSD_CONV_W - 1, SSD_CONV_DIM), x_prompt.dtype)
    zero_hgrn = jnp.zeros((N_HGRN_LAYERS, bp, HGRN_N_HEADS, HGRN_HEAD_DIM, HGRN_HEAD_DIM), jnp.float32)
    y_prompt, ssd_p, conv_p, hgrn_p = trunk(x_prompt, zero_ssd, zero_conv, zero_hgrn)
    y_sample, ssd_s, conv_s, hgrn_s = trunk(x_sample, state_ssd, cache_conv, state_hgrn)
    return (y_prompt, y_sample, ssd_p, conv_p, hgrn_p, ssd_s, conv_s, hgrn_s)
```

```cpp
#include <hip/hip_runtime.h>
#include <hip/hip_cooperative_groups.h>
#include <cstdio>
#include <cstdint>
namespace cg = cooperative_groups;
namespace pg8 {
#define PG8_LAS __attribute__((address_space(3)))
typedef unsigned short bf16_t;
typedef short bf16x8 __attribute__((ext_vector_type(8)));
typedef float f32x4 __attribute__((ext_vector_type(4)));
typedef unsigned u32x4 __attribute__((ext_vector_type(4)));
constexpr int BM = 256, BK = 64, HALF = 128, HTB = HALF * BK * 2  , STAGE_BYTES = 8 * HTB, NXCD = 8, WGM = 8;

__host__ __device__ __forceinline__ int lds_byte(int r, int c) { const int st = (r >> 4) * 2 + (c >> 5), rr = r & 15, cc = c & 31, ob = rr * 64 + cc * 2; return st * 1024 + (ob ^ (((ob >> 9) & 1) << 5)); }
__host__ __device__ __forceinline__ void stage_rc(int b, int& R, int& C) { const int st = b / 1024, sb = b % 1024, swz = sb ^ (((sb >> 9) & 1) << 5); R = (st >> 1) * 16 + swz / 64; C = (st & 1) * 32 + (swz % 64) / 2; }
__host__ __device__ __forceinline__ int perm32(int rho) { const int n = rho >> 4, i = rho & 15; return 8 * (i >> 2) + 4 * n + (i & 3); }

struct Unit { int pm, pn; };
struct Gemm { const bf16_t* A; const bf16_t* Bt; int M, N, K; };

struct StaticOrder {
    int nM, nN, nwg, G, c;
    __host__ __device__ void init(int M, int N, int G_, int c_) { nM = M / BM; nN = N / BM; nwg = nM * nN; G = G_; c = c_; }
    __host__ __device__ bool next(int i, Unit& u) const {
        const long L = (long)i * G + c; if (L >= nwg) return false;
        int wgid = (int)L; { const int q = nwg / NXCD, r = nwg % NXCD, xcd = wgid % NXCD, off = wgid / NXCD; wgid = (xcd < r ? xcd * (q + 1) : r * (q + 1) + (xcd - r) * q) + off; }
        const int nig = WGM * nN, gid = wgid / nig, fm = gid * WGM, gsz = (nM - fm) < WGM ? (nM - fm) : WGM;
        u.pm = fm + ((wgid % nig) % gsz); u.pn = (wgid % nig) / gsz; return true;
    }
    __device__ __forceinline__ void a_ready(const Unit&) const {}
    __device__ __forceinline__ void done(const Unit&) const {}
};
__device__ __forceinline__ unsigned cvt_pk_bf16(float lo, float hi) { unsigned r; asm volatile("v_cvt_pk_bf16_f32 %0, %1, %2" : "=v"(r) : "v"(lo), "v"(hi)); return r; }
typedef float f32x2 __attribute__((ext_vector_type(2)));
template <class Epi, class Sched, bool ALIGN_EPI = false, bool SP2 = false>
__device__ __forceinline__ void gemm_phase(PG8_LAS unsigned char* lds, const Gemm g, const Sched& S, const Epi& E) {
    const int tid = threadIdx.x, wid = __builtin_amdgcn_readfirstlane(tid >> 6), lane = tid & 63, wr = wid >> 2, wc = wid & 3, fr = lane & 15, fq = lane >> 4;
    const int K = g.K, nt = K / BK;
    unsigned voffA[2], voffB[2];
#pragma unroll
    for (int i = 0; i < 2; ++i) { int R, C; stage_rc(tid * 16 + i * 8192, R, C); const int Rb = Epi::PERM ? ((R & ~31) + perm32(R & 31)) : R;
        voffA[i] = (unsigned)(R * K + C) * 2u; voffB[i] = (unsigned)(Rb * K + C) * 2u; }
    const size_t kstep = (size_t)(BK * 2);
    const size_t hstep = (size_t)HALF * K * 2;
    const size_t tstep = 2 * hstep;
    const unsigned ldsw = (unsigned)wid * 1024u;
    const int aoff = lds_byte(wr * 64 + fr, fq * 8), boff = lds_byte(wc * 32 + fr, fq * 8);
#define PG8_SA(b, h) (((b) * 2 + (h)) * HTB)
#define PG8_SB(b, h) ((4 + (b) * 2 + (h)) * HTB)
#define PG8_STAGE(bufoff, gbase, voff) do { _Pragma("unroll") for (int _i = 0; _i < 2; ++_i) \
        __builtin_amdgcn_global_load_lds((const unsigned*)((const char*)(gbase) + (voff)[_i]), (PG8_LAS unsigned*)(lds + (bufoff) + ldsw + _i * 8192), 16, 0, 0); } while (0)
#define PG8_LDA(dst, b, h) do { _Pragma("unroll") for (int m = 0; m < 4; ++m) _Pragma("unroll") for (int k = 0; k < 2; ++k) dst[m][k] = *(const PG8_LAS bf16x8*)(lds + PG8_SA(b, h) + aoff + m * 2048 + k * 1024); } while (0)
#define PG8_LDB(dst, b, h) do { _Pragma("unroll") for (int n = 0; n < 2; ++n) _Pragma("unroll") for (int k = 0; k < 2; ++k) dst[n][k] = *(const PG8_LAS bf16x8*)(lds + PG8_SB(b, h) + boff + n * 2048 + k * 1024); } while (0)
#define PG8_MMA(ai, bj, At, Bt) do { __builtin_amdgcn_s_setprio(1); _Pragma("unroll") for (int m = 0; m < 4; ++m) _Pragma("unroll") for (int n = 0; n < 2; ++n) _Pragma("unroll") for (int k = 0; k < 2; ++k) \
        acc[ai][bj][m][n] = __builtin_amdgcn_mfma_f32_16x16x32_bf16(Bt[n][k], At[m][k], acc[ai][bj][m][n], 0, 0, 0); __builtin_amdgcn_s_setprio(0); } while (0)
#define PG8_WAIT_V(n) asm volatile("s_waitcnt vmcnt(" #n ")" ::: "memory")
#define PG8_WAIT_L(n) asm volatile("s_waitcnt lgkmcnt(" #n ")" ::: "memory")
#define PG8_BAR __builtin_amdgcn_s_barrier()
#define PG8_SCHED __builtin_amdgcn_sched_barrier(0)
    Unit cur, nxt; int ui = 0;
    if (!S.next(0, cur)) return;
    f32x4 acc[2][2][4][2];
#pragma unroll
    for (int a = 0; a < 2; ++a)
#pragma unroll
        for (int b = 0; b < 2; ++b)
#pragma unroll
            for (int m = 0; m < 4; ++m)
#pragma unroll
                for (int n = 0; n < 2; ++n) acc[a][b][m][n] = (f32x4){0.f, 0.f, 0.f, 0.f};
    bf16x8 At[4][2], B0[2][2], B1[2][2];
    const char* cA = (const char*)g.A + (size_t)cur.pm * tstep; const char* cB = (const char*)g.Bt + (size_t)cur.pn * tstep;
    S.a_ready(cur);
    if constexpr (SP2) {
        PG8_STAGE(PG8_SB(0, 0), cB, voffB); PG8_STAGE(PG8_SB(0, 1), cB + hstep, voffB); PG8_STAGE(PG8_SA(0, 0), cA, voffA); PG8_STAGE(PG8_SA(0, 1), cA + hstep, voffA);
        if (wr == 1) PG8_BAR;
        PG8_WAIT_V(2); PG8_BAR;
        PG8_STAGE(PG8_SB(1, 0), cB + kstep, voffB); PG8_STAGE(PG8_SA(1, 0), cA + kstep, voffA); PG8_STAGE(PG8_SB(1, 1), cB + hstep + kstep, voffB);
        PG8_WAIT_V(6); PG8_BAR;
    } else {
        PG8_STAGE(PG8_SB(0, 0), cB, voffB); PG8_STAGE(PG8_SA(0, 0), cA, voffA); PG8_STAGE(PG8_SB(0, 1), cB + hstep, voffB); PG8_STAGE(PG8_SA(0, 1), cA + hstep, voffA);
        if (wr == 1) PG8_BAR;
        PG8_WAIT_V(4); PG8_BAR;
        PG8_STAGE(PG8_SB(1, 0), cB + kstep, voffB); PG8_STAGE(PG8_SA(1, 0), cA + kstep, voffA); PG8_STAGE(PG8_SB(1, 1), cB + hstep + kstep, voffB);
        PG8_WAIT_V(6); PG8_BAR;
    }
    for (;;) {
        const bool has_next = S.next(ui + 1, nxt);
        const char* nA = has_next ? (const char*)g.A + (size_t)nxt.pm * tstep : cA; const char* nB = has_next ? (const char*)g.Bt + (size_t)nxt.pn * tstep : cB;
        for (int t = 0; t < nt; t += 2) {
            const bool last = (t == nt - 2);
            const char* a1 = cA + (size_t)(t + 1) * kstep;
            const char* a2 = last ? nA : cA + (size_t)(t + 2) * kstep; const char* b2 = last ? nB : cB + (size_t)(t + 2) * kstep;
            const char* a3 = a2 + kstep; const char* b3 = b2 + kstep;
            if (last && has_next) S.a_ready(nxt);
            if constexpr (SP2) {
            PG8_LDB(B0, 0, 0); PG8_LDB(B1, 0, 1); PG8_SCHED; PG8_LDA(At, 0, 0); PG8_STAGE(PG8_SA(1, 1), a1 + hstep, voffA);
            PG8_WAIT_V(8); PG8_WAIT_L(0); PG8_BAR; PG8_MMA(0, 0, At, B0); PG8_MMA(0, 1, At, B1); PG8_BAR; PG8_SCHED;
            PG8_LDA(At, 0, 1); PG8_STAGE(PG8_SB(0, 0), b2, voffB); PG8_STAGE(PG8_SB(0, 1), b2 + hstep, voffB); PG8_STAGE(PG8_SA(0, 0), a2, voffA);
            PG8_WAIT_V(8); PG8_WAIT_L(0); PG8_BAR; PG8_MMA(1, 0, At, B0); PG8_MMA(1, 1, At, B1); PG8_BAR; PG8_SCHED;
            PG8_LDB(B0, 1, 0); PG8_LDB(B1, 1, 1); PG8_SCHED; PG8_LDA(At, 1, 0); PG8_STAGE(PG8_SA(0, 1), a2 + hstep, voffA);
            PG8_WAIT_V(8); PG8_WAIT_L(0); PG8_BAR; PG8_MMA(0, 0, At, B0); PG8_MMA(0, 1, At, B1); PG8_BAR; PG8_SCHED;
            PG8_LDA(At, 1, 1); PG8_STAGE(PG8_SB(1, 0), b3, voffB); PG8_STAGE(PG8_SB(1, 1), b3 + hstep, voffB); PG8_STAGE(PG8_SA(1, 0), a3, voffA);
            PG8_WAIT_V(8); PG8_WAIT_L(0); PG8_BAR; PG8_MMA(1, 0, At, B0); PG8_MMA(1, 1, At, B1); PG8_BAR; PG8_SCHED;
            } else {
            PG8_LDB(B0, 0, 0); PG8_SCHED; PG8_LDA(At, 0, 0); PG8_STAGE(PG8_SA(1, 1), a1 + hstep, voffA);
            PG8_WAIT_L(8); PG8_BAR; PG8_WAIT_L(0); PG8_MMA(0, 0, At, B0); PG8_BAR; PG8_SCHED;
            PG8_LDB(B1, 0, 1); PG8_STAGE(PG8_SB(0, 0), b2, voffB);
            PG8_BAR; PG8_WAIT_L(0); PG8_MMA(0, 1, At, B1); PG8_BAR;
            PG8_LDA(At, 0, 1); PG8_STAGE(PG8_SA(0, 0), a2, voffA);
            PG8_BAR; PG8_WAIT_L(0); PG8_MMA(1, 0, At, B0); PG8_BAR; PG8_SCHED;
            PG8_STAGE(PG8_SB(0, 1), b2 + hstep, voffB);
            PG8_WAIT_V(6); PG8_BAR; PG8_MMA(1, 1, At, B1); PG8_BAR;
            PG8_LDB(B0, 1, 0); PG8_SCHED; PG8_LDA(At, 1, 0); PG8_STAGE(PG8_SA(0, 1), a2 + hstep, voffA);
            PG8_WAIT_L(8); PG8_BAR; PG8_WAIT_L(0); PG8_MMA(0, 0, At, B0); PG8_BAR; PG8_SCHED;
            PG8_LDB(B1, 1, 1); PG8_STAGE(PG8_SB(1, 0), b3, voffB);
            PG8_BAR; PG8_WAIT_L(0); PG8_MMA(0, 1, At, B1); PG8_BAR;
            PG8_LDA(At, 1, 1); PG8_STAGE(PG8_SA(1, 0), a3, voffA);
            PG8_BAR; PG8_WAIT_L(0); PG8_MMA(1, 0, At, B0); PG8_BAR; PG8_SCHED;
            PG8_STAGE(PG8_SB(1, 1), b3 + hstep, voffB);
            PG8_WAIT_V(6); PG8_BAR; PG8_MMA(1, 1, At, B1); PG8_BAR;
            }
        }
        if constexpr (ALIGN_EPI) { if (wr == 0) PG8_BAR; }
        if constexpr (!Epi::AFTER_DRAIN) { E(acc, cur, wr, wc, fr, fq); S.done(cur); }
        if (!has_next) break;
#pragma unroll
        for (int a = 0; a < 2; ++a)
#pragma unroll
            for (int b = 0; b < 2; ++b)
#pragma unroll
                for (int m = 0; m < 4; ++m)
#pragma unroll
                    for (int n = 0; n < 2; ++n) acc[a][b][m][n] = (f32x4){0.f, 0.f, 0.f, 0.f};
        cur = nxt; cA = nA; cB = nB; ++ui;
        if constexpr (ALIGN_EPI) { if (wr == 1) PG8_BAR; }
    }
    PG8_WAIT_V(0);
    if constexpr (!ALIGN_EPI) { if (wr == 0) PG8_BAR; }
    PG8_BAR;
    if constexpr (Epi::AFTER_DRAIN) { E.fused(acc, cur, wr, wc, fr, fq, lds, wid, lane); S.done(cur); }
#undef PG8_SA
#undef PG8_SB
#undef PG8_STAGE
#undef PG8_LDA
#undef PG8_LDB
#undef PG8_MMA
#undef PG8_WAIT_V
#undef PG8_WAIT_L
#undef PG8_BAR
#undef PG8_SCHED
}
}
#define DI __device__ __forceinline__
#define LAS __attribute__((address_space(3)))
typedef unsigned short bf16_t;
typedef short bf16x8 __attribute__((ext_vector_type(8)));
typedef float f32x4 __attribute__((ext_vector_type(4)));
typedef float f32x16 __attribute__((ext_vector_type(16)));
typedef unsigned u32x4 __attribute__((ext_vector_type(4)));
typedef unsigned u32x2 __attribute__((ext_vector_type(2)));
typedef __bf16 bf16v2 __attribute__((ext_vector_type(2)));
#define MFMA32(a, b, c) __builtin_amdgcn_mfma_f32_32x32x16_bf16((a), (b), (c), 0, 0, 0)

constexpr int MP = 16384, MS = 512, M = MP + MS;
constexpr int NIN0 = 5376, FF = 2816, NGU = 5632, NIN1 = 4096;
constexpr float EPS = 1e-6f;
constexpr int NPH = 16;
constexpr int LDS_BYTES = 155648;

constexpr size_t WS_WIN0 = 0;
constexpr size_t WS_WOUT0 = WS_WIN0 + (size_t)NIN0 * 1024 * 2;
constexpr size_t WS_WGU0 = WS_WOUT0 + (size_t)1024 * 2048 * 2;
constexpr size_t WS_WDN0 = WS_WGU0 + (size_t)NGU * 1024 * 2;
constexpr size_t WS_WIN1 = WS_WDN0 + (size_t)1024 * FF * 2;
constexpr size_t WS_WOUT1 = WS_WIN1 + (size_t)NIN1 * 1024 * 2;
constexpr size_t WS_WGU1 = WS_WOUT1 + (size_t)1024 * 1024 * 2;
constexpr size_t WS_WDN1 = WS_WGU1 + (size_t)NGU * 1024 * 2;
constexpr size_t WS_SSQ = WS_WDN1 + (size_t)1024 * FF * 2;
constexpr size_t WS_DTRAW = WS_SSQ + (size_t)5 * M * 4;
constexpr size_t WS_CDEC = WS_DTRAW + (size_t)M * 32 * 4;
constexpr size_t WS_BIG = WS_CDEC + (size_t)65536 * 4;
constexpr size_t BIG_XBC = (size_t)M * 2048 * 2;
constexpr size_t BIG_XB = (size_t)M * 1024 * 2 * 4;
constexpr size_t WS_BAR = WS_BIG + (size_t)M * 5120 * 2;
constexpr size_t WS_END = WS_BAR + 65536;
constexpr int LDS_MISC = LDS_BYTES - 64;
constexpr size_t O_Y = 0, O_SSDP = (size_t)M * 1024, O_CONVP = O_SSDP + 524288, O_HGP = O_CONVP + 18432, O_SSDS = O_HGP + 262144,
                 O_CONVS = O_SSDS + 4194304, O_HGS = O_CONVS + 147456;

struct Args { const float* in[24]; float* out; unsigned char* ws; int ph_lo, ph_hi; };

DI unsigned pk2(float lo, float hi) { bf16v2 v; v[0] = (__bf16)lo; v[1] = (__bf16)hi; return __builtin_bit_cast(unsigned, v); }
DI float bflo(unsigned u) { return __uint_as_float(u << 16); }
DI float bfhi(unsigned u) { return __uint_as_float(u & 0xffff0000u); }
DI float siluf(float x) { return x * __builtin_amdgcn_rcpf(1.f + __builtin_amdgcn_exp2f(-1.4426950408889634f * x)); }
DI float sigm(float x) { return __builtin_amdgcn_rcpf(1.f + __builtin_amdgcn_exp2f(-1.4426950408889634f * x)); }
DI int crow(int i, int h) { return (i & 3) + 8 * (i >> 2) + 4 * h; }
DI bf16x8 pack8(const f32x16& x, int s) { u32x4 p; p[0] = pk2(x[8 * s], x[8 * s + 1]); p[1] = pk2(x[8 * s + 2], x[8 * s + 3]); p[2] = pk2(x[8 * s + 4], x[8 * s + 5]); p[3] = pk2(x[8 * s + 6], x[8 * s + 7]); return __builtin_bit_cast(bf16x8, p); }
DI void unpack8(const bf16x8& b, f32x16& x, int s) { u32x4 p = __builtin_bit_cast(u32x4, b);
#pragma unroll
    for (int w = 0; w < 4; ++w) { x[8 * s + 2 * w] = bflo(p[w]); x[8 * s + 2 * w + 1] = bfhi(p[w]); } }
DI bf16x8 lds_b128(LAS unsigned char* p) { return *(LAS bf16x8*)p; }
DI bf16x8 lds_2b64(LAS unsigned char* p) { u32x2 a = *(LAS u32x2*)p, b = *(LAS u32x2*)(p + 16); u32x4 r; r[0] = a[0]; r[1] = a[1]; r[2] = b[0]; r[3] = b[1]; return __builtin_bit_cast(bf16x8, r); }
DI f32x16 zero16() { f32x16 z;
#pragma unroll
    for (int i = 0; i < 16; ++i) z[i] = 0.f;
    return z; }
DI float wave_sum(float v) {
#pragma unroll
    for (int o = 1; o < 64; o <<= 1) v += __shfl_xor(v, o);
    return v; }

struct TItem { const float* W; bf16_t* WT; const float* scale; int ld, K, mode, k0, n0; };
constexpr int TI_IN0 = 16 * 161, TI_OUT0 = 32 * 32, TI_G = 16 * 88, TI_DN = 44 * 32, TI_IN1 = 16 * 128, TI_OUT1 = 16 * 32;
constexpr int TI_SET1 = TI_IN0, TI_SET2A = TI_SET1 + TI_OUT0 + 2 * TI_G + TI_DN, TI_SET2 = TI_SET2A + TI_IN1, TI_ALL = TI_SET2 + TI_OUT1 + 2 * TI_G + TI_DN;
static_assert(TI_SET1 % 4 == 0 && TI_SET2A % 4 == 0 && TI_SET2 % 4 == 0 && TI_ALL % 4 == 0, "items go four per trip");
DI TItem p0_decode(const Args& a, int it) {
    unsigned char* ws = a.ws; TItem t; int r = it, nblk;
    if (r < TI_IN0) { t.W = a.in[6]; t.ld = 5152; t.K = 1024; t.WT = (bf16_t*)(ws + WS_WIN0); t.mode = 0; t.scale = a.in[5]; nblk = 161; }
    else { r -= TI_IN0; int layer = 0;
        if (r >= TI_OUT0 + 2 * TI_G + TI_DN) { r -= TI_OUT0 + 2 * TI_G + TI_DN;
            if (r < TI_IN1) { t.W = a.in[15]; t.ld = 4096; t.K = 1024; t.WT = (bf16_t*)(ws + WS_WIN1); t.mode = 0; t.scale = a.in[14]; nblk = 128; layer = -1; }
            else { r -= TI_IN1; layer = 1; } }
        if (layer >= 0) { const size_t woff = (size_t)layer * 1024 * FF; const int i_out = layer ? TI_OUT1 : TI_OUT0;
            if (r < i_out) { t.W = layer ? a.in[18] : a.in[13]; t.ld = 1024; t.K = layer ? 1024 : 2048; t.WT = (bf16_t*)(ws + (layer ? WS_WOUT1 : WS_WOUT0)); t.mode = 0; t.scale = nullptr; nblk = 32; }
            else if ((r -= i_out) < TI_G) { t.W = a.in[20] + woff; t.ld = FF; t.K = 1024; t.WT = (bf16_t*)(ws + (layer ? WS_WGU1 : WS_WGU0)); t.mode = 1; t.scale = a.in[19] + layer * 1024; nblk = 88; }
            else if ((r -= TI_G) < TI_G) { t.W = a.in[21] + woff; t.ld = FF; t.K = 1024; t.WT = (bf16_t*)(ws + (layer ? WS_WGU1 : WS_WGU0)); t.mode = 2; t.scale = a.in[19] + layer * 1024; nblk = 88; }
            else { r -= TI_G; t.W = a.in[22] + woff; t.ld = 1024; t.K = FF; t.WT = (bf16_t*)(ws + (layer ? WS_WDN1 : WS_WDN0)); t.mode = 0; t.scale = nullptr; nblk = 32; } } }
    t.k0 = 64 * (r / nblk); t.n0 = 32 * (r % nblk); return t;
}
DI void p0_load(const TItem& t, float (&v)[32], int lane) {
#pragma unroll
    for (int i = 0; i < 32; ++i) { const int kk = 2 * i + (lane >> 5); v[i] = t.W[(size_t)(t.k0 + kk) * t.ld + t.n0 + (lane & 31)]; }
    if (t.scale) {
#pragma unroll
        for (int i = 0; i < 32; ++i) v[i] *= t.scale[t.k0 + 2 * i + (lane >> 5)]; }
}
DI void p0_store(const TItem& t, const float (&v)[32], LAS float* scr, int lane) {
#pragma unroll
    for (int i = 0; i < 32; ++i) scr[(2 * i + (lane >> 5)) * 33 + (lane & 31)] = v[i];
    asm volatile("s_waitcnt lgkmcnt(0)" ::: "memory");
    const int c = lane & 7;
#pragma unroll
    for (int j = 0; j < 4; ++j) { const int n = (lane >> 3) + 8 * j; const LAS float* s = scr + (8 * c) * 33 + n;
        u32x4 o; o[0] = pk2(s[0 * 33], s[1 * 33]); o[1] = pk2(s[2 * 33], s[3 * 33]); o[2] = pk2(s[4 * 33], s[5 * 33]); o[3] = pk2(s[6 * 33], s[7 * 33]);
        const int nn = t.n0 + n; const int drow = t.mode == 0 ? nn : ((nn >> 7) * 256 + (nn & 127) + (t.mode == 2 ? 128 : 0));
        *(u32x4*)(t.WT + (size_t)drow * t.K + t.k0 + 8 * c) = o; }
    asm volatile("s_waitcnt lgkmcnt(0)" ::: "memory");
}

DI void convert_items(const Args& a, LAS unsigned char* lds, int lo, int hi, int gw, int NGW) {
    const int lane = threadIdx.x & 63, wave = threadIdx.x >> 6;
    LAS float* scr = (LAS float*)(lds + wave * 18432);
    for (int it = lo + 4 * gw; it < hi; it += 4 * NGW) {
        const TItem t0 = p0_decode(a, it), t1 = p0_decode(a, it + 1), t2 = p0_decode(a, it + 2), t3 = p0_decode(a, it + 3);
        float v0[32], v1[32], v2[32], v3[32];
        p0_load(t0, v0, lane); p0_load(t1, v1, lane); p0_load(t2, v2, lane); p0_load(t3, v3, lane);
        p0_store(t0, v0, scr, lane); p0_store(t1, v1, scr + 2112, lane); p0_store(t2, v2, scr, lane); p0_store(t3, v3, scr + 2112, lane);
    }
}
DI void p0_prologue(const Args& a, LAS unsigned char* lds) {
    const int tid = threadIdx.x, lane = tid & 63, wave = tid >> 6;
    const int gw = blockIdx.x * 8 + wave, NGW = gridDim.x * 8;
    unsigned char* ws = a.ws;
    convert_items(a, lds, 0, TI_SET1, gw, NGW);
    { u32x4* z = (u32x4*)(ws + WS_WIN0 + (size_t)5152 * 1024 * 2); const int n16 = 224 * 1024 * 2 / 16;
      for (int i = blockIdx.x * 512 + tid; i < n16; i += gridDim.x * 512) z[i] = (u32x4){0u, 0u, 0u, 0u}; }
    float* ssq = (float*)(ws + WS_SSQ); bf16_t* xb = (bf16_t*)a.out;
    for (int m0 = 4 * gw; m0 < M; m0 += 4 * NGW) {
        f32x4 v[4][4];
#pragma unroll
        for (int q = 0; q < 4; ++q) { const int m = m0 + q; const float* xr = m < MP ? a.in[0] + (size_t)m * 1024 : a.in[1] + (size_t)(m - MP) * 1024;
#pragma unroll
            for (int j = 0; j < 4; ++j) v[q][j] = *((const f32x4*)xr + lane + 64 * j); }
#pragma unroll
        for (int q = 0; q < 4; ++q) { const int m = m0 + q; float s = 0.f;
#pragma unroll
            for (int j = 0; j < 4; ++j) { const f32x4 x = v[q][j]; s += (x[0] * x[0] + x[1] * x[1]) + (x[2] * x[2] + x[3] * x[3]);
                u32x2 w; w[0] = pk2(x[0], x[1]); w[1] = pk2(x[2], x[3]); *((u32x2*)(xb + (size_t)m * 1024) + lane + 64 * j) = w; }
            s = wave_sum(s);
            if (lane == 0) { ssq[m] = s; ssq[M + m] = 0.f; ssq[2 * M + m] = 0.f; ssq[3 * M + m] = 0.f; ssq[4 * M + m] = 0.f; } }
    }
}

struct EpiIn0 { static constexpr bool PERM = true, AFTER_DRAIN = false;
    bf16_t* Z; bf16_t* XBC; float* dtraw; const float* ssq;
    DI void operator()(const f32x4 (&acc)[2][2][4][2], const pg8::Unit& u, int wr, int wc, int fr, int fq) const {
        const int row0 = u.pm * 256 + wr * 64 + fr;
#pragma unroll
        for (int ai = 0; ai < 2; ++ai)
#pragma unroll
            for (int m = 0; m < 4; ++m) { const int row = row0 + ai * 128 + m * 16; const float rs = rsqrtf(ssq[row] * (1.f / 1024.f) + EPS);
                if (u.pn < 20) { bf16_t* base; int ldc, colt; if (u.pn < 8) { base = Z; ldc = 2048; colt = u.pn * 256; } else { base = XBC; ldc = 3072; colt = (u.pn - 8) * 256; }
#pragma unroll
                    for (int bj = 0; bj < 2; ++bj) { const f32x4 v0 = acc[ai][bj][m][0] * rs, v1 = acc[ai][bj][m][1] * rs; u32x4 w; w[0] = pk2(v0[0], v0[1]); w[1] = pk2(v0[2], v0[3]); w[2] = pk2(v1[0], v1[1]); w[3] = pk2(v1[2], v1[3]);
                        *(u32x4*)(base + (size_t)row * ldc + colt + bj * 128 + wc * 32 + 8 * fq) = w; } }
                else if (wc == 0) { float* p = dtraw + (size_t)row * 32 + 8 * fq; *(f32x4*)p = acc[ai][0][m][0] * rs; *(f32x4*)(p + 4) = acc[ai][0][m][1] * rs; } }
    }
};
struct EpiRes { static constexpr bool PERM = false, AFTER_DRAIN = false;
    const float* base0; const float* base1; float* xf; bf16_t* xb; float* ssq_out;
    DI void operator()(const f32x4 (&acc)[2][2][4][2], const pg8::Unit& u, int wr, int wc, int fr, int fq) const {
        const int row0 = u.pm * 256 + wr * 64 + fr, col0 = u.pn * 256 + wc * 32 + 4 * fq;
#pragma unroll
        for (int ai = 0; ai < 2; ++ai)
#pragma unroll
            for (int m = 0; m < 4; ++m) { const int row = row0 + ai * 128 + m * 16; const float* bp = row < MP ? base0 + (size_t)row * 1024 : base1 + (size_t)(row - MP) * 1024; float s = 0.f;
#pragma unroll
                for (int bj = 0; bj < 2; ++bj)
#pragma unroll
                    for (int n = 0; n < 2; ++n) { const int col = col0 + bj * 128 + n * 16; const f32x4 v = *(const f32x4*)(bp + col) + acc[ai][bj][m][n];
                        *(f32x4*)(xf + (size_t)row * 1024 + col) = v; s += (v[0] * v[0] + v[1] * v[1]) + (v[2] * v[2] + v[3] * v[3]);
                        if (xb) { u32x2 w; w[0] = pk2(v[0], v[1]); w[1] = pk2(v[2], v[3]); *(u32x2*)(xb + (size_t)row * 1024 + col) = w; } }
                s += __shfl_xor(s, 16); s += __shfl_xor(s, 32);
                if (fq == 0) atomicAdd(ssq_out + row, s); }
    }
};
struct EpiGU { static constexpr bool PERM = true, AFTER_DRAIN = false;
    bf16_t* H; const float* ssq;
    DI void operator()(const f32x4 (&acc)[2][2][4][2], const pg8::Unit& u, int wr, int wc, int fr, int fq) const {
        const int row0 = u.pm * 256 + wr * 64 + fr, col0 = u.pn * 128 + wc * 32 + 8 * fq;
#pragma unroll
        for (int ai = 0; ai < 2; ++ai)
#pragma unroll
            for (int m = 0; m < 4; ++m) { const int row = row0 + ai * 128 + m * 16; const float rs = rsqrtf(ssq[row] * (1.f / 1024.f) + EPS); float h[8];
#pragma unroll
                for (int n = 0; n < 2; ++n)
#pragma unroll
                    for (int j = 0; j < 4; ++j) { const float g = acc[ai][0][m][n][j] * rs, up = acc[ai][1][m][n][j] * rs; h[4 * n + j] = siluf(g) * up; }
                u32x4 w; w[0] = pk2(h[0], h[1]); w[1] = pk2(h[2], h[3]); w[2] = pk2(h[4], h[5]); w[3] = pk2(h[6], h[7]);
                *(u32x4*)(H + (size_t)row * FF + col0) = w; }
    }
};
struct EpiIn1 { static constexpr bool PERM = true, AFTER_DRAIN = false;
    bf16_t* O4; const float* ssq; const float* lbraw;
    DI void operator()(const f32x4 (&acc)[2][2][4][2], const pg8::Unit& u, int wr, int wc, int fr, int fq) const {
        const int row0 = u.pm * 256 + wr * 64 + fr, type = u.pn >> 2, col0 = (u.pn & 3) * 256 + wc * 32 + 8 * fq;
        bf16_t* base = O4 + (size_t)type * M * 1024; const bool act = (type == 0 || type == 3);
#pragma unroll
        for (int ai = 0; ai < 2; ++ai)
#pragma unroll
            for (int m = 0; m < 4; ++m) { const int row = row0 + ai * 128 + m * 16; const float rs = rsqrtf(ssq[row] * (1.f / 1024.f) + EPS);
#pragma unroll
                for (int bj = 0; bj < 2; ++bj) { f32x4 v0 = acc[ai][bj][m][0] * rs, v1 = acc[ai][bj][m][1] * rs;
                    if (act) {
#pragma unroll
                        for (int j = 0; j < 4; ++j) { v0[j] = siluf(v0[j]); v1[j] = siluf(v1[j]); } }
                    if (type == 1) { const int cc = col0 + bj * 128;
#pragma unroll
                        for (int j = 0; j < 4; ++j) { const float lb0 = sigm(lbraw[1024 + cc + j] - lbraw[cc + j]), lb1 = sigm(lbraw[1024 + cc + 4 + j] - lbraw[cc + 4 + j]);
                            v0[j] = __builtin_amdgcn_logf(lb0 + (1.f - lb0) * sigm(v0[j])); v1[j] = __builtin_amdgcn_logf(lb1 + (1.f - lb1) * sigm(v1[j])); } }
                    u32x4 w; w[0] = pk2(v0[0], v0[1]); w[1] = pk2(v0[2], v0[3]); w[2] = pk2(v1[0], v1[1]); w[3] = pk2(v1[2], v1[3]);
                    *(u32x4*)(base + (size_t)row * 1024 + col0 + bj * 128) = w; } }
    }
};
#define XB_TMO      128
#define XB_XCNT(j)  (256  + 64 * (j))
#define XB_XSUB(j)  (1280 + 64 * (j))
#define XB_XGEN(j)  (2304 + 64 * (j))
#define XB_TOP      3328
#define XB_TOPGEN   3392
#define XCD_BAR_WORDS 3456
#define XB_SPIN_CAP (1u << 18)

__device__ __forceinline__ unsigned xb_ld(unsigned* p)              { return __hip_atomic_load(p, __ATOMIC_RELAXED, __HIP_MEMORY_SCOPE_AGENT); }
__device__ __forceinline__ unsigned xb_add(unsigned* p, unsigned v) { return __hip_atomic_fetch_add(p, v, __ATOMIC_RELAXED, __HIP_MEMORY_SCOPE_AGENT); }
__device__ __forceinline__ unsigned xb_xcc_id() { return (unsigned)__builtin_amdgcn_s_getreg((3 << 11) | 20) & 0xFu; }
#define XB_SPIN(cond, bar) do { unsigned _sp = 0; while (cond) { __builtin_amdgcn_s_sleep(1); \
    if ((++_sp & 255u) == 0u) { if (xb_ld(&(bar)[XB_TMO])) break; if (_sp > XB_SPIN_CAP) { atomicAdd(&(bar)[XB_TMO], 1u); break; } } } } while (0)

struct XcdBarrier {
    unsigned* bar; unsigned x;
    volatile LAS unsigned* st;
};

__device__ __forceinline__ XcdBarrier xcd_barrier_post(unsigned* bar, volatile LAS unsigned* st) {
    XcdBarrier b; b.bar = bar; b.x = xb_xcc_id(); b.st = st;
    if (threadIdx.x == 0) (void)xb_add(&bar[XB_XCNT(b.x)], 1u);
    return b;
}
__device__ __forceinline__ void xcd_barrier_complete(unsigned* bar, unsigned x, unsigned& nloc, unsigned& nx) {
    const unsigned G = gridDim.x * gridDim.y * gridDim.z;
    unsigned sum, cnt, mine, sp = 0u;
    for (;;) {
        sum = 0u; cnt = 0u; mine = 0u;
#pragma unroll
        for (unsigned j = 0; j < 16; ++j) { const unsigned c = xb_ld(&bar[XB_XCNT(j)]); sum += c; cnt += (c > 0u) ? 1u : 0u; mine = (j == x) ? c : mine; }
        if (sum == G) break;
        __builtin_amdgcn_s_sleep(1);
        if ((++sp & 255u) == 0u) { if (xb_ld(&bar[XB_TMO])) break; if (sp > XB_SPIN_CAP) { atomicAdd(&bar[XB_TMO], 1u); break; } }
    }
    nloc = mine > 0u ? mine : 1u; nx = cnt > 0u ? cnt : 1u;
}

__device__ __forceinline__ void xcd_barrier(const XcdBarrier& b) {
    asm volatile("s_waitcnt vmcnt(0)" ::: "memory");
    __syncthreads();
    if (threadIdx.x == 0) {
        unsigned* bar = b.bar;
        __builtin_amdgcn_s_waitcnt(0);
        unsigned nloc = b.st[0], nx = b.st[1];
        if (nloc == 0u) { xcd_barrier_complete(bar, b.x, nloc, nx); b.st[0] = nloc; b.st[1] = nx; }
        const unsigned old = xb_add(&bar[XB_XSUB(b.x)], 1u);
        const unsigned gen = old / nloc;
        if (old + 1u == (gen + 1u) * nloc) {
            __builtin_amdgcn_fence(__ATOMIC_RELEASE, "agent");
            asm volatile("s_waitcnt vmcnt(0)" ::: "memory");
            const unsigned og = xb_add(&bar[XB_TOP], 1u);
            const unsigned tg = og / nx;
            if (og + 1u == (tg + 1u) * nx) xb_add(&bar[XB_TOPGEN], 1u);
            else XB_SPIN(xb_ld(&bar[XB_TOPGEN]) == tg, bar);
            __builtin_amdgcn_fence(__ATOMIC_ACQUIRE, "agent");
            xb_add(&bar[XB_XGEN(b.x)], 1u);
            asm volatile("s_waitcnt vmcnt(0)" ::: "memory");
        } else {
            XB_SPIN(xb_ld(&bar[XB_XGEN(b.x)]) == gen, bar);
            __builtin_amdgcn_fence(__ATOMIC_ACQUIRE, "agent");
            asm volatile("s_waitcnt vmcnt(0)" ::: "memory");
        }
    }
    __syncthreads();
}
constexpr int L_XT = 0, L_BN = 73728, L_CN = 91136, L_BT = 108544, L_SDT = 126976, L_SCUM = 129024, L_SW = 131072, L_RED = 133120, L_GW = 135168;
template <bool OUT> DI void ssd_unit(const Args& a, LAS unsigned char* L, int unit) {
    const int tid = threadIdx.x, lane = tid & 63, wid = tid >> 6, r = lane & 31, h = lane >> 5;
    unsigned char* ws = a.ws;
    bf16_t* Z = (bf16_t*)(ws + WS_BIG); const bf16_t* XBC = (const bf16_t*)(ws + WS_BIG + BIG_XBC);
    const float* dtraw = (const float*)(ws + WS_DTRAW); float* cdec = (float*)(ws + WS_CDEC);
    float* LBUF = a.out;
    const bool prompt = unit < 256;
    int b, sc, g, row_base, nch, len;
    if (prompt) { b = unit >> 7; sc = (unit >> 2) & 31; g = unit & 3; row_base = b * 8192 + sc * 256; nch = 4; len = 64; }
    else { const int u2 = unit - 256; b = u2 >> 2; sc = 0; g = u2 & 3; row_base = MP + b * 32; nch = 1; len = 32; }
    const int hh = wid, head = g * 8 + hh;
    LAS float* SDT = (LAS float*)(L + L_SDT); LAS float* SCUM = (LAS float*)(L + L_SCUM); LAS float* SW = (LAS float*)(L + L_SW); LAS float* RED = (LAS float*)(L + L_RED);
    const float Dh = a.in[11][head];
    bf16x8 stp[4][2][2];
    const float* sprev = prompt ? LBUF + (size_t)((b * 32 + sc) * 32 + head) * 8192 : a.in[2] + (size_t)(b * 32 + head) * 8192;
#pragma unroll
    for (int nt = 0; nt < 4; ++nt)
#pragma unroll
        for (int pt = 0; pt < 2; ++pt) { f32x16 t = zero16();
            if (OUT) {
#pragma unroll
                for (int g4 = 0; g4 < 4; ++g4) { const f32x4 v = *(const f32x4*)(sprev + (32 * pt + r) * 128 + 32 * nt + 8 * g4 + 4 * h); t[4 * g4] = v[0]; t[4 * g4 + 1] = v[1]; t[4 * g4 + 2] = v[2]; t[4 * g4 + 3] = v[3]; } }
            stp[nt][pt][0] = pack8(t, 0); stp[nt][pt][1] = pack8(t, 1); if (pt == 1 && (nt & 1)) __builtin_amdgcn_sched_barrier(0); }
    float dsum = 0.f;
    if (OUT) __syncthreads();
    if (OUT && tid < 128) *(LAS f32x4*)(L + L_GW + tid * 16) = *(const f32x4*)(a.in[12] + g * 512 + tid * 4);
    for (int c = 0; c < nch; ++c) {
        int r_s = r, h_s = h, tid_s = tid; asm volatile("" : "+v"(r_s), "+v"(h_s), "+v"(tid_s));
        const int r = r_s, h = h_s, tid = tid_s;
        const int row0 = row_base + c * 64;
        __syncthreads();
        { const int s = tid >> 3, h8 = tid & 7, hd = g * 8 + h8; float dtv = 0.f;
          if (s < len) { const float xr = dtraw[(size_t)(row0 + s) * 32 + hd] + a.in[9][hd]; dtv = xr > 20.f ? xr : log1pf(__expf(xr)); }
          SDT[s * 8 + h8] = dtv; SCUM[s * 8 + h8] = -dtv * __expf(a.in[10][hd]); }
        __syncthreads();
        if (tid >= 448 && tid < 456) { const int h8 = tid - 448; float run = 0.f;
#pragma unroll 8
            for (int s2 = 0; s2 < 64; ++s2) { run += SCUM[s2 * 8 + h8]; SCUM[s2 * 8 + h8] = run; }
#pragma unroll 8
            for (int s2 = 0; s2 < 64; ++s2) SW[h8 * 64 + s2] = SDT[s2 * 8 + h8] * __expf(run - SCUM[s2 * 8 + h8]); }
        {
            const bool first_chunk = prompt ? (sc == 0 && c == 0) : true;
            const bool last_chunk = prompt ? (sc == 31 && c == 3) : true;
#pragma unroll 1
            for (int it = 0; it < 3; ++it) {
                const int id = tid + 512 * it, cg4 = id % 192, s0 = (id / 192) * 8; int kind, lc, col;
                if (cg4 < 128) { kind = 0; lc = cg4 * 4; col = g * 512 + lc; } else if (cg4 < 160) { kind = 1; lc = (cg4 - 128) * 4; col = 2048 + g * 128 + lc; } else { kind = 2; lc = (cg4 - 160) * 4; col = 2560 + g * 128 + lc; }
                u32x2 raw[11]; f32x4 w[4];
                const bf16_t* rp = XBC + (size_t)(row0 + s0 - 3) * 3072 + col;
#pragma unroll
                for (int i = 0; i < 11; ++i) { const int s = s0 - 3 + i; raw[i] = (u32x2){0u, 0u};
                    if (s >= 0 ? (s < len) : !first_chunk) raw[i] = *(const u32x2*)(rp + (size_t)i * 3072); }
#pragma unroll
                for (int t4 = 0; t4 < 4; ++t4) w[t4] = *(const f32x4*)(a.in[7] + t4 * 3072 + col);
                const f32x4 bias = *(const f32x4*)(a.in[8] + col);
                if (!prompt && s0 == 0) {
#pragma unroll
                    for (int i = 0; i < 3; ++i) { const f32x4 hv = *(const f32x4*)(a.in[3] + (size_t)(b * 3 + i) * 3072 + col); raw[i][0] = pk2(hv[0], hv[1]); raw[i][1] = pk2(hv[2], hv[3]); } }
                float* convout = a.out + (prompt ? O_CONVP : O_CONVS) + (size_t)b * 3 * 3072 + col;
                f32x4 win[3]; unsigned vbp[4][4]; f32x4 vprev = (f32x4){0.f, 0.f, 0.f, 0.f};
#pragma unroll
                for (int i = 0; i < 11; ++i) { const int s = s0 - 3 + i;
                    const f32x4 cur = (f32x4){bflo(raw[i][0]), bfhi(raw[i][0]), bflo(raw[i][1]), bfhi(raw[i][1])};
                    if (i < 3) { win[i] = cur; }
                    else { const int j8 = i - 3;
                        if (!OUT && last_chunk && s >= len - 3 && s < len) *(f32x4*)(convout + (size_t)(s - (len - 3)) * 3072) = cur;
                        f32x4 v = bias + w[0] * win[0] + w[1] * win[1] + w[2] * win[2] + w[3] * cur;
#pragma unroll
                        for (int j = 0; j < 4; ++j) v[j] = (s < len) ? siluf(v[j]) : 0.f;
                        if (kind != 0) { u32x2 o; o[0] = pk2(v[0], v[1]); o[1] = pk2(v[2], v[3]); *(LAS u32x2*)(L + (kind == 1 ? L_BN : L_CN) + (s * 136 + lc) * 2) = o; }
                        if (j8 & 1) {
#pragma unroll
                            for (int j = 0; j < 4; ++j) vbp[j][j8 >> 1] = pk2(vprev[j], v[j]); }
                        else vprev = v;
                        win[0] = win[1]; win[1] = win[2]; win[2] = cur;
                    }
                }
                if (kind != 2) { LAS unsigned char* tb = L + (kind == 0 ? L_XT : L_BT);
#pragma unroll
                    for (int j = 0; j < 4; ++j) { u32x4 o; o[0] = vbp[j][0]; o[1] = vbp[j][1]; o[2] = vbp[j][2]; o[3] = vbp[j][3]; *(LAS u32x4*)(tb + ((lc + j) * 72 + s0) * 2) = o; } }
            }
        }
        __syncthreads();
        const float clast = SCUM[63 * 8 + hh];
        if (OUT) {
#pragma unroll
            for (int tt = 0; tt < 2; ++tt) {
                f32x16 y[2] = {zero16(), zero16()};
                const bool valid = (32 * tt + r) < len; const size_t rowoff = (size_t)(row0 + 32 * tt + r) * 2048 + head * 64;
                u32x2 zpre[2][4];
#pragma unroll
                for (int pt = 0; pt < 2; ++pt)
#pragma unroll
                    for (int g4 = 0; g4 < 4; ++g4) { zpre[pt][g4] = (u32x2){0u, 0u}; if (valid) zpre[pt][g4] = *(const u32x2*)(Z + rowoff + 32 * pt + 8 * g4 + 4 * h); }
#pragma unroll
                for (int nt = 0; nt < 4; ++nt)
#pragma unroll
                    for (int q = 0; q < 2; ++q) { const bf16x8 pb = lds_2b64(L + L_CN + ((32 * tt + r) * 136 + 32 * nt + 16 * q + 4 * h) * 2);
#pragma unroll
                        for (int pt = 0; pt < 2; ++pt) y[pt] = MFMA32(stp[nt][pt][q], pb, y[pt]); }
                const float ct = SCUM[(32 * tt + r) * 8 + hh]; { const float e = __expf(ct); y[0] = y[0] * e; y[1] = y[1] * e; }
#pragma unroll
                for (int st = 0; st <= tt; ++st) {
                    f32x16 gm = zero16();
#pragma unroll
                    for (int ks = 0; ks < 8; ++ks) { const bf16x8 fa = lds_b128(L + L_BN + ((32 * st + r) * 136 + 16 * ks + 8 * h) * 2), fb = lds_b128(L + L_CN + ((32 * tt + r) * 136 + 16 * ks + 8 * h) * 2);
                        gm = MFMA32(fa, fb, gm); }
                    const int t = 32 * tt + r;
#pragma unroll
                    for (int i = 0; i < 16; ++i) { const int s = 32 * st + crow(i, h); const float cs = SCUM[s * 8 + hh], ds = SDT[s * 8 + hh];
                        float val = (s <= t) ? gm[i] * __expf(fminf(ct - cs, 0.f)) * ds : 0.f; if (s == t) val += Dh; gm[i] = val; }
#pragma unroll
                    for (int q = 0; q < 2; ++q) { const bf16x8 xs = pack8(gm, q);
#pragma unroll
                        for (int pt = 0; pt < 2; ++pt) { const bf16x8 pa = lds_2b64(L + L_XT + ((hh * 64 + 32 * pt + r) * 72 + 32 * st + 16 * q + 4 * h) * 2); y[pt] = MFMA32(pa, xs, y[pt]); } }
                }
                float ssum = 0.f;
#pragma unroll
                for (int pt = 0; pt < 2; ++pt)
#pragma unroll
                    for (int g4 = 0; g4 < 4; ++g4) { const u32x2 zz = zpre[pt][g4];
                        y[pt][4 * g4] *= siluf(bflo(zz[0])); y[pt][4 * g4 + 1] *= siluf(bfhi(zz[0])); y[pt][4 * g4 + 2] *= siluf(bflo(zz[1])); y[pt][4 * g4 + 3] *= siluf(bfhi(zz[1]));
#pragma unroll
                        for (int j = 0; j < 4; ++j) { const float v = valid ? y[pt][4 * g4 + j] : 0.f; ssum += v * v; } }
                ssum += __shfl_xor(ssum, 32);
                if (h == 0) RED[hh * 64 + 32 * tt + r] = ssum;
                __syncthreads();
                float tot = 0.f;
#pragma unroll
                for (int w8 = 0; w8 < 8; ++w8) tot += RED[w8 * 64 + 32 * tt + r];
                const float rstd = rsqrtf(tot * (1.f / 512.f) + EPS);
                if (valid) {
#pragma unroll
                    for (int pt = 0; pt < 2; ++pt)
#pragma unroll
                        for (int g4 = 0; g4 < 4; ++g4) { const int p0 = 32 * pt + 8 * g4 + 4 * h; const f32x4 gw = *(LAS f32x4*)(L + L_GW + (hh * 64 + p0) * 4);
                            u32x2 o; o[0] = pk2(y[pt][4 * g4] * rstd * gw[0], y[pt][4 * g4 + 1] * rstd * gw[1]); o[1] = pk2(y[pt][4 * g4 + 2] * rstd * gw[2], y[pt][4 * g4 + 3] * rstd * gw[3]);
                            *(u32x2*)(Z + rowoff + p0) = o; } }
            }
        }
        dsum += clast;
        if (!OUT || c + 1 < nch) {
            const float dec = __expf(clast);
#pragma unroll
            for (int nt = 0; nt < 4; ++nt) { bf16x8 af[4];
#pragma unroll
                for (int ks = 0; ks < 4; ++ks) { const u32x4 raw = *(LAS u32x4*)(L + L_BT + ((32 * nt + r) * 72 + 16 * ks + 8 * h) * 2);
                    const f32x4 s0 = *(LAS f32x4*)(SW + hh * 64 + 16 * ks + 8 * h), s1 = *(LAS f32x4*)(SW + hh * 64 + 16 * ks + 8 * h + 4);
                    u32x4 o; o[0] = pk2(bflo(raw[0]) * s0[0], bfhi(raw[0]) * s0[1]); o[1] = pk2(bflo(raw[1]) * s0[2], bfhi(raw[1]) * s0[3]); o[2] = pk2(bflo(raw[2]) * s1[0], bfhi(raw[2]) * s1[1]); o[3] = pk2(bflo(raw[3]) * s1[2], bfhi(raw[3]) * s1[3]);
                    af[ks] = __builtin_bit_cast(bf16x8, o); }
#pragma unroll
                for (int pt = 0; pt < 2; ++pt) { f32x16 t; unpack8(stp[nt][pt][0], t, 0); unpack8(stp[nt][pt][1], t, 1); t = t * dec;
#pragma unroll
                    for (int ks = 0; ks < 4; ++ks) { const bf16x8 fb = lds_b128(L + L_XT + ((hh * 64 + 32 * pt + r) * 72 + 16 * ks + 8 * h) * 2); t = MFMA32(af[ks], fb, t); }
                    stp[nt][pt][0] = pack8(t, 0); stp[nt][pt][1] = pack8(t, 1); } }
        }
    }
    if (!OUT) {
        const float dect = __expf(dsum);
        int loff = r * 128 + 4 * h; asm volatile("" : "+v"(loff) :: "memory");
        float* dstp = (prompt ? LBUF + (size_t)((b * 32 + sc) * 32 + head) * 8192 : a.out + O_SSDS + (size_t)(b * 32 + head) * 8192) + loff;
        const float* s0p = a.in[2] + (size_t)(prompt ? 0 : (b * 32 + head)) * 8192 + loff;
#pragma unroll
        for (int nt = 0; nt < 4; ++nt)
#pragma unroll
            for (int pt = 0; pt < 2; ++pt) { f32x16 t; unpack8(stp[nt][pt][0], t, 0); unpack8(stp[nt][pt][1], t, 1);
#pragma unroll
                for (int g4 = 0; g4 < 4; ++g4) { const int co = (32 * pt) * 128 + 32 * nt + 8 * g4; f32x4 v = (f32x4){t[4 * g4], t[4 * g4 + 1], t[4 * g4 + 2], t[4 * g4 + 3]};
                    if (!prompt) { const f32x4 s0 = *(const f32x4*)(s0p + co); v = s0 * dect + v; }
                    *(f32x4*)(dstp + co) = v; }
                __builtin_amdgcn_sched_barrier(0); }
        if (prompt && lane == 0) cdec[(b * 32 + sc) * 32 + head] = dect;
    }
}
DI void ssd_pass(const Args& a) {
    float* LBUF = a.out; const float* cdec = (const float*)(a.ws + WS_CDEC);
    for (int item = blockIdx.x * 512 + threadIdx.x; item < 131072; item += gridDim.x * 512) { const int b = item >> 16, head = (item >> 11) & 31, e4 = item & 2047;
        float* base = LBUF + (size_t)(b * 32 * 32 + head) * 8192 + e4 * 4; f32x4 run = (f32x4){0.f, 0.f, 0.f, 0.f};
#pragma unroll 1
        for (int sc0 = 0; sc0 < 32; sc0 += 8) { f32x4 l[8]; float dc[8];
#pragma unroll
            for (int j = 0; j < 8; ++j) { l[j] = *(const f32x4*)(base + (size_t)(sc0 + j) * 32 * 8192); dc[j] = cdec[(b * 32 + sc0 + j) * 32 + head]; }
#pragma unroll
            for (int j = 0; j < 8; ++j) { *(f32x4*)(base + (size_t)(sc0 + j) * 32 * 8192) = run; run = run * dc[j] + l[j]; } }
        *(f32x4*)(a.out + O_SSDP + (size_t)(b * 32 + head) * 8192 + e4 * 4) = run; }
}

constexpr int G_QE = 0, G_KE = 17408, G_KDT = 34816, G_VT = 53248, G_HEAD = 71680, G_SDEC = 143360, G_RED = 144384, G_HT = 146432;
template <bool OUT> DI void gla_unit(const Args& a, LAS unsigned char* L, int unit) {
    const int tid = threadIdx.x, lane = tid & 63, wid = tid >> 6, r = lane & 31, h = lane >> 5;
    unsigned char* ws = a.ws;
    bf16_t* QS = (bf16_t*)(ws + WS_BIG); const bf16_t* FR = QS + (size_t)M * 1024; const bf16_t* VV = QS + (size_t)2 * M * 1024; const bf16_t* GS = QS + (size_t)3 * M * 1024;
    float* LBUF = (float*)(ws + WS_BIG + BIG_XB); float* cdec = (float*)(ws + WS_CDEC);
    const bool prompt = unit < 256;
    int b, sc, pr, row_base, nch, len;
    if (prompt) { b = unit >> 7; sc = (unit >> 2) & 31; pr = unit & 3; row_base = b * 8192 + sc * 256; nch = 4; len = 64; }
    else { const int u2 = unit - 256; b = u2 >> 2; sc = 0; pr = u2 & 3; row_base = MP + b * 32; nch = 1; len = 32; }
    const int hl = wid >> 2, vt = wid & 3, head = pr * 2 + hl;
    LAS unsigned char* LH = L + hl * G_HEAD;
    LAS float* SDEC = (LAS float*)(L + G_SDEC) + hl * 128; LAS float* RED = (LAS float*)(L + G_RED);
    const int phl = tid >> 8, ptt = tid & 255, phead = pr * 2 + phl; LAS unsigned char* PH = L + phl * G_HEAD;
    float bsum0 = 0.f, bsum1 = 0.f;
    bf16x8 stp[4][2];
    const float* sprev = prompt ? LBUF + (size_t)((b * 32 + sc) * 8 + head) * 16384 : a.in[4] + (size_t)(b * 8 + head) * 16384;
#pragma unroll
    for (int kt = 0; kt < 4; ++kt) { f32x16 t = zero16();
        if (OUT) {
#pragma unroll
            for (int i = 0; i < 16; ++i) t[i] = sprev[(32 * kt + crow(i, h)) * 128 + 32 * vt + r]; }
        stp[kt][0] = pack8(t, 0); stp[kt][1] = pack8(t, 1); }
    for (int c = 0; c < nch; ++c) {
        const int row0 = row_base + c * 64;
        __syncthreads();
        {
            const int cp = ptt & 63, rq = ptt >> 6, kc = 2 * cp; const size_t cb = (size_t)(row0 + 16 * rq) * 1024 + phead * 128 + kc;
            LAS float* HT = (LAS float*)(L + G_HT) + phl * 512;
            unsigned rf[16], rv[16], rqs[16];
#pragma unroll
            for (int j = 0; j < 16; ++j) { const bool ok = (16 * rq + j) < len; rf[j] = 0u; rv[j] = 0u; rqs[j] = 0u;
                if (ok) { rf[j] = *(const unsigned*)(FR + cb + (size_t)j * 1024); rv[j] = *(const unsigned*)(VV + cb + (size_t)j * 1024); rqs[j] = *(const unsigned*)(QS + cb + (size_t)j * 1024); } }
            float b0[16], b1[16]; float c0 = 0.f, c1 = 0.f;
#pragma unroll
            for (int j = 0; j < 16; ++j) { c0 += bflo(rf[j]); c1 += bfhi(rf[j]); b0[j] = c0; b1[j] = c1; }
            HT[rq * 128 + kc] = c0; HT[rq * 128 + kc + 1] = c1;
#pragma unroll
            for (int hf = 0; hf < 2; ++hf) { u32x4 o0, o1;
#pragma unroll
                for (int w2 = 0; w2 < 4; ++w2) { const unsigned x0 = rv[8 * hf + 2 * w2], x1 = rv[8 * hf + 2 * w2 + 1]; o0[w2] = (x0 & 0xffffu) | (x1 << 16); o1[w2] = (x0 >> 16) | (x1 & 0xffff0000u); }
                *(LAS u32x4*)(PH + G_VT + (kc * 72 + 16 * rq + 8 * hf) * 2) = o0; *(LAS u32x4*)(PH + G_VT + ((kc + 1) * 72 + 16 * rq + 8 * hf) * 2) = o1; }
            __syncthreads();
            float off0 = 0.f, off1 = 0.f, bl0 = 0.f, bl1 = 0.f;
#pragma unroll
            for (int q4 = 0; q4 < 4; ++q4) { const float t0 = HT[q4 * 128 + kc], t1 = HT[q4 * 128 + kc + 1]; bl0 += t0; bl1 += t1; if (q4 < rq) { off0 += t0; off1 += t1; } }
            const float ebl0 = __builtin_amdgcn_exp2f(bl0), ebl1 = __builtin_amdgcn_exp2f(bl1);
            if (rq == 0) { bsum0 += bl0; bsum1 += bl1; ((LAS float*)(L + G_SDEC))[phl * 128 + kc] = ebl0; ((LAS float*)(L + G_SDEC))[phl * 128 + kc + 1] = ebl1; }
#pragma unroll
            for (int hf = 0; hf < 2; ++hf) { u32x4 o0, o1; float kd0[8], kd1[8];
#pragma unroll
                for (int j = 0; j < 8; ++j) { const int jj = 8 * hf + j, s = 16 * rq + jj; const bool ok = s < len;
                    const float k0 = ok ? 1.f - __builtin_amdgcn_exp2f(bflo(rf[jj])) : 0.f, k1 = ok ? 1.f - __builtin_amdgcn_exp2f(bfhi(rf[jj])) : 0.f;
                    const float e0 = __builtin_amdgcn_exp2f(b0[jj] + off0), e1 = __builtin_amdgcn_exp2f(b1[jj] + off1), r0 = __builtin_amdgcn_rcpf(e0), r1 = __builtin_amdgcn_rcpf(e1);
                    const float ke0 = k0 * r0, ke1 = k1 * r1; kd0[j] = ke0 * ebl0; kd1[j] = ke1 * ebl1;
                    *(LAS unsigned*)(PH + G_QE + (s * 136 + kc) * 2) = pk2(bflo(rqs[jj]) * e0, bfhi(rqs[jj]) * e1); *(LAS unsigned*)(PH + G_KE + (s * 136 + kc) * 2) = pk2(ke0, ke1); }
                o0[0] = pk2(kd0[0], kd0[1]); o0[1] = pk2(kd0[2], kd0[3]); o0[2] = pk2(kd0[4], kd0[5]); o0[3] = pk2(kd0[6], kd0[7]);
                o1[0] = pk2(kd1[0], kd1[1]); o1[1] = pk2(kd1[2], kd1[3]); o1[2] = pk2(kd1[4], kd1[5]); o1[3] = pk2(kd1[6], kd1[7]);
                *(LAS u32x4*)(PH + G_KDT + (kc * 72 + 16 * rq + 8 * hf) * 2) = o0; *(LAS u32x4*)(PH + G_KDT + ((kc + 1) * 72 + 16 * rq + 8 * hf) * 2) = o1; }
        }
        __syncthreads();
        if (OUT) {
            f32x16 o[2] = {zero16(), zero16()};
            u32x2 gpre[2][4]; f32x4 gwv[4];
#pragma unroll
            for (int g4 = 0; g4 < 4; ++g4) { gwv[g4] = *(const f32x4*)(a.in[17] + 32 * vt + 8 * g4 + 4 * h);
#pragma unroll
                for (int tt = 0; tt < 2; ++tt) { gpre[tt][g4] = (u32x2){0u, 0u}; if ((32 * tt + r) < len) gpre[tt][g4] = *(const u32x2*)(GS + (size_t)(row0 + 32 * tt + r) * 1024 + head * 128 + 32 * vt + 8 * g4 + 4 * h); } }
#pragma unroll
            for (int kt = 0; kt < 4; ++kt)
#pragma unroll
                for (int q = 0; q < 2; ++q)
#pragma unroll
                    for (int tt = 0; tt < 2; ++tt) { const bf16x8 pb = lds_2b64(LH + G_QE + ((32 * tt + r) * 136 + 32 * kt + 16 * q + 4 * h) * 2); o[tt] = MFMA32(stp[kt][q], pb, o[tt]); }
#pragma unroll
            for (int cmb = 0; cmb < 3; ++cmb) { const int st = cmb >> 1, tt = (cmb + 1) >> 1;
                f32x16 gm = zero16();
#pragma unroll
                for (int ks = 0; ks < 8; ++ks) { const bf16x8 fa = lds_b128(LH + G_KE + ((32 * st + r) * 136 + 16 * ks + 8 * h) * 2), fb = lds_b128(LH + G_QE + ((32 * tt + r) * 136 + 16 * ks + 8 * h) * 2);
                    gm = MFMA32(fa, fb, gm); }
                const int t = 32 * tt + r;
#pragma unroll
                for (int i = 0; i < 16; ++i) { const int s = 32 * st + crow(i, h); gm[i] = (s <= t) ? gm[i] : 0.f; }
#pragma unroll
                for (int q = 0; q < 2; ++q) { const bf16x8 xs = pack8(gm, q); const bf16x8 pa = lds_2b64(LH + G_VT + ((32 * vt + r) * 72 + 32 * st + 16 * q + 4 * h) * 2); o[tt] = MFMA32(pa, xs, o[tt]); }
            }
#pragma unroll
            for (int tt = 0; tt < 2; ++tt) { float ss = 0.f;
#pragma unroll
                for (int i = 0; i < 16; ++i) ss += o[tt][i] * o[tt][i];
                ss += __shfl_xor(ss, 32); if (h == 0) RED[wid * 64 + 32 * tt + r] = ss; }
            __syncthreads();
#pragma unroll
            for (int tt = 0; tt < 2; ++tt) { const bool valid = (32 * tt + r) < len; float tot = 0.f;
#pragma unroll
                for (int w4 = 0; w4 < 4; ++w4) tot += RED[(hl * 4 + w4) * 64 + 32 * tt + r];
                const float rstd = rsqrtf(tot * (1.f / 128.f) + EPS); const size_t rowoff = (size_t)(row0 + 32 * tt + r) * 1024 + head * 128;
                if (valid) {
#pragma unroll
                    for (int g4 = 0; g4 < 4; ++g4) { const int v0 = 32 * vt + 8 * g4 + 4 * h; const f32x4 gw = gwv[g4]; const u32x2 gg = gpre[tt][g4];
                        u32x2 w; w[0] = pk2(o[tt][4 * g4] * rstd * gw[0] * bflo(gg[0]), o[tt][4 * g4 + 1] * rstd * gw[1] * bfhi(gg[0])); w[1] = pk2(o[tt][4 * g4 + 2] * rstd * gw[2] * bflo(gg[1]), o[tt][4 * g4 + 3] * rstd * gw[3] * bfhi(gg[1]));
                        *(u32x2*)(QS + rowoff + v0) = w; } } }
        }
        if (!OUT || c + 1 < nch) {
#pragma unroll
            for (int kt = 0; kt < 4; ++kt) { f32x16 t; unpack8(stp[kt][0], t, 0); unpack8(stp[kt][1], t, 1);
#pragma unroll
                for (int i = 0; i < 16; ++i) t[i] *= SDEC[32 * kt + crow(i, h)];
#pragma unroll
                for (int ks = 0; ks < 4; ++ks) { const bf16x8 fa = lds_b128(LH + G_KDT + ((32 * kt + r) * 72 + 16 * ks + 8 * h) * 2), fb = lds_b128(LH + G_VT + ((32 * vt + r) * 72 + 16 * ks + 8 * h) * 2); t = MFMA32(fa, fb, t); }
                stp[kt][0] = pack8(t, 0); stp[kt][1] = pack8(t, 1); }
        }
    }
    if (!OUT) {
#pragma unroll
        for (int kt = 0; kt < 4; ++kt) { f32x16 t; unpack8(stp[kt][0], t, 0); unpack8(stp[kt][1], t, 1);
#pragma unroll
            for (int i = 0; i < 16; ++i) { const int k = 32 * kt + crow(i, h); const size_t off = (size_t)k * 128 + 32 * vt + r;
                if (prompt) LBUF[(size_t)((b * 32 + sc) * 8 + head) * 16384 + off] = t[i];
                else a.out[O_HGS + (size_t)(b * 8 + head) * 16384 + off] = SDEC[k] * a.in[4][(size_t)(b * 8 + head) * 16384 + off] + t[i]; } }
        if (prompt && ptt < 64) { cdec[((b * 32 + sc) * 8 + phead) * 128 + 2 * ptt] = __builtin_amdgcn_exp2f(bsum0); cdec[((b * 32 + sc) * 8 + phead) * 128 + 2 * ptt + 1] = __builtin_amdgcn_exp2f(bsum1); }
    }
}
DI void gla_pass(const Args& a) {
    float* LBUF = (float*)(a.ws + WS_BIG + BIG_XB); const float* cdec = (const float*)(a.ws + WS_CDEC);
    for (int item = blockIdx.x * 512 + threadIdx.x; item < 65536; item += gridDim.x * 512) { const int b = item >> 15, head = (item >> 12) & 7, e4 = item & 4095, k = e4 >> 5;
        float* base = LBUF + (size_t)(b * 32 * 8 + head) * 16384 + e4 * 4; f32x4 run = (f32x4){0.f, 0.f, 0.f, 0.f};
#pragma unroll 1
        for (int sc0 = 0; sc0 < 32; sc0 += 8) { f32x4 l[8]; float dc[8];
#pragma unroll
            for (int j = 0; j < 8; ++j) { l[j] = *(const f32x4*)(base + (size_t)(sc0 + j) * 8 * 16384); dc[j] = cdec[((b * 32 + sc0 + j) * 8 + head) * 128 + k]; }
#pragma unroll
            for (int j = 0; j < 8; ++j) { *(f32x4*)(base + (size_t)(sc0 + j) * 8 * 16384) = run; run = run * dc[j] + l[j]; } }
        *(f32x4*)(a.out + O_HGP + (size_t)(b * 8 + head) * 16384 + e4 * 4) = run; }
}
DI void final_norm(const Args& a) {
    const int lane = threadIdx.x & 63, gw = blockIdx.x * 8 + (threadIdx.x >> 6), NGW = gridDim.x * 8; const float* ssq = (const float*)(a.ws + WS_SSQ) + 4 * (size_t)M;
    for (int m = gw; m < M; m += NGW) { const float rs = rsqrtf(ssq[m] * (1.f / 1024.f) + EPS); f32x4* row = (f32x4*)(a.out + (size_t)m * 1024);
#pragma unroll
        for (int j = 0; j < 4; ++j) { const f32x4 w = *((const f32x4*)a.in[23] + lane + 64 * j); row[lane + 64 * j] = row[lane + 64 * j] * rs * w; } }
}


DI void sample_gemm_res(const bf16_t* A, const bf16_t* Bt, int K, const float* base, float* xf, bf16_t* xb, float* ssq_out) {
    const int lane = threadIdx.x & 63, wid = threadIdx.x >> 6, c16 = lane & 15, q = lane >> 4;
    for (int tile = blockIdx.x * 8 + wid; tile < 2048; tile += gridDim.x * 8) { const int rt = tile >> 6, ct = tile & 63;
        const bf16_t* ap = A + (size_t)(MP + rt * 16 + c16) * K + 8 * q; const bf16_t* bp = Bt + (size_t)(ct * 16 + c16) * K + 8 * q;
        f32x4 acc0 = (f32x4){0.f, 0.f, 0.f, 0.f}, acc1 = acc0;
#pragma unroll 8
        for (int k = 0; k < K; k += 64) { const bf16x8 a0 = *(const bf16x8*)(ap + k), b0 = *(const bf16x8*)(bp + k), a1 = *(const bf16x8*)(ap + k + 32), b1 = *(const bf16x8*)(bp + k + 32);
            acc0 = __builtin_amdgcn_mfma_f32_16x16x32_bf16(a0, b0, acc0, 0, 0, 0); acc1 = __builtin_amdgcn_mfma_f32_16x16x32_bf16(a1, b1, acc1, 0, 0, 0); }
        const f32x4 acc = acc0 + acc1; const int col = ct * 16 + c16;
#pragma unroll
        for (int i = 0; i < 4; ++i) { const int rl = rt * 16 + 4 * q + i; const size_t o = (size_t)(MP + rl) * 1024 + col; const float v = base[(size_t)rl * 1024 + col] + acc[i];
            xf[o] = v; if (xb) xb[o] = (bf16_t)(pk2(v, 0.f) & 0xffffu);
            float s = v * v; s += __shfl_xor(s, 1); s += __shfl_xor(s, 2); s += __shfl_xor(s, 4); s += __shfl_xor(s, 8);
            if (c16 == 0) atomicAdd(ssq_out + MP + rl, s); } }
}
__global__ void __launch_bounds__(512, 2) mk_fwd(Args a) {
    extern __shared__ __attribute__((aligned(16))) unsigned char lds_raw[];
    LAS unsigned char* lds = (LAS unsigned char*)lds_raw;
    unsigned char* ws = a.ws; float* ssq = (float*)(ws + WS_SSQ);
    if (threadIdx.x < 16) ((LAS unsigned*)(lds + LDS_MISC))[threadIdx.x] = 0u;
    __syncthreads();
    XcdBarrier xbar; xbar.bar = (unsigned*)(ws + WS_BAR); xbar.x = 0; xbar.st = nullptr;
    if (a.ph_hi - a.ph_lo > 1) xbar = xcd_barrier_post((unsigned*)(ws + WS_BAR), (volatile LAS unsigned*)(lds + LDS_MISC));
    const int lo = a.ph_lo, hi = a.ph_hi, G = gridDim.x, bx = blockIdx.x;
    if (lo < 0) cg::this_grid().sync();
#ifndef DUPMASK
#define DUPMASK 0
#endif
#define REP(k) for (int rep_ = 0; rep_ < 1 + ((DUPMASK >> (k)) & 1); ++rep_)
#ifdef ONLY
#define IN(k) ((k) == ONLY && lo <= (k) && (k) < hi)
#else
#define IN(k) (lo <= (k) && (k) < hi)
#endif
#ifndef DUPSYNC
#define DUPSYNC 0
#endif
#define SEAM(k) do { if (IN((k) + 1)) { xcd_barrier(xbar); if (DUPSYNC) xcd_barrier(xbar); } } while (0)
    bf16_t* BIG = (bf16_t*)(ws + WS_BIG); bf16_t* XB = (bf16_t*)(ws + WS_BIG + BIG_XB);
    if (IN(0)) { REP(0) p0_prologue(a, lds); SEAM(0); }
    if (IN(1)) { pg8::Gemm g{(const bf16_t*)a.out, (const bf16_t*)(ws + WS_WIN0), M, NIN0, 1024}; pg8::StaticOrder S; S.init(M, NIN0, G, bx);
        EpiIn0 E{BIG, (bf16_t*)(ws + WS_BIG + BIG_XBC), (float*)(ws + WS_DTRAW), ssq};
        REP(1) pg8::gemm_phase<EpiIn0, pg8::StaticOrder, true, true>(lds, g, S, E);
        { const int nfull = (M / 256) * (NIN0 / 256) - 5 * G;
          if (G == 256 && nfull > 0 && nfull < G) { if (bx >= nfull) convert_items(a, lds, TI_SET1, TI_SET2A, (bx - nfull) * 8 + (int)(threadIdx.x >> 6), (G - nfull) * 8); }
          else convert_items(a, lds, TI_SET1, TI_SET2A, bx * 8 + (int)(threadIdx.x >> 6), G * 8); }
        SEAM(1); }
    if (IN(2)) { REP(2) for (int u = bx; u < 320; u += G) ssd_unit<false>(a, lds, u);
        if (bx >= 64 && bx < 128) ssd_unit<true>(a, lds, 192 + bx);
        SEAM(2); }
    if (IN(3)) { ssd_pass(a); SEAM(3); }
    if (IN(4)) { for (int u = bx; u < 256; u += G) ssd_unit<true>(a, lds, u); SEAM(4); }
    if (IN(5)) { pg8::Gemm g{BIG, (const bf16_t*)(ws + WS_WOUT0), MP, 1024, 2048}; pg8::StaticOrder S; S.init(MP, 1024, G, bx);
        EpiRes E{a.in[0], a.in[1], a.out, XB, ssq + M};
        pg8::gemm_phase<EpiRes, pg8::StaticOrder, true, true>(lds, g, S, E);
        sample_gemm_res(BIG, (const bf16_t*)(ws + WS_WOUT0), 2048, a.in[1], a.out, XB, ssq + M); SEAM(5); }
    if (IN(6)) { pg8::Gemm g{XB, (const bf16_t*)(ws + WS_WGU0), M, NGU, 1024}; pg8::StaticOrder S; S.init(M, NGU, G, bx);
        EpiGU E{BIG, ssq + M};
        REP(6) pg8::gemm_phase<EpiGU, pg8::StaticOrder, true, true>(lds, g, S, E);
        { const int nfull = (M / 256) * (NGU / 256) - 5 * G;
          if (G == 256 && nfull > 0 && nfull < G) { if (bx >= nfull) convert_items(a, lds, TI_SET2A, TI_SET2, (bx - nfull) * 8 + (int)(threadIdx.x >> 6), (G - nfull) * 8); }
          else convert_items(a, lds, TI_SET2A, TI_SET2, bx * 8 + (int)(threadIdx.x >> 6), G * 8); }
        SEAM(6); }
    if (IN(7)) { pg8::Gemm g{BIG, (const bf16_t*)(ws + WS_WDN0), MP, 1024, FF}; pg8::StaticOrder S; S.init(MP, 1024, G, bx);
        EpiRes E{a.out, a.out + (size_t)MP * 1024, a.out, XB, ssq + 2 * M};
        pg8::gemm_phase<EpiRes, pg8::StaticOrder, true, true>(lds, g, S, E);
        sample_gemm_res(BIG, (const bf16_t*)(ws + WS_WDN0), FF, a.out + (size_t)MP * 1024, a.out, XB, ssq + 2 * M); SEAM(7); }
    if (IN(8)) { pg8::Gemm g{XB, (const bf16_t*)(ws + WS_WIN1), M, NIN1, 1024}; pg8::StaticOrder S; S.init(M, NIN1, G, bx);
        EpiIn1 E{BIG, ssq + 2 * M, a.in[16]};
        REP(8) pg8::gemm_phase<EpiIn1, pg8::StaticOrder, true, true>(lds, g, S, E);
        { const int nfull = (M / 256) * (NIN1 / 256) - 4 * G;
          if (G == 256 && nfull > 0 && nfull < G) { if (bx >= nfull) convert_items(a, lds, TI_SET2, TI_ALL, (bx - nfull) * 8 + (int)(threadIdx.x >> 6), (G - nfull) * 8); }
          else convert_items(a, lds, TI_SET2, TI_ALL, bx * 8 + (int)(threadIdx.x >> 6), G * 8); }
        SEAM(8); }
    if (IN(9)) { REP(9) for (int u = bx; u < 320; u += G) gla_unit<false>(a, lds, u);
        if (bx >= 64 && bx < 128) gla_unit<true>(a, lds, 192 + bx);
        SEAM(9); }
    if (IN(10)) { gla_pass(a); SEAM(10); }
    if (IN(11)) { for (int u = bx; u < 256; u += G) gla_unit<true>(a, lds, u); SEAM(11); }
    if (IN(12)) { pg8::Gemm g{BIG, (const bf16_t*)(ws + WS_WOUT1), MP, 1024, 1024}; pg8::StaticOrder S; S.init(MP, 1024, G, bx);
        EpiRes E{a.out, a.out + (size_t)MP * 1024, a.out, XB, ssq + 3 * M};
        pg8::gemm_phase<EpiRes, pg8::StaticOrder, true, true>(lds, g, S, E);
        sample_gemm_res(BIG, (const bf16_t*)(ws + WS_WOUT1), 1024, a.out + (size_t)MP * 1024, a.out, XB, ssq + 3 * M); SEAM(12); }
    if (IN(13)) { pg8::Gemm g{XB, (const bf16_t*)(ws + WS_WGU1), M, NGU, 1024}; pg8::StaticOrder S; S.init(M, NGU, G, bx);
        EpiGU E{BIG, ssq + 3 * M};
        pg8::gemm_phase<EpiGU, pg8::StaticOrder, true, true>(lds, g, S, E); SEAM(13); }
    if (IN(14)) { pg8::Gemm g{BIG, (const bf16_t*)(ws + WS_WDN1), MP, 1024, FF}; pg8::StaticOrder S; S.init(MP, 1024, G, bx);
        EpiRes E{a.out, a.out + (size_t)MP * 1024, a.out, nullptr, ssq + 4 * M};
        pg8::gemm_phase<EpiRes, pg8::StaticOrder, true, true>(lds, g, S, E);
        sample_gemm_res(BIG, (const bf16_t*)(ws + WS_WDN1), FF, a.out + (size_t)MP * 1024, a.out, nullptr, ssq + 4 * M); SEAM(14); }
    if (IN(15)) { final_norm(a); }
#undef IN
#undef SEAM
}

#ifndef MK_MULTI
#define MK_MULTI 0
#endif
extern "C" void kernel_launch(void* const* d_in, const int* in_sizes, int n_in, void* d_out, int out_size, void* d_ws, size_t ws_size, hipStream_t stream) {
    static int grid = 0;
    if (grid == 0) {
        if (n_in != 24 || ws_size < WS_END) { fprintf(stderr, "kernel_launch: unexpected n_in %d / ws_size %zu (need %zu)\n", n_in, ws_size, (size_t)WS_END); grid = -1; return; }
        int dev = 0, cus = 0, per_cu = 0;
        hipGetDevice(&dev); hipDeviceGetAttribute(&cus, hipDeviceAttributeMultiprocessorCount, dev);
        if (hipFuncSetAttribute((const void*)mk_fwd, hipFuncAttributeMaxDynamicSharedMemorySize, LDS_BYTES) != hipSuccess) { fprintf(stderr, "kernel_launch: hipFuncSetAttribute failed\n"); grid = -1; return; }
        if (hipOccupancyMaxActiveBlocksPerMultiprocessor(&per_cu, (const void*)mk_fwd, 512, LDS_BYTES) != hipSuccess || per_cu < 1) { fprintf(stderr, "kernel_launch: occupancy query says %d\n", per_cu); per_cu = 1; }
        (void)hipGetLastError();
        grid = cus * 1;
        fprintf(stderr, "kernel_launch: grid %d (cus %d, per_cu %d)\n", grid, cus, per_cu);
    }
    if (grid < 0) return;
    Args a{};
    for (int i = 0; i < 24; ++i) a.in[i] = (const float*)d_in[i];
    a.out = (float*)d_out; a.ws = (unsigned char*)d_ws;
#if MK_MULTI
    for (int ph = 0; ph < NPH; ++ph) { a.ph_lo = ph; a.ph_hi = ph + 1; hipLaunchKernelGGL(mk_fwd, dim3(grid), dim3(512), LDS_BYTES, stream, a); }
#else
    a.ph_lo = 0; a.ph_hi = NPH;
    if (hipMemsetAsync((char*)d_ws + WS_BAR, 0, 65536, stream) != hipSuccess) { fprintf(stderr, "kernel_launch: memset of barrier words failed\n"); return; }
    void* args[] = {&a};
    hipError_t e = hipLaunchCooperativeKernel((const void*)mk_fwd, dim3(grid), dim3(512), args, LDS_BYTES, stream);
    if (e != hipSuccess) fprintf(stderr, "cooperative launch failed: %s (grid %d)\n", hipGetErrorString(e), grid);
#endif
}
```

```cpp
#include <hip/hip_runtime.h>
#include <hip/hip_cooperative_groups.h>
#include <cstdio>
#include <cstdint>
namespace cg = cooperative_groups;
namespace pg8 {
#define PG8_LAS __attribute__((address_space(3)))
typedef unsigned short bf16_t;
typedef short bf16x8 __attribute__((ext_vector_type(8)));
typedef float f32x4 __attribute__((ext_vector_type(4)));
typedef unsigned u32x4 __attribute__((ext_vector_type(4)));
constexpr int BM = 256, BK = 64, HALF = 128, HTB = HALF * BK * 2  , STAGE_BYTES = 8 * HTB, NXCD = 8, WGM = 8;

__host__ __device__ __forceinline__ int lds_byte(int r, int c) { const int st = (r >> 4) * 2 + (c >> 5), rr = r & 15, cc = c & 31, ob = rr * 64 + cc * 2; return st * 1024 + (ob ^ (((ob >> 9) & 1) << 5)); }
__host__ __device__ __forceinline__ void stage_rc(int b, int& R, int& C) { const int st = b / 1024, sb = b % 1024, swz = sb ^ (((sb >> 9) & 1) << 5); R = (st >> 1) * 16 + swz / 64; C = (st & 1) * 32 + (swz % 64) / 2; }
__host__ __device__ __forceinline__ int perm32(int rho) { const int n = rho >> 4, i = rho & 15; return 8 * (i >> 2) + 4 * n + (i & 3); }

struct Unit { int pm, pn; };
struct Gemm { const bf16_t* A; const bf16_t* Bt; int M, N, K; };

struct StaticOrder {
    int nM, nN, nwg, G, c;
    __host__ __device__ void init(int M, int N, int G_, int c_) { nM = M / BM; nN = N / BM; nwg = nM * nN; G = G_; c = c_; }
    __host__ __device__ bool next(int i, Unit& u) const {
        const long L = (long)i * G + c; if (L >= nwg) return false;
        int wgid = (int)L; { const int q = nwg / NXCD, r = nwg % NXCD, xcd = wgid % NXCD, off = wgid / NXCD; wgid = (xcd < r ? xcd * (q + 1) : r * (q + 1) + (xcd - r) * q) + off; }
        const int nig = WGM * nN, gid = wgid / nig, fm = gid * WGM, gsz = (nM - fm) < WGM ? (nM - fm) : WGM;
        u.pm = fm + ((wgid % nig) % gsz); u.pn = (wgid % nig) / gsz; return true;
    }
    __device__ __forceinline__ void a_ready(const Unit&) const {}
    __device__ __forceinline__ void done(const Unit&) const {}
};
__device__ __forceinline__ unsigned cvt_pk_bf16(float lo, float hi) { unsigned r; asm volatile("v_cvt_pk_bf16_f32 %0, %1, %2" : "=v"(r) : "v"(lo), "v"(hi)); return r; }
typedef float f32x2 __attribute__((ext_vector_type(2)));
template <class Epi, class Sched, bool ALIGN_EPI = false, bool SP2 = false>
__device__ __forceinline__ void gemm_phase(PG8_LAS unsigned char* lds, const Gemm g, const Sched& S, const Epi& E) {
    const int tid = threadIdx.x, wid = __builtin_amdgcn_readfirstlane(tid >> 6), lane = tid & 63, wr = wid >> 2, wc = wid & 3, fr = lane & 15, fq = lane >> 4;
    const int K = g.K, nt = K / BK;
    unsigned voffA[2], voffB[2];
#pragma unroll
    for (int i = 0; i < 2; ++i) { int R, C; stage_rc(tid * 16 + i * 8192, R, C); const int Rb = Epi::PERM ? ((R & ~31) + perm32(R & 31)) : R;
        voffA[i] = (unsigned)(R * K + C) * 2u; voffB[i] = (unsigned)(Rb * K + C) * 2u; }
    const size_t kstep = (size_t)(BK * 2);
    const size_t hstep = (size_t)HALF * K * 2;
    const size_t tstep = 2 * hstep;
    const unsigned ldsw = (unsigned)wid * 1024u;
    const int aoff = lds_byte(wr * 64 + fr, fq * 8), boff = lds_byte(wc * 32 + fr, fq * 8);
#define PG8_SA(b, h) (((b) * 2 + (h)) * HTB)
#define PG8_SB(b, h) ((4 + (b) * 2 + (h)) * HTB)
#define PG8_STAGE(bufoff, gbase, voff) do { _Pragma("unroll") for (int _i = 0; _i < 2; ++_i) \
        __builtin_amdgcn_global_load_lds((const unsigned*)((const char*)(gbase) + (voff)[_i]), (PG8_LAS unsigned*)(lds + (bufoff) + ldsw + _i * 8192), 16, 0, 0); } while (0)
#define PG8_LDA(dst, b, h) do { _Pragma("unroll") for (int m = 0; m < 4; ++m) _Pragma("unroll") for (int k = 0; k < 2; ++k) dst[m][k] = *(const PG8_LAS bf16x8*)(lds + PG8_SA(b, h) + aoff + m * 2048 + k * 1024); } while (0)
#define PG8_LDB(dst, b, h) do { _Pragma("unroll") for (int n = 0; n < 2; ++n) _Pragma("unroll") for (int k = 0; k < 2; ++k) dst[n][k] = *(const PG8_LAS bf16x8*)(lds + PG8_SB(b, h) + boff + n * 2048 + k * 1024); } while (0)
#define PG8_MMA(ai, bj, At, Bt) do { __builtin_amdgcn_s_setprio(1); _Pragma("unroll") for (int m = 0; m < 4; ++m) _Pragma("unroll") for (int n = 0; n < 2; ++n) _Pragma("unroll") for (int k = 0; k < 2; ++k) \
        acc[ai][bj][m][n] = __builtin_amdgcn_mfma_f32_16x16x32_bf16(Bt[n][k], At[m][k], acc[ai][bj][m][n], 0, 0, 0); __builtin_amdgcn_s_setprio(0); } while (0)
#define PG8_WAIT_V(n) asm volatile("s_waitcnt vmcnt(" #n ")" ::: "memory")
#define PG8_WAIT_L(n) asm volatile("s_waitcnt lgkmcnt(" #n ")" ::: "memory")
#define PG8_BAR __builtin_amdgcn_s_barrier()
#define PG8_SCHED __builtin_amdgcn_sched_barrier(0)
    Unit cur, nxt; int ui = 0;
    if (!S.next(0, cur)) return;
    f32x4 acc[2][2][4][2];
#pragma unroll
    for (int a = 0; a < 2; ++a)
#pragma unroll
        for (int b = 0; b < 2; ++b)
#pragma unroll
            for (int m = 0; m < 4; ++m)
#pragma unroll
                for (int n = 0; n < 2; ++n) acc[a][b][m][n] = (f32x4){0.f, 0.f, 0.f, 0.f};
    bf16x8 At[4][2], B0[2][2], B1[2][2];
    const char* cA = (const char*)g.A + (size_t)cur.pm * tstep; const char* cB = (const char*)g.Bt + (size_t)cur.pn * tstep;
    S.a_ready(cur);
    if constexpr (SP2) {
        PG8_STAGE(PG8_SB(0, 0), cB, voffB); PG8_STAGE(PG8_SB(0, 1), cB + hstep, voffB); PG8_STAGE(PG8_SA(0, 0), cA, voffA); PG8_STAGE(PG8_SA(0, 1), cA + hstep, voffA);
        if (wr == 1) PG8_BAR;
        PG8_WAIT_V(2); PG8_BAR;
        PG8_STAGE(PG8_SB(1, 0), cB + kstep, voffB); PG8_STAGE(PG8_SA(1, 0), cA + kstep, voffA); PG8_STAGE(PG8_SB(1, 1), cB + hstep + kstep, voffB);
        PG8_WAIT_V(6); PG8_BAR;
    } else {
        PG8_STAGE(PG8_SB(0, 0), cB, voffB); PG8_STAGE(PG8_SA(0, 0), cA, voffA); PG8_STAGE(PG8_SB(0, 1), cB + hstep, voffB); PG8_STAGE(PG8_SA(0, 1), cA + hstep, voffA);
        if (wr == 1) PG8_BAR;
        PG8_WAIT_V(4); PG8_BAR;
        PG8_STAGE(PG8_SB(1, 0), cB + kstep, voffB); PG8_STAGE(PG8_SA(1, 0), cA + kstep, voffA); PG8_STAGE(PG8_SB(1, 1), cB + hstep + kstep, voffB);
        PG8_WAIT_V(6); PG8_BAR;
    }
    for (;;) {
        const bool has_next = S.next(ui + 1, nxt);
        const char* nA = has_next ? (const char*)g.A + (size_t)nxt.pm * tstep : cA; const char* nB = has_next ? (const char*)g.Bt + (size_t)nxt.pn * tstep : cB;
        for (int t = 0; t < nt; t += 2) {
            const bool last = (t == nt - 2);
            const char* a1 = cA + (size_t)(t + 1) * kstep;
            const char* a2 = last ? nA : cA + (size_t)(t + 2) * kstep; const char* b2 = last ? nB : cB + (size_t)(t + 2) * kstep;
            const char* a3 = a2 + kstep; const char* b3 = b2 + kstep;
            if (last && has_next) S.a_ready(nxt);
            if constexpr (SP2) {
            PG8_LDB(B0, 0, 0); PG8_LDB(B1, 0, 1); PG8_SCHED; PG8_LDA(At, 0, 0); PG8_STAGE(PG8_SA(1, 1), a1 + hstep, voffA);
            PG8_WAIT_V(8); PG8_WAIT_L(0); PG8_BAR; PG8_MMA(0, 0, At, B0); PG8_MMA(0, 1, At, B1); PG8_BAR; PG8_SCHED;
            PG8_LDA(At, 0, 1); PG8_STAGE(PG8_SB(0, 0), b2, voffB); PG8_STAGE(PG8_SB(0, 1), b2 + hstep, voffB); PG8_STAGE(PG8_SA(0, 0), a2, voffA);
            PG8_WAIT_V(8); PG8_WAIT_L(0); PG8_BAR; PG8_MMA(1, 0, At, B0); PG8_MMA(1, 1, At, B1); PG8_BAR; PG8_SCHED;
            PG8_LDB(B0, 1, 0); PG8_LDB(B1, 1, 1); PG8_SCHED; PG8_LDA(At, 1, 0); PG8_STAGE(PG8_SA(0, 1), a2 + hstep, voffA);
            PG8_WAIT_V(8); PG8_WAIT_L(0); PG8_BAR; PG8_MMA(0, 0, At, B0); PG8_MMA(0, 1, At, B1); PG8_BAR; PG8_SCHED;
            PG8_LDA(At, 1, 1); PG8_STAGE(PG8_SB(1, 0), b3, voffB); PG8_STAGE(PG8_SB(1, 1), b3 + hstep, voffB); PG8_STAGE(PG8_SA(1, 0), a3, voffA);
            PG8_WAIT_V(8); PG8_WAIT_L(0); PG8_BAR; PG8_MMA(1, 0, At, B0); PG8_MMA(1, 1, At, B1); PG8_BAR; PG8_SCHED;
            } else {
            PG8_LDB(B0, 0, 0); PG8_SCHED; PG8_LDA(At, 0, 0); PG8_STAGE(PG8_SA(1, 1), a1 + hstep, voffA);
            PG8_WAIT_L(8); PG8_BAR; PG8_WAIT_L(0); PG8_MMA(0, 0, At, B0); PG8_BAR; PG8_SCHED;
            PG8_LDB(B1, 0, 1); PG8_STAGE(PG8_SB(0, 0), b2, voffB);
            PG8_BAR; PG8_WAIT_L(0); PG8_MMA(0, 1, At, B1); PG8_BAR;
            PG8_LDA(At, 0, 1); PG8_STAGE(PG8_SA(0, 0), a2, voffA);
            PG8_BAR; PG8_WAIT_L(0); PG8_MMA(1, 0, At, B0); PG8_BAR; PG8_SCHED;
            PG8_STAGE(PG8_SB(0, 1), b2 + hstep, voffB);
            PG8_WAIT_V(6); PG8_BAR; PG8_MMA(1, 1, At, B1); PG8_BAR;
            PG8_LDB(B0, 1, 0); PG8_SCHED; PG8_LDA(At, 1, 0); PG8_STAGE(PG8_SA(0, 1), a2 + hstep, voffA);
            PG8_WAIT_L(8); PG8_BAR; PG8_WAIT_L(0); PG8_MMA(0, 0, At, B0); PG8_BAR; PG8_SCHED;
            PG8_LDB(B1, 1, 1); PG8_STAGE(PG8_SB(1, 0), b3, voffB);
            PG8_BAR; PG8_WAIT_L(0); PG8_MMA(0, 1, At, B1); PG8_BAR;
            PG8_LDA(At, 1, 1); PG8_STAGE(PG8_SA(1, 0), a3, voffA);
            PG8_BAR; PG8_WAIT_L(0); PG8_MMA(1, 0, At, B0); PG8_BAR; PG8_SCHED;
            PG8_STAGE(PG8_SB(1, 1), b3 + hstep, voffB);
            PG8_WAIT_V(6); PG8_BAR; PG8_MMA(1, 1, At, B1); PG8_BAR;
            }
        }
        if constexpr (ALIGN_EPI) { if (wr == 0) PG8_BAR; }
        if constexpr (!Epi::AFTER_DRAIN) { E(acc, cur, wr, wc, fr, fq); S.done(cur); }
        if (!has_next) break;
#pragma unroll
        for (int a = 0; a < 2; ++a)
#pragma unroll
            for (int b = 0; b < 2; ++b)
#pragma unroll
                for (int m = 0; m < 4; ++m)
#pragma unroll
                    for (int n = 0; n < 2; ++n) acc[a][b][m][n] = (f32x4){0.f, 0.f, 0.f, 0.f};
        cur = nxt; cA = nA; cB = nB; ++ui;
        if constexpr (ALIGN_EPI) { if (wr == 1) PG8_BAR; }
    }
    PG8_WAIT_V(0);
    if constexpr (!ALIGN_EPI) { if (wr == 0) PG8_BAR; }
    PG8_BAR;
    if constexpr (Epi::AFTER_DRAIN) { E.fused(acc, cur, wr, wc, fr, fq, lds, wid, lane); S.done(cur); }
#undef PG8_SA
#undef PG8_SB
#undef PG8_STAGE
#undef PG8_LDA
#undef PG8_LDB
#undef PG8_MMA
#undef PG8_WAIT_V
#undef PG8_WAIT_L
#undef PG8_BAR
#undef PG8_SCHED
}
}
#define DI __device__ __forceinline__
#define LAS __attribute__((address_space(3)))
typedef unsigned short bf16_t;
typedef short bf16x8 __attribute__((ext_vector_type(8)));
typedef float f32x4 __attribute__((ext_vector_type(4)));
typedef float f32x16 __attribute__((ext_vector_type(16)));
typedef unsigned u32x4 __attribute__((ext_vector_type(4)));
typedef unsigned u32x2 __attribute__((ext_vector_type(2)));
typedef __bf16 bf16v2 __attribute__((ext_vector_type(2)));
#define MFMA32(a, b, c) __builtin_amdgcn_mfma_f32_32x32x16_bf16((a), (b), (c), 0, 0, 0)

constexpr int MP = 16384, MS = 512, M = MP + MS;
constexpr int NIN0 = 5376, FF = 2816, NGU = 5632, NIN1 = 4096;
constexpr float EPS = 1e-6f;
constexpr int NPH = 16;
constexpr int LDS_BYTES = 155648;

constexpr size_t WS_WIN0 = 0;
constexpr size_t WS_WOUT0 = WS_WIN0 + (size_t)NIN0 * 1024 * 2;
constexpr size_t WS_WGU0 = WS_WOUT0 + (size_t)1024 * 2048 * 2;
constexpr size_t WS_WDN0 = WS_WGU0 + (size_t)NGU * 1024 * 2;
constexpr size_t WS_WIN1 = WS_WDN0 + (size_t)1024 * FF * 2;
constexpr size_t WS_WOUT1 = WS_WIN1 + (size_t)NIN1 * 1024 * 2;
constexpr size_t WS_WGU1 = WS_WOUT1 + (size_t)1024 * 1024 * 2;
constexpr size_t WS_WDN1 = WS_WGU1 + (size_t)NGU * 1024 * 2;
constexpr size_t WS_SSQ = WS_WDN1 + (size_t)1024 * FF * 2;
constexpr size_t WS_DTRAW = WS_SSQ + (size_t)5 * M * 4;
constexpr size_t WS_CDEC = WS_DTRAW + (size_t)M * 32 * 4;
constexpr size_t WS_BIG = WS_CDEC + (size_t)65536 * 4;
constexpr size_t BIG_XBC = (size_t)M * 2048 * 2;
constexpr size_t BIG_XB = (size_t)M * 1024 * 2 * 4;
constexpr size_t WS_BAR = WS_BIG + (size_t)M * 5120 * 2;
constexpr size_t WS_END = WS_BAR + 65536;
constexpr int LDS_MISC = LDS_BYTES - 64;
constexpr size_t O_Y = 0, O_SSDP = (size_t)M * 1024, O_CONVP = O_SSDP + 524288, O_HGP = O_CONVP + 18432, O_SSDS = O_HGP + 262144,
                 O_CONVS = O_SSDS + 4194304, O_HGS = O_CONVS + 147456;

struct Args { const float* in[24]; float* out; unsigned char* ws; int ph_lo, ph_hi; };

DI unsigned pk2(float lo, float hi) { bf16v2 v; v[0] = (__bf16)lo; v[1] = (__bf16)hi; return __builtin_bit_cast(unsigned, v); }
DI float bflo(unsigned u) { return __uint_as_float(u << 16); }
DI float bfhi(unsigned u) { return __uint_as_float(u & 0xffff0000u); }
DI float siluf(float x) { return x * __builtin_amdgcn_rcpf(1.f + __builtin_amdgcn_exp2f(-1.4426950408889634f * x)); }
DI float sigm(float x) { return __builtin_amdgcn_rcpf(1.f + __builtin_amdgcn_exp2f(-1.4426950408889634f * x)); }
DI int crow(int i, int h) { return (i & 3) + 8 * (i >> 2) + 4 * h; }
DI bf16x8 pack8(const f32x16& x, int s) { u32x4 p; p[0] = pk2(x[8 * s], x[8 * s + 1]); p[1] = pk2(x[8 * s + 2], x[8 * s + 3]); p[2] = pk2(x[8 * s + 4], x[8 * s + 5]); p[3] = pk2(x[8 * s + 6], x[8 * s + 7]); return __builtin_bit_cast(bf16x8, p); }
DI void unpack8(const bf16x8& b, f32x16& x, int s) { u32x4 p = __builtin_bit_cast(u32x4, b);
#pragma unroll
    for (int w = 0; w < 4; ++w) { x[8 * s + 2 * w] = bflo(p[w]); x[8 * s + 2 * w + 1] = bfhi(p[w]); } }
DI bf16x8 lds_b128(LAS unsigned char* p) { return *(LAS bf16x8*)p; }
DI bf16x8 lds_2b64(LAS unsigned char* p) { u32x2 a = *(LAS u32x2*)p, b = *(LAS u32x2*)(p + 16); u32x4 r; r[0] = a[0]; r[1] = a[1]; r[2] = b[0]; r[3] = b[1]; return __builtin_bit_cast(bf16x8, r); }
DI f32x16 zero16() { f32x16 z;
#pragma unroll
    for (int i = 0; i < 16; ++i) z[i] = 0.f;
    return z; }
DI float wave_sum(float v) {
#pragma unroll
    for (int o = 1; o < 64; o <<= 1) v += __shfl_xor(v, o);
    return v; }

struct TItem { const float* W; bf16_t* WT; const float* scale; int ld, K, mode, k0, n0; };
constexpr int TI_IN0 = 16 * 161, TI_OUT0 = 32 * 32, TI_G = 16 * 88, TI_DN = 44 * 32, TI_IN1 = 16 * 128, TI_OUT1 = 16 * 32;
constexpr int TI_SET1 = TI_IN0, TI_SET2A = TI_SET1 + TI_OUT0 + 2 * TI_G + TI_DN, TI_SET2 = TI_SET2A + TI_IN1, TI_ALL = TI_SET2 + TI_OUT1 + 2 * TI_G + TI_DN;
static_assert(TI_SET1 % 4 == 0 && TI_SET2A % 4 == 0 && TI_SET2 % 4 == 0 && TI_ALL % 4 == 0, "items go four per trip");
DI TItem p0_decode(const Args& a, int it) {
    unsigned char* ws = a.ws; TItem t; int r = it, nblk;
    if (r < TI_IN0) { t.W = a.in[6]; t.ld = 5152; t.K = 1024; t.WT = (bf16_t*)(ws + WS_WIN0); t.mode = 0; t.scale = a.in[5]; nblk = 161; }
    else { r -= TI_IN0; int layer = 0;
        if (r >= TI_OUT0 + 2 * TI_G + TI_DN) { r -= TI_OUT0 + 2 * TI_G + TI_DN;
            if (r < TI_IN1) { t.W = a.in[15]; t.ld = 4096; t.K = 1024; t.WT = (bf16_t*)(ws + WS_WIN1); t.mode = 0; t.scale = a.in[14]; nblk = 128; layer = -1; }
            else { r -= TI_IN1; layer = 1; } }
        if (layer >= 0) { const size_t woff = (size_t)layer * 1024 * FF; const int i_out = layer ? TI_OUT1 : TI_OUT0;
            if (r < i_out) { t.W = layer ? a.in[18] : a.in[13]; t.ld = 1024; t.K = layer ? 1024 : 2048; t.WT = (bf16_t*)(ws + (layer ? WS_WOUT1 : WS_WOUT0)); t.mode = 0; t.scale = nullptr; nblk = 32; }
            else if ((r -= i_out) < TI_G) { t.W = a.in[20] + woff; t.ld = FF; t.K = 1024; t.WT = (bf16_t*)(ws + (layer ? WS_WGU1 : WS_WGU0)); t.mode = 1; t.scale = a.in[19] + layer * 1024; nblk = 88; }
            else if ((r -= TI_G) < TI_G) { t.W = a.in[21] + woff; t.ld = FF; t.K = 1024; t.WT = (bf16_t*)(ws + (layer ? WS_WGU1 : WS_WGU0)); t.mode = 2; t.scale = a.in[19] + layer * 1024; nblk = 88; }
            else { r -= TI_G; t.W = a.in[22] + woff; t.ld = 1024; t.K = FF; t.WT = (bf16_t*)(ws + (layer ? WS_WDN1 : WS_WDN0)); t.mode = 0; t.scale = nullptr; nblk = 32; } } }
    t.k0 = 64 * (r / nblk); t.n0 = 32 * (r % nblk); return t;
}
DI void p0_load(const TItem& t, float (&v)[32], int lane) {
#pragma unroll
    for (int i = 0; i < 32; ++i) { const int kk = 2 * i + (lane >> 5); v[i] = t.W[(size_t)(t.k0 + kk) * t.ld + t.n0 + (lane & 31)]; }
    if (t.scale) {
#pragma unroll
        for (int i = 0; i < 32; ++i) v[i] *= t.scale[t.k0 + 2 * i + (lane >> 5)]; }
}
DI void p0_store(const TItem& t, const float (&v)[32], LAS float* scr, int lane) {
#pragma unroll
    for (int i = 0; i < 32; ++i) scr[(2 * i + (lane >> 5)) * 33 + (lane & 31)] = v[i];
    asm volatile("s_waitcnt lgkmcnt(0)" ::: "memory");
    const int c = lane & 7;
#pragma unroll
    for (int j = 0; j < 4; ++j) { const int n = (lane >> 3) + 8 * j; const LAS float* s = scr + (8 * c) * 33 + n;
        u32x4 o; o[0] = pk2(s[0 * 33], s[1 * 33]); o[1] = pk2(s[2 * 33], s[3 * 33]); o[2] = pk2(s[4 * 33], s[5 * 33]); o[3] = pk2(s[6 * 33], s[7 * 33]);
        const int nn = t.n0 + n; const int drow = t.mode == 0 ? nn : ((nn >> 7) * 256 + (nn & 127) + (t.mode == 2 ? 128 : 0));
        *(u32x4*)(t.WT + (size_t)drow * t.K + t.k0 + 8 * c) = o; }
    asm volatile("s_waitcnt lgkmcnt(0)" ::: "memory");
}

DI void convert_items(const Args& a, LAS unsigned char* lds, int lo, int hi, int gw, int NGW) {
    const int lane = threadIdx.x & 63, wave = threadIdx.x >> 6;
    LAS float* scr = (LAS float*)(lds + wave * 18432);
    for (int it = lo + 4 * gw; it < hi; it += 4 * NGW) {
        const TItem t0 = p0_decode(a, it), t1 = p0_decode(a, it + 1), t2 = p0_decode(a, it + 2), t3 = p0_decode(a, it + 3);
        float v0[32], v1[32], v2[32], v3[32];
        p0_load(t0, v0, lane); p0_load(t1, v1, lane); p0_load(t2, v2, lane); p0_load(t3, v3, lane);
        p0_store(t0, v0, scr, lane); p0_store(t1, v1, scr + 2112, lane); p0_store(t2, v2, scr, lane); p0_store(t3, v3, scr + 2112, lane);
    }
}
DI void p0_prologue(const Args& a, LAS unsigned char* lds) {
    const int tid = threadIdx.x, lane = tid & 63, wave = tid >> 6;
    const int gw = blockIdx.x * 8 + wave, NGW = gridDim.x * 8;
    unsigned char* ws = a.ws;
    convert_items(a, lds, 0, TI_SET1, gw, NGW);
    { u32x4* z = (u32x4*)(ws + WS_WIN0 + (size_t)5152 * 1024 * 2); const int n16 = 224 * 1024 * 2 / 16;
      for (int i = blockIdx.x * 512 + tid; i < n16; i += gridDim.x * 512) z[i] = (u32x4){0u, 0u, 0u, 0u}; }
    float* ssq = (float*)(ws + WS_SSQ); bf16_t* xb = (bf16_t*)a.out;
    for (int m0 = 4 * gw; m0 < M; m0 += 4 * NGW) {
        f32x4 v[4][4];
#pragma unroll
        for (int q = 0; q < 4; ++q) { const int m = m0 + q; const float* xr = m < MP ? a.in[0] + (size_t)m * 1024 : a.in[1] + (size_t)(m - MP) * 1024;
#pragma unroll
            for (int j = 0; j < 4; ++j) v[q][j] = *((const f32x4*)xr + lane + 64 * j); }
#pragma unroll
        for (int q = 0; q < 4; ++q) { const int m = m0 + q; float s = 0.f;
#pragma unroll
            for (int j = 0; j < 4; ++j) { const f32x4 x = v[q][j]; s += (x[0] * x[0] + x[1] * x[1]) + (x[2] * x[2] + x[3] * x[3]);
                u32x2 w; w[0] = pk2(x[0], x[1]); w[1] = pk2(x[2], x[3]); *((u32x2*)(xb + (size_t)m * 1024) + lane + 64 * j) = w; }
            s = wave_sum(s);
            if (lane == 0) { ssq[m] = s; ssq[M + m] = 0.f; ssq[2 * M + m] = 0.f; ssq[3 * M + m] = 0.f; ssq[4 * M + m] = 0.f; } }
    }
}

struct EpiIn0 { static constexpr bool PERM = true, AFTER_DRAIN = false;
    bf16_t* Z; bf16_t* XBC; float* dtraw; const float* ssq;
    DI void operator()(const f32x4 (&acc)[2][2][4][2], const pg8::Unit& u, int wr, int wc, int fr, int fq) const {
        const int row0 = u.pm * 256 + wr * 64 + fr;
#pragma unroll
        for (int ai = 0; ai < 2; ++ai)
#pragma unroll
            for (int m = 0; m < 4; ++m) { const int row = row0 + ai * 128 + m * 16; const float rs = rsqrtf(ssq[row] * (1.f / 1024.f) + EPS);
                if (u.pn < 20) { bf16_t* base; int ldc, colt; if (u.pn < 8) { base = Z; ldc = 2048; colt = u.pn * 256; } else { base = XBC; ldc = 3072; colt = (u.pn - 8) * 256; }
#pragma unroll
                    for (int bj = 0; bj < 2; ++bj) { const f32x4 v0 = acc[ai][bj][m][0] * rs, v1 = acc[ai][bj][m][1] * rs; u32x4 w; w[0] = pk2(v0[0], v0[1]); w[1] = pk2(v0[2], v0[3]); w[2] = pk2(v1[0], v1[1]); w[3] = pk2(v1[2], v1[3]);
                        *(u32x4*)(base + (size_t)row * ldc + colt + bj * 128 + wc * 32 + 8 * fq) = w; } }
                else if (wc == 0) { float* p = dtraw + (size_t)row * 32 + 8 * fq; *(f32x4*)p = acc[ai][0][m][0] * rs; *(f32x4*)(p + 4) = acc[ai][0][m][1] * rs; } }
    }
};
struct EpiRes { static constexpr bool PERM = false, AFTER_DRAIN = false;
    const float* base0; const float* base1; float* xf; bf16_t* xb; float* ssq_out;
    DI void operator()(const f32x4 (&acc)[2][2][4][2], const pg8::Unit& u, int wr, int wc, int fr, int fq) const {
        const int row0 = u.pm * 256 + wr * 64 + fr, col0 = u.pn * 256 + wc * 32 + 4 * fq;
#pragma unroll
        for (int ai = 0; ai < 2; ++ai)
#pragma unroll
            for (int m = 0; m < 4; ++m) { const int row = row0 + ai * 128 + m * 16; const float* bp = row < MP ? base0 + (size_t)row * 1024 : base1 + (size_t)(row - MP) * 1024; float s = 0.f;
#pragma unroll
                for (int bj = 0; bj < 2; ++bj)
#pragma unroll
                    for (int n = 0; n < 2; ++n) { const int col = col0 + bj * 128 + n * 16; const f32x4 v = *(const f32x4*)(bp + col) + acc[ai][bj][m][n];
                        *(f32x4*)(xf + (size_t)row * 1024 + col) = v; s += (v[0] * v[0] + v[1] * v[1]) + (v[2] * v[2] + v[3] * v[3]);
                        if (xb) { u32x2 w; w[0] = pk2(v[0], v[1]); w[1] = pk2(v[2], v[3]); *(u32x2*)(xb + (size_t)row * 1024 + col) = w; } }
                s += __shfl_xor(s, 16); s += __shfl_xor(s, 32);
                if (fq == 0) atomicAdd(ssq_out + row, s); }
    }
};
struct EpiGU { static constexpr bool PERM = true, AFTER_DRAIN = false;
    bf16_t* H; const float* ssq;
    DI void operator()(const f32x4 (&acc)[2][2][4][2], const pg8::Unit& u, int wr, int wc, int fr, int fq) const {
        const int row0 = u.pm * 256 + wr * 64 + fr, col0 = u.pn * 128 + wc * 32 + 8 * fq;
#pragma unroll
        for (int ai = 0; ai < 2; ++ai)
#pragma unroll
            for (int m = 0; m < 4; ++m) { const int row = row0 + ai * 128 + m * 16; const float rs = rsqrtf(ssq[row] * (1.f / 1024.f) + EPS); float h[8];
#pragma unroll
                for (int n = 0; n < 2; ++n)
#pragma unroll
                    for (int j = 0; j < 4; ++j) { const float g = acc[ai][0][m][n][j] * rs, up = acc[ai][1][m][n][j] * rs; h[4 * n + j] = siluf(g) * up; }
                u32x4 w; w[0] = pk2(h[0], h[1]); w[1] = pk2(h[2], h[3]); w[2] = pk2(h[4], h[5]); w[3] = pk2(h[6], h[7]);
                *(u32x4*)(H + (size_t)row * FF + col0) = w; }
    }
};
struct EpiIn1 { static constexpr bool PERM = true, AFTER_DRAIN = false;
    bf16_t* O4; const float* ssq; const float* lbraw;
    DI void operator()(const f32x4 (&acc)[2][2][4][2], const pg8::Unit& u, int wr, int wc, int fr, int fq) const {
        const int row0 = u.pm * 256 + wr * 64 + fr, type = u.pn >> 2, col0 = (u.pn & 3) * 256 + wc * 32 + 8 * fq;
        bf16_t* base = O4 + (size_t)type * M * 1024; const bool act = (type == 0 || type == 3);
#pragma unroll
        for (int ai = 0; ai < 2; ++ai)
#pragma unroll
            for (int m = 0; m < 4; ++m) { const int row = row0 + ai * 128 + m * 16; const float rs = rsqrtf(ssq[row] * (1.f / 1024.f) + EPS);
#pragma unroll
                for (int bj = 0; bj < 2; ++bj) { f32x4 v0 = acc[ai][bj][m][0] * rs, v1 = acc[ai][bj][m][1] * rs;
                    if (act) {
#pragma unroll
                        for (int j = 0; j < 4; ++j) { v0[j] = siluf(v0[j]); v1[j] = siluf(v1[j]); } }
                    if (type == 1) { const int cc = col0 + bj * 128;
#pragma unroll
                        for (int j = 0; j < 4; ++j) { const float lb0 = sigm(lbraw[1024 + cc + j] - lbraw[cc + j]), lb1 = sigm(lbraw[1024 + cc + 4 + j] - lbraw[cc + 4 + j]);
                            v0[j] = __builtin_amdgcn_logf(lb0 + (1.f - lb0) * sigm(v0[j])); v1[j] = __builtin_amdgcn_logf(lb1 + (1.f - lb1) * sigm(v1[j])); } }
                    u32x4 w; w[0] = pk2(v0[0], v0[1]); w[1] = pk2(v0[2], v0[3]); w[2] = pk2(v1[0], v1[1]); w[3] = pk2(v1[2], v1[3]);
                    *(u32x4*)(base + (size_t)row * 1024 + col0 + bj * 128) = w; } }
    }
};
#define XB_TMO      128
#define XB_XCNT(j)  (256  + 64 * (j))
#define XB_XSUB(j)  (1280 + 64 * (j))
#define XB_XGEN(j)  (2304 + 64 * (j))
#define XB_TOP      3328
#define XB_TOPGEN   3392
#define XCD_BAR_WORDS 3456
#define XB_SPIN_CAP (1u << 18)

__device__ __forceinline__ unsigned xb_ld(unsigned* p)              { return __hip_atomic_load(p, __ATOMIC_RELAXED, __HIP_MEMORY_SCOPE_AGENT); }
__device__ __forceinline__ unsigned xb_add(unsigned* p, unsigned v) { return __hip_atomic_fetch_add(p, v, __ATOMIC_RELAXED, __HIP_MEMORY_SCOPE_AGENT); }
__device__ __forceinline__ unsigned xb_xcc_id() { return (unsigned)__builtin_amdgcn_s_getreg((3 << 11) | 20) & 0xFu; }
#define XB_SPIN(cond, bar) do { unsigned _sp = 0; while (cond) { __builtin_amdgcn_s_sleep(1); \
    if ((++_sp & 255u) == 0u) { if (xb_ld(&(bar)[XB_TMO])) break; if (_sp > XB_SPIN_CAP) { atomicAdd(&(bar)[XB_TMO], 1u); break; } } } } while (0)

struct XcdBarrier {
    unsigned* bar; unsigned x;
    volatile LAS unsigned* st;
};

__device__ __forceinline__ XcdBarrier xcd_barrier_post(unsigned* bar, volatile LAS unsigned* st) {
    XcdBarrier b; b.bar = bar; b.x = xb_xcc_id(); b.st = st;
    if (threadIdx.x == 0) (void)xb_add(&bar[XB_XCNT(b.x)], 1u);
    return b;
}
__device__ __forceinline__ void xcd_barrier_complete(unsigned* bar, unsigned x, unsigned& nloc, unsigned& nx) {
    const unsigned G = gridDim.x * gridDim.y * gridDim.z;
    unsigned sum, cnt, mine, sp = 0u;
    for (;;) {
        sum = 0u; cnt = 0u; mine = 0u;
#pragma unroll
        for (unsigned j = 0; j < 16; ++j) { const unsigned c = xb_ld(&bar[XB_XCNT(j)]); sum += c; cnt += (c > 0u) ? 1u : 0u; mine = (j == x) ? c : mine; }
        if (sum == G) break;
        __builtin_amdgcn_s_sleep(1);
        if ((++sp & 255u) == 0u) { if (xb_ld(&bar[XB_TMO])) break; if (sp > XB_SPIN_CAP) { atomicAdd(&bar[XB_TMO], 1u); break; } }
    }
    nloc = mine > 0u ? mine : 1u; nx = cnt > 0u ? cnt : 1u;
}

__device__ __forceinline__ void xcd_barrier(const XcdBarrier& b) {
    asm volatile("s_waitcnt vmcnt(0)" ::: "memory");
    __syncthreads();
    if (threadIdx.x == 0) {
        unsigned* bar = b.bar;
        __builtin_amdgcn_s_waitcnt(0);
        unsigned nloc = b.st[0], nx = b.st[1];
        if (nloc == 0u) { xcd_barrier_complete(bar, b.x, nloc, nx); b.st[0] = nloc; b.st[1] = nx; }
        const unsigned old = xb_add(&bar[XB_XSUB(b.x)], 1u);
        const unsigned gen = old / nloc;
        if (old + 1u == (gen + 1u) * nloc) {
            __builtin_amdgcn_fence(__ATOMIC_RELEASE, "agent");
            asm volatile("s_waitcnt vmcnt(0)" ::: "memory");
            const unsigned og = xb_add(&bar[XB_TOP], 1u);
            const unsigned tg = og / nx;
            if (og + 1u == (tg + 1u) * nx) xb_add(&bar[XB_TOPGEN], 1u);
            else XB_SPIN(xb_ld(&bar[XB_TOPGEN]) == tg, bar);
            __builtin_amdgcn_fence(__ATOMIC_ACQUIRE, "agent");
            xb_add(&bar[XB_XGEN(b.x)], 1u);
            asm volatile("s_waitcnt vmcnt(0)" ::: "memory");
        } else {
            XB_SPIN(xb_ld(&bar[XB_XGEN(b.x)]) == gen, bar);
            __builtin_amdgcn_fence(__ATOMIC_ACQUIRE, "agent");
            asm volatile("s_waitcnt vmcnt(0)" ::: "memory");
        }
    }
    __syncthreads();
}
constexpr int L_XT = 0, L_BN = 73728, L_CN = 91136, L_BT = 108544, L_SDT = 126976, L_SCUM = 129024, L_SW = 131072, L_RED = 133120, L_GW = 135168;
template <bool OUT> DI void ssd_unit(const Args& a, LAS unsigned char* L, int unit) {
    const int tid = threadIdx.x, lane = tid & 63, wid = tid >> 6, r = lane & 31, h = lane >> 5;
    unsigned char* ws = a.ws;
    bf16_t* Z = (bf16_t*)(ws + WS_BIG); const bf16_t* XBC = (const bf16_t*)(ws + WS_BIG + BIG_XBC);
    const float* dtraw = (const float*)(ws + WS_DTRAW); float* cdec = (float*)(ws + WS_CDEC);
    float* LBUF = a.out;
    const bool prompt = unit < 256;
    int b, sc, g, row_base, nch, len;
    if (prompt) { b = unit >> 7; sc = (unit >> 2) & 31; g = unit & 3; row_base = b * 8192 + sc * 256; nch = 4; len = 64; }
    else { const int u2 = unit - 256; b = u2 >> 2; sc = 0; g = u2 & 3; row_base = MP + b * 32; nch = 1; len = 32; }
    const int hh = wid, head = g * 8 + hh;
    LAS float* SDT = (LAS float*)(L + L_SDT); LAS float* SCUM = (LAS float*)(L + L_SCUM); LAS float* SW = (LAS float*)(L + L_SW); LAS float* RED = (LAS float*)(L + L_RED);
    const float Dh = a.in[11][head];
    bf16x8 stp[4][2][2];
    const float* sprev = prompt ? LBUF + (size_t)((b * 32 + sc) * 32 + head) * 8192 : a.in[2] + (size_t)(b * 32 + head) * 8192;
#pragma unroll
    for (int nt = 0; nt < 4; ++nt)
#pragma unroll
        for (int pt = 0; pt < 2; ++pt) { f32x16 t = zero16();
            if (OUT) {
#pragma unroll
                for (int g4 = 0; g4 < 4; ++g4) { const f32x4 v = *(const f32x4*)(sprev + (32 * pt + r) * 128 + 32 * nt + 8 * g4 + 4 * h); t[4 * g4] = v[0]; t[4 * g4 + 1] = v[1]; t[4 * g4 + 2] = v[2]; t[4 * g4 + 3] = v[3]; } }
            stp[nt][pt][0] = pack8(t, 0); stp[nt][pt][1] = pack8(t, 1); if (pt == 1 && (nt & 1)) __builtin_amdgcn_sched_barrier(0); }
    float dsum = 0.f;
    if (OUT) __syncthreads();
    if (OUT && tid < 128) *(LAS f32x4*)(L + L_GW + tid * 16) = *(const f32x4*)(a.in[12] + g * 512 + tid * 4);
    for (int c = 0; c < nch; ++c) {
        int r_s = r, h_s = h, tid_s = tid; asm volatile("" : "+v"(r_s), "+v"(h_s), "+v"(tid_s));
        const int r = r_s, h = h_s, tid = tid_s;
        const int row0 = row_base + c * 64;
        __syncthreads();
        { const int s = tid >> 3, h8 = tid & 7, hd = g * 8 + h8; float dtv = 0.f;
          if (s < len) { const float xr = dtraw[(size_t)(row0 + s) * 32 + hd] + a.in[9][hd]; dtv = xr > 20.f ? xr : log1pf(__expf(xr)); }
          SDT[s * 8 + h8] = dtv; SCUM[s * 8 + h8] = -dtv * __expf(a.in[10][hd]); }
        __syncthreads();
        if (tid >= 448 && tid < 456) { const int h8 = tid - 448; float run = 0.f;
#pragma unroll 8
            for (int s2 = 0; s2 < 64; ++s2) { run += SCUM[s2 * 8 + h8]; SCUM[s2 * 8 + h8] = run; }
#pragma unroll 8
            for (int s2 = 0; s2 < 64; ++s2) SW[h8 * 64 + s2] = SDT[s2 * 8 + h8] * __expf(run - SCUM[s2 * 8 + h8]); }
        {
            const bool first_chunk = prompt ? (sc == 0 && c == 0) : true;
            const bool last_chunk = prompt ? (sc == 31 && c == 3) : true;
#pragma unroll 1
            for (int it = 0; it < 3; ++it) {
                const int id = tid + 512 * it, cg4 = id % 192, s0 = (id / 192) * 8; int kind, lc, col;
                if (cg4 < 128) { kind = 0; lc = cg4 * 4; col = g * 512 + lc; } else if (cg4 < 160) { kind = 1; lc = (cg4 - 128) * 4; col = 2048 + g * 128 + lc; } else { kind = 2; lc = (cg4 - 160) * 4; col = 2560 + g * 128 + lc; }
                u32x2 raw[11]; f32x4 w[4];
                const bf16_t* rp = XBC + (size_t)(row0 + s0 - 3) * 3072 + col;
#pragma unroll
                for (int i = 0; i < 11; ++i) { const int s = s0 - 3 + i; raw[i] = (u32x2){0u, 0u};
                    if (s >= 0 ? (s < len) : !first_chunk) raw[i] = *(const u32x2*)(rp + (size_t)i * 3072); }
#pragma unroll
                for (int t4 = 0; t4 < 4; ++t4) w[t4] = *(const f32x4*)(a.in[7] + t4 * 3072 + col);
                const f32x4 bias = *(const f32x4*)(a.in[8] + col);
                if (!prompt && s0 == 0) {
#pragma unroll
                    for (int i = 0; i < 3; ++i) { const f32x4 hv = *(const f32x4*)(a.in[3] + (size_t)(b * 3 + i) * 3072 + col); raw[i][0] = pk2(hv[0], hv[1]); raw[i][1] = pk2(hv[2], hv[3]); } }
                float* convout = a.out + (prompt ? O_CONVP : O_CONVS) + (size_t)b * 3 * 3072 + col;
                f32x4 win[3]; unsigned vbp[4][4]; f32x4 vprev = (f32x4){0.f, 0.f, 0.f, 0.f};
#pragma unroll
                for (int i = 0; i < 11; ++i) { const int s = s0 - 3 + i;
                    const f32x4 cur = (f32x4){bflo(raw[i][0]), bfhi(raw[i][0]), bflo(raw[i][1]), bfhi(raw[i][1])};
                    if (i < 3) { win[i] = cur; }
                    else { const int j8 = i - 3;
                        if (!OUT && last_chunk && s >= len - 3 && s < len) *(f32x4*)(convout + (size_t)(s - (len - 3)) * 3072) = cur;
                        f32x4 v = bias + w[0] * win[0] + w[1] * win[1] + w[2] * win[2] + w[3] * cur;
#pragma unroll
                        for (int j = 0; j < 4; ++j) v[j] = (s < len) ? siluf(v[j]) : 0.f;
                        if (kind != 0) { u32x2 o; o[0] = pk2(v[0], v[1]); o[1] = pk2(v[2], v[3]); *(LAS u32x2*)(L + (kind == 1 ? L_BN : L_CN) + (s * 136 + lc) * 2) = o; }
                        if (j8 & 1) {
#pragma unroll
                            for (int j = 0; j < 4; ++j) vbp[j][j8 >> 1] = pk2(vprev[j], v[j]); }
                        else vprev = v;
                        win[0] = win[1]; win[1] = win[2]; win[2] = cur;
                    }
                }
                if (kind != 2) { LAS unsigned char* tb = L + (kind == 0 ? L_XT : L_BT);
#pragma unroll
                    for (int j = 0; j < 4; ++j) { u32x4 o; o[0] = vbp[j][0]; o[1] = vbp[j][1]; o[2] = vbp[j][2]; o[3] = vbp[j][3]; *(LAS u32x4*)(tb + ((lc + j) * 72 + s0) * 2) = o; } }
            }
        }
        __syncthreads();
        const float clast = SCUM[63 * 8 + hh];
        if (OUT) {
#pragma unroll
            for (int tt = 0; tt < 2; ++tt) {
                f32x16 y[2] = {zero16(), zero16()};
                const bool valid = (32 * tt + r) < len; const size_t rowoff = (size_t)(row0 + 32 * tt + r) * 2048 + head * 64;
                u32x2 zpre[2][4];
#pragma unroll
                for (int pt = 0; pt < 2; ++pt)
#pragma unroll
                    for (int g4 = 0; g4 < 4; ++g4) { zpre[pt][g4] = (u32x2){0u, 0u}; if (valid) zpre[pt][g4] = *(const u32x2*)(Z + rowoff + 32 * pt + 8 * g4 + 4 * h); }
#pragma unroll
                for (int nt = 0; nt < 4; ++nt)
#pragma unroll
                    for (int q = 0; q < 2; ++q) { const bf16x8 pb = lds_2b64(L + L_CN + ((32 * tt + r) * 136 + 32 * nt + 16 * q + 4 * h) * 2);
#pragma unroll
                        for (int pt = 0; pt < 2; ++pt) y[pt] = MFMA32(stp[nt][pt][q], pb, y[pt]); }
                const float ct = SCUM[(32 * tt + r) * 8 + hh]; { const float e = __expf(ct); y[0] = y[0] * e; y[1] = y[1] * e; }
#pragma unroll
                for (int st = 0; st <= tt; ++st) {
                    f32x16 gm = zero16();
#pragma unroll
                    for (int ks = 0; ks < 8; ++ks) { const bf16x8 fa = lds_b128(L + L_BN + ((32 * st + r) * 136 + 16 * ks + 8 * h) * 2), fb = lds_b128(L + L_CN + ((32 * tt + r) * 136 + 16 * ks + 8 * h) * 2);
                        gm = MFMA32(fa, fb, gm); }
                    const int t = 32 * tt + r;
#pragma unroll
                    for (int i = 0; i < 16; ++i) { const int s = 32 * st + crow(i, h); const float cs = SCUM[s * 8 + hh], ds = SDT[s * 8 + hh];
                        float val = (s <= t) ? gm[i] * __expf(fminf(ct - cs, 0.f)) * ds : 0.f; if (s == t) val += Dh; gm[i] = val; }
#pragma unroll
                    for (int q = 0; q < 2; ++q) { const bf16x8 xs = pack8(gm, q);
#pragma unroll
                        for (int pt = 0; pt < 2; ++pt) { const bf16x8 pa = lds_2b64(L + L_XT + ((hh * 64 + 32 * pt + r) * 72 + 32 * st + 16 * q + 4 * h) * 2); y[pt] = MFMA32(pa, xs, y[pt]); } }
                }
                float ssum = 0.f;
#pragma unroll
                for (int pt = 0; pt < 2; ++pt)
#pragma unroll
                    for (int g4 = 0; g4 < 4; ++g4) { const u32x2 zz = zpre[pt][g4];
                        y[pt][4 * g4] *= siluf(bflo(zz[0])); y[pt][4 * g4 + 1] *= siluf(bfhi(zz[0])); y[pt][4 * g4 + 2] *= siluf(bflo(zz[1])); y[pt][4 * g4 + 3] *= siluf(bfhi(zz[1]));
#pragma unroll
                        for (int j = 0; j < 4; ++j) { const float v = valid ? y[pt][4 * g4 + j] : 0.f; ssum += v * v; } }
                ssum += __shfl_xor(ssum, 32);
                if (h == 0) RED[hh * 64 + 32 * tt + r] = ssum;
                __syncthreads();
                float tot = 0.f;
#pragma unroll
                for (int w8 = 0; w8 < 8; ++w8) tot += RED[w8 * 64 + 32 * tt + r];
                const float rstd = rsqrtf(tot * (1.f / 512.f) + EPS);
                if (valid) {
#pragma unroll
                    for (int pt = 0; pt < 2; ++pt)
#pragma unroll
                        for (int g4 = 0; g4 < 4; ++g4) { const int p0 = 32 * pt + 8 * g4 + 4 * h; const f32x4 gw = *(LAS f32x4*)(L + L_GW + (hh * 64 + p0) * 4);
                            u32x2 o; o[0] = pk2(y[pt][4 * g4] * rstd * gw[0], y[pt][4 * g4 + 1] * rstd * gw[1]); o[1] = pk2(y[pt][4 * g4 + 2] * rstd * gw[2], y[pt][4 * g4 + 3] * rstd * gw[3]);
                            *(u32x2*)(Z + rowoff + p0) = o; } }
            }
        }
        dsum += clast;
        if (!OUT || c + 1 < nch) {
            const float dec = __expf(clast);
            bf16x8 xs[2][4];
#pragma unroll
            for (int ks = 0; ks < 4; ++ks) { const f32x4 s0 = *(LAS f32x4*)(SW + hh * 64 + 16 * ks + 8 * h), s1 = *(LAS f32x4*)(SW + hh * 64 + 16 * ks + 8 * h + 4);
#pragma unroll
                for (int pt = 0; pt < 2; ++pt) { const u32x4 raw = *(LAS u32x4*)(L + L_XT + ((hh * 64 + 32 * pt + r) * 72 + 16 * ks + 8 * h) * 2);
                    u32x4 o; o[0] = pk2(bflo(raw[0]) * s0[0], bfhi(raw[0]) * s0[1]); o[1] = pk2(bflo(raw[1]) * s0[2], bfhi(raw[1]) * s0[3]); o[2] = pk2(bflo(raw[2]) * s1[0], bfhi(raw[2]) * s1[1]); o[3] = pk2(bflo(raw[3]) * s1[2], bfhi(raw[3]) * s1[3]);
                    xs[pt][ks] = __builtin_bit_cast(bf16x8, o); } }
#pragma unroll
            for (int nt = 0; nt < 4; ++nt) { bf16x8 af[4];
#pragma unroll
                for (int ks = 0; ks < 4; ++ks) af[ks] = lds_b128(L + L_BT + ((32 * nt + r) * 72 + 16 * ks + 8 * h) * 2);
#pragma unroll
                for (int pt = 0; pt < 2; ++pt) { f32x16 t; unpack8(stp[nt][pt][0], t, 0); unpack8(stp[nt][pt][1], t, 1); t = t * dec;
#pragma unroll
                    for (int ks = 0; ks < 4; ++ks) t = MFMA32(af[ks], xs[pt][ks], t);
                    stp[nt][pt][0] = pack8(t, 0); stp[nt][pt][1] = pack8(t, 1); } }
        }
    }
    if (!OUT) {
        const float dect = __expf(dsum);
        int loff = r * 128 + 4 * h; asm volatile("" : "+v"(loff) :: "memory");
        float* dstp = (prompt ? LBUF + (size_t)((b * 32 + sc) * 32 + head) * 8192 : a.out + O_SSDS + (size_t)(b * 32 + head) * 8192) + loff;
        const float* s0p = a.in[2] + (size_t)(prompt ? 0 : (b * 32 + head)) * 8192 + loff;
#pragma unroll
        for (int nt = 0; nt < 4; ++nt)
#pragma unroll
            for (int pt = 0; pt < 2; ++pt) { f32x16 t; unpack8(stp[nt][pt][0], t, 0); unpack8(stp[nt][pt][1], t, 1);
#pragma unroll
                for (int g4 = 0; g4 < 4; ++g4) { const int co = (32 * pt) * 128 + 32 * nt + 8 * g4; f32x4 v = (f32x4){t[4 * g4], t[4 * g4 + 1], t[4 * g4 + 2], t[4 * g4 + 3]};
                    if (!prompt) { const f32x4 s0 = *(const f32x4*)(s0p + co); v = s0 * dect + v; }
                    *(f32x4*)(dstp + co) = v; }
                __builtin_amdgcn_sched_barrier(0); }
        if (prompt && lane == 0) cdec[(b * 32 + sc) * 32 + head] = dect;
    }
}
DI void ssd_pass(const Args& a) {
    float* LBUF = a.out; const float* cdec = (const float*)(a.ws + WS_CDEC);
    for (int item = blockIdx.x * 512 + threadIdx.x; item < 131072; item += gridDim.x * 512) { const int b = item >> 16, head = (item >> 11) & 31, e4 = item & 2047;
        float* base = LBUF + (size_t)(b * 32 * 32 + head) * 8192 + e4 * 4; f32x4 run = (f32x4){0.f, 0.f, 0.f, 0.f};
#pragma unroll 1
        for (int sc0 = 0; sc0 < 32; sc0 += 8) { f32x4 l[8]; float dc[8];
#pragma unroll
            for (int j = 0; j < 8; ++j) { l[j] = *(const f32x4*)(base + (size_t)(sc0 + j) * 32 * 8192); dc[j] = cdec[(b * 32 + sc0 + j) * 32 + head]; }
#pragma unroll
            for (int j = 0; j < 8; ++j) { *(f32x4*)(base + (size_t)(sc0 + j) * 32 * 8192) = run; run = run * dc[j] + l[j]; } }
        *(f32x4*)(a.out + O_SSDP + (size_t)(b * 32 + head) * 8192 + e4 * 4) = run; }
}

constexpr int G_QE = 0, G_KE = 17408, G_KDT = 34816, G_VT = 53248, G_HEAD = 71680, G_SDEC = 143360, G_RED = 144384, G_HT = 146432;
template <bool OUT> DI void gla_unit(const Args& a, LAS unsigned char* L, int unit) {
    const int tid = threadIdx.x, lane = tid & 63, wid = tid >> 6, r = lane & 31, h = lane >> 5;
    unsigned char* ws = a.ws;
    bf16_t* QS = (bf16_t*)(ws + WS_BIG); const bf16_t* FR = QS + (size_t)M * 1024; const bf16_t* VV = QS + (size_t)2 * M * 1024; const bf16_t* GS = QS + (size_t)3 * M * 1024;
    float* LBUF = (float*)(ws + WS_BIG + BIG_XB); float* cdec = (float*)(ws + WS_CDEC);
    const bool prompt = unit < 256;
    int b, sc, pr, row_base, nch, len;
    if (prompt) { b = unit >> 7; sc = (unit >> 2) & 31; pr = unit & 3; row_base = b * 8192 + sc * 256; nch = 4; len = 64; }
    else { const int u2 = unit - 256; b = u2 >> 2; sc = 0; pr = u2 & 3; row_base = MP + b * 32; nch = 1; len = 32; }
    const int hl = wid >> 2, vt = wid & 3, head = pr * 2 + hl;
    LAS unsigned char* LH = L + hl * G_HEAD;
    LAS float* SDEC = (LAS float*)(L + G_SDEC) + hl * 128; LAS float* RED = (LAS float*)(L + G_RED);
    const int phl = tid >> 8, ptt = tid & 255, phead = pr * 2 + phl; LAS unsigned char* PH = L + phl * G_HEAD;
    float bsum0 = 0.f, bsum1 = 0.f;
    bf16x8 stp[4][2];
    const float* sprev = prompt ? LBUF + (size_t)((b * 32 + sc) * 8 + head) * 16384 : a.in[4] + (size_t)(b * 8 + head) * 16384;
#pragma unroll
    for (int kt = 0; kt < 4; ++kt) { f32x16 t = zero16();
        if (OUT) {
#pragma unroll
            for (int i = 0; i < 16; ++i) t[i] = sprev[(32 * kt + crow(i, h)) * 128 + 32 * vt + r]; }
        stp[kt][0] = pack8(t, 0); stp[kt][1] = pack8(t, 1); }
    for (int c = 0; c < nch; ++c) {
        const int row0 = row_base + c * 64;
        __syncthreads();
        {
            const int cp = ptt & 63, rq = ptt >> 6, kc = 2 * cp; const size_t cb = (size_t)(row0 + 16 * rq) * 1024 + phead * 128 + kc;
            LAS float* HT = (LAS float*)(L + G_HT) + phl * 512;
            unsigned rf[16], rv[16], rqs[16];
#pragma unroll
            for (int j = 0; j < 16; ++j) { const bool ok = (16 * rq + j) < len; rf[j] = 0u; rv[j] = 0u; rqs[j] = 0u;
                if (ok) { rf[j] = *(const unsigned*)(FR + cb + (size_t)j * 1024); rv[j] = *(const unsigned*)(VV + cb + (size_t)j * 1024); rqs[j] = *(const unsigned*)(QS + cb + (size_t)j * 1024); } }
            float b0[16], b1[16]; float c0 = 0.f, c1 = 0.f;
#pragma unroll
            for (int j = 0; j < 16; ++j) { c0 += bflo(rf[j]); c1 += bfhi(rf[j]); b0[j] = c0; b1[j] = c1; }
            HT[rq * 128 + kc] = c0; HT[rq * 128 + kc + 1] = c1;
#pragma unroll
            for (int hf = 0; hf < 2; ++hf) { u32x4 o0, o1;
#pragma unroll
                for (int w2 = 0; w2 < 4; ++w2) { const unsigned x0 = rv[8 * hf + 2 * w2], x1 = rv[8 * hf + 2 * w2 + 1]; o0[w2] = (x0 & 0xffffu) | (x1 << 16); o1[w2] = (x0 >> 16) | (x1 & 0xffff0000u); }
                *(LAS u32x4*)(PH + G_VT + (kc * 72 + 16 * rq + 8 * hf) * 2) = o0; *(LAS u32x4*)(PH + G_VT + ((kc + 1) * 72 + 16 * rq + 8 * hf) * 2) = o1; }
            __syncthreads();
            float off0 = 0.f, off1 = 0.f, bl0 = 0.f, bl1 = 0.f;
#pragma unroll
            for (int q4 = 0; q4 < 4; ++q4) { const float t0 = HT[q4 * 128 + kc], t1 = HT[q4 * 128 + kc + 1]; bl0 += t0; bl1 += t1; if (q4 < rq) { off0 += t0; off1 += t1; } }
            const float ebl0 = __builtin_amdgcn_exp2f(bl0), ebl1 = __builtin_amdgcn_exp2f(bl1);
            if (rq == 0) { bsum0 += bl0; bsum1 += bl1; ((LAS float*)(L + G_SDEC))[phl * 128 + kc] = ebl0; ((LAS float*)(L + G_SDEC))[phl * 128 + kc + 1] = ebl1; }
#pragma unroll
            for (int hf = 0; hf < 2; ++hf) { u32x4 o0, o1; float kd0[8], kd1[8];
#pragma unroll
                for (int j = 0; j < 8; ++j) { const int jj = 8 * hf + j, s = 16 * rq + jj; const bool ok = s < len;
                    const float k0 = ok ? 1.f - __builtin_amdgcn_exp2f(bflo(rf[jj])) : 0.f, k1 = ok ? 1.f - __builtin_amdgcn_exp2f(bfhi(rf[jj])) : 0.f;
                    const float e0 = __builtin_amdgcn_exp2f(b0[jj] + off0), e1 = __builtin_amdgcn_exp2f(b1[jj] + off1), r0 = __builtin_amdgcn_rcpf(e0), r1 = __builtin_amdgcn_rcpf(e1);
                    const float ke0 = k0 * r0, ke1 = k1 * r1; kd0[j] = ke0 * ebl0; kd1[j] = ke1 * ebl1;
                    *(LAS unsigned*)(PH + G_QE + (s * 136 + kc) * 2) = pk2(bflo(rqs[jj]) * e0, bfhi(rqs[jj]) * e1); *(LAS unsigned*)(PH + G_KE + (s * 136 + kc) * 2) = pk2(ke0, ke1); }
                o0[0] = pk2(kd0[0], kd0[1]); o0[1] = pk2(kd0[2], kd0[3]); o0[2] = pk2(kd0[4], kd0[5]); o0[3] = pk2(kd0[6], kd0[7]);
                o1[0] = pk2(kd1[0], kd1[1]); o1[1] = pk2(kd1[2], kd1[3]); o1[2] = pk2(kd1[4], kd1[5]); o1[3] = pk2(kd1[6], kd1[7]);
                *(LAS u32x4*)(PH + G_KDT + (kc * 72 + 16 * rq + 8 * hf) * 2) = o0; *(LAS u32x4*)(PH + G_KDT + ((kc + 1) * 72 + 16 * rq + 8 * hf) * 2) = o1; }
        }
        __syncthreads();
        if (OUT) {
            f32x16 o[2] = {zero16(), zero16()};
            u32x2 gpre[2][4]; f32x4 gwv[4];
#pragma unroll
            for (int g4 = 0; g4 < 4; ++g4) { gwv[g4] = *(const f32x4*)(a.in[17] + 32 * vt + 8 * g4 + 4 * h);
#pragma unroll
                for (int tt = 0; tt < 2; ++tt) { gpre[tt][g4] = (u32x2){0u, 0u}; if ((32 * tt + r) < len) gpre[tt][g4] = *(const u32x2*)(GS + (size_t)(row0 + 32 * tt + r) * 1024 + head * 128 + 32 * vt + 8 * g4 + 4 * h); } }
#pragma unroll
            for (int kt = 0; kt < 4; ++kt)
#pragma unroll
                for (int q = 0; q < 2; ++q)
#pragma unroll
                    for (int tt = 0; tt < 2; ++tt) { const bf16x8 pb = lds_2b64(LH + G_QE + ((32 * tt + r) * 136 + 32 * kt + 16 * q + 4 * h) * 2); o[tt] = MFMA32(stp[kt][q], pb, o[tt]); }
#pragma unroll
            for (int cmb = 0; cmb < 3; ++cmb) { const int st = cmb >> 1, tt = (cmb + 1) >> 1;
                f32x16 gm = zero16();
#pragma unroll
                for (int ks = 0; ks < 8; ++ks) { const bf16x8 fa = lds_b128(LH + G_KE + ((32 * st + r) * 136 + 16 * ks + 8 * h) * 2), fb = lds_b128(LH + G_QE + ((32 * tt + r) * 136 + 16 * ks + 8 * h) * 2);
                    gm = MFMA32(fa, fb, gm); }
                const int t = 32 * tt + r;
#pragma unroll
                for (int i = 0; i < 16; ++i) { const int s = 32 * st + crow(i, h); gm[i] = (s <= t) ? gm[i] : 0.f; }
#pragma unroll
                for (int q = 0; q < 2; ++q) { const bf16x8 xs = pack8(gm, q); const bf16x8 pa = lds_2b64(LH + G_VT + ((32 * vt + r) * 72 + 32 * st + 16 * q + 4 * h) * 2); o[tt] = MFMA32(pa, xs, o[tt]); }
            }
#pragma unroll
            for (int tt = 0; tt < 2; ++tt) { float ss = 0.f;
#pragma unroll
                for (int i = 0; i < 16; ++i) ss += o[tt][i] * o[tt][i];
                ss += __shfl_xor(ss, 32); if (h == 0) RED[wid * 64 + 32 * tt + r] = ss; }
            __syncthreads();
#pragma unroll
            for (int tt = 0; tt < 2; ++tt) { const bool valid = (32 * tt + r) < len; float tot = 0.f;
#pragma unroll
                for (int w4 = 0; w4 < 4; ++w4) tot += RED[(hl * 4 + w4) * 64 + 32 * tt + r];
                const float rstd = rsqrtf(tot * (1.f / 128.f) + EPS); const size_t rowoff = (size_t)(row0 + 32 * tt + r) * 1024 + head * 128;
                if (valid) {
#pragma unroll
                    for (int g4 = 0; g4 < 4; ++g4) { const int v0 = 32 * vt + 8 * g4 + 4 * h; const f32x4 gw = gwv[g4]; const u32x2 gg = gpre[tt][g4];
                        u32x2 w; w[0] = pk2(o[tt][4 * g4] * rstd * gw[0] * bflo(gg[0]), o[tt][4 * g4 + 1] * rstd * gw[1] * bfhi(gg[0])); w[1] = pk2(o[tt][4 * g4 + 2] * rstd * gw[2] * bflo(gg[1]), o[tt][4 * g4 + 3] * rstd * gw[3] * bfhi(gg[1]));
                        *(u32x2*)(QS + rowoff + v0) = w; } } }
        }
        if (!OUT || c + 1 < nch) {
#pragma unroll
            for (int kt = 0; kt < 4; ++kt) { f32x16 t; unpack8(stp[kt][0], t, 0); unpack8(stp[kt][1], t, 1);
#pragma unroll
                for (int i = 0; i < 16; ++i) t[i] *= SDEC[32 * kt + crow(i, h)];
#pragma unroll
                for (int ks = 0; ks < 4; ++ks) { const bf16x8 fa = lds_b128(LH + G_KDT + ((32 * kt + r) * 72 + 16 * ks + 8 * h) * 2), fb = lds_b128(LH + G_VT + ((32 * vt + r) * 72 + 16 * ks + 8 * h) * 2); t = MFMA32(fa, fb, t); }
                stp[kt][0] = pack8(t, 0); stp[kt][1] = pack8(t, 1); }
        }
    }
    if (!OUT) {
#pragma unroll
        for (int kt = 0; kt < 4; ++kt) { f32x16 t; unpack8(stp[kt][0], t, 0); unpack8(stp[kt][1], t, 1);
#pragma unroll
            for (int i = 0; i < 16; ++i) { const int k = 32 * kt + crow(i, h); const size_t off = (size_t)k * 128 + 32 * vt + r;
                if (prompt) LBUF[(size_t)((b * 32 + sc) * 8 + head) * 16384 + off] = t[i];
                else a.out[O_HGS + (size_t)(b * 8 + head) * 16384 + off] = SDEC[k] * a.in[4][(size_t)(b * 8 + head) * 16384 + off] + t[i]; } }
        if (prompt && ptt < 64) { cdec[((b * 32 + sc) * 8 + phead) * 128 + 2 * ptt] = __builtin_amdgcn_exp2f(bsum0); cdec[((b * 32 + sc) * 8 + phead) * 128 + 2 * ptt + 1] = __builtin_amdgcn_exp2f(bsum1); }
    }
}
DI void gla_pass(const Args& a) {
    float* LBUF = (float*)(a.ws + WS_BIG + BIG_XB); const float* cdec = (const float*)(a.ws + WS_CDEC);
    for (int item = blockIdx.x * 512 + threadIdx.x; item < 65536; item += gridDim.x * 512) { const int b = item >> 15, head = (item >> 12) & 7, e4 = item & 4095, k = e4 >> 5;
        float* base = LBUF + (size_t)(b * 32 * 8 + head) * 16384 + e4 * 4; f32x4 run = (f32x4){0.f, 0.f, 0.f, 0.f};
#pragma unroll 1
        for (int sc0 = 0; sc0 < 32; sc0 += 8) { f32x4 l[8]; float dc[8];
#pragma unroll
            for (int j = 0; j < 8; ++j) { l[j] = *(const f32x4*)(base + (size_t)(sc0 + j) * 8 * 16384); dc[j] = cdec[((b * 32 + sc0 + j) * 8 + head) * 128 + k]; }
#pragma unroll
            for (int j = 0; j < 8; ++j) { *(f32x4*)(base + (size_t)(sc0 + j) * 8 * 16384) = run; run = run * dc[j] + l[j]; } }
        *(f32x4*)(a.out + O_HGP + (size_t)(b * 8 + head) * 16384 + e4 * 4) = run; }
}
DI void final_norm(const Args& a) {
    const int lane = threadIdx.x & 63, gw = blockIdx.x * 8 + (threadIdx.x >> 6), NGW = gridDim.x * 8; const float* ssq = (const float*)(a.ws + WS_SSQ) + 4 * (size_t)M;
    for (int m = gw; m < M; m += NGW) { const float rs = rsqrtf(ssq[m] * (1.f / 1024.f) + EPS); f32x4* row = (f32x4*)(a.out + (size_t)m * 1024);
#pragma unroll
        for (int j = 0; j < 4; ++j) { const f32x4 w = *((const f32x4*)a.in[23] + lane + 64 * j); row[lane + 64 * j] = row[lane + 64 * j] * rs * w; } }
}


DI void sample_gemm_res(const bf16_t* A, const bf16_t* Bt, int K, const float* base, float* xf, bf16_t* xb, float* ssq_out) {
    const int lane = threadIdx.x & 63, wid = threadIdx.x >> 6, c16 = lane & 15, q = lane >> 4;
    for (int tile = blockIdx.x * 8 + wid; tile < 2048; tile += gridDim.x * 8) { const int rt = tile >> 6, ct = tile & 63;
        const bf16_t* ap = A + (size_t)(MP + rt * 16 + c16) * K + 8 * q; const bf16_t* bp = Bt + (size_t)(ct * 16 + c16) * K + 8 * q;
        f32x4 acc0 = (f32x4){0.f, 0.f, 0.f, 0.f}, acc1 = acc0;
#pragma unroll 8
        for (int k = 0; k < K; k += 64) { const bf16x8 a0 = *(const bf16x8*)(ap + k), b0 = *(const bf16x8*)(bp + k), a1 = *(const bf16x8*)(ap + k + 32), b1 = *(const bf16x8*)(bp + k + 32);
            acc0 = __builtin_amdgcn_mfma_f32_16x16x32_bf16(a0, b0, acc0, 0, 0, 0); acc1 = __builtin_amdgcn_mfma_f32_16x16x32_bf16(a1, b1, acc1, 0, 0, 0); }
        const f32x4 acc = acc0 + acc1; const int col = ct * 16 + c16;
#pragma unroll
        for (int i = 0; i < 4; ++i) { const int rl = rt * 16 + 4 * q + i; const size_t o = (size_t)(MP + rl) * 1024 + col; const float v = base[(size_t)rl * 1024 + col] + acc[i];
            xf[o] = v; if (xb) xb[o] = (bf16_t)(pk2(v, 0.f) & 0xffffu);
            float s = v * v; s += __shfl_xor(s, 1); s += __shfl_xor(s, 2); s += __shfl_xor(s, 4); s += __shfl_xor(s, 8);
            if (c16 == 0) atomicAdd(ssq_out + MP + rl, s); } }
}
__global__ void __launch_bounds__(512, 2) mk_fwd(Args a) {
    extern __shared__ __attribute__((aligned(16))) unsigned char lds_raw[];
    LAS unsigned char* lds = (LAS unsigned char*)lds_raw;
    unsigned char* ws = a.ws; float* ssq = (float*)(ws + WS_SSQ);
    if (threadIdx.x < 16) ((LAS unsigned*)(lds + LDS_MISC))[threadIdx.x] = 0u;
    __syncthreads();
    XcdBarrier xbar; xbar.bar = (unsigned*)(ws + WS_BAR); xbar.x = 0; xbar.st = nullptr;
    if (a.ph_hi - a.ph_lo > 1) xbar = xcd_barrier_post((unsigned*)(ws + WS_BAR), (volatile LAS unsigned*)(lds + LDS_MISC));
    const int lo = a.ph_lo, hi = a.ph_hi, G = gridDim.x, bx = blockIdx.x;
    if (lo < 0) cg::this_grid().sync();
#ifndef DUPMASK
#define DUPMASK 0
#endif
#define REP(k) for (int rep_ = 0; rep_ < 1 + ((DUPMASK >> (k)) & 1); ++rep_)
#ifdef ONLY
#define IN(k) ((k) == ONLY && lo <= (k) && (k) < hi)
#else
#define IN(k) (lo <= (k) && (k) < hi)
#endif
#ifndef DUPSYNC
#define DUPSYNC 0
#endif
#define SEAM(k) do { if (IN((k) + 1)) { xcd_barrier(xbar); if (DUPSYNC) xcd_barrier(xbar); } } while (0)
    bf16_t* BIG = (bf16_t*)(ws + WS_BIG); bf16_t* XB = (bf16_t*)(ws + WS_BIG + BIG_XB);
    if (IN(0)) { REP(0) p0_prologue(a, lds); SEAM(0); }
    if (IN(1)) { pg8::Gemm g{(const bf16_t*)a.out, (const bf16_t*)(ws + WS_WIN0), M, NIN0, 1024}; pg8::StaticOrder S; S.init(M, NIN0, G, bx);
        EpiIn0 E{BIG, (bf16_t*)(ws + WS_BIG + BIG_XBC), (float*)(ws + WS_DTRAW), ssq};
        REP(1) pg8::gemm_phase<EpiIn0, pg8::StaticOrder, true, true>(lds, g, S, E);
        { const int nfull = (M / 256) * (NIN0 / 256) - 5 * G;
          if (G == 256 && nfull > 0 && nfull < G) { if (bx >= nfull) convert_items(a, lds, TI_SET1, TI_SET2A, (bx - nfull) * 8 + (int)(threadIdx.x >> 6), (G - nfull) * 8); }
          else convert_items(a, lds, TI_SET1, TI_SET2A, bx * 8 + (int)(threadIdx.x >> 6), G * 8); }
        SEAM(1); }
    if (IN(2)) { REP(2) for (int u = bx; u < 320; u += G) ssd_unit<false>(a, lds, u);
        if (bx >= 64 && bx < 128) ssd_unit<true>(a, lds, 192 + bx);
        SEAM(2); }
    if (IN(3)) { ssd_pass(a); SEAM(3); }
    if (IN(4)) { for (int u = bx; u < 256; u += G) ssd_unit<true>(a, lds, u); SEAM(4); }
    if (IN(5)) { pg8::Gemm g{BIG, (const bf16_t*)(ws + WS_WOUT0), MP, 1024, 2048}; pg8::StaticOrder S; S.init(MP, 1024, G, bx);
        EpiRes E{a.in[0], a.in[1], a.out, XB, ssq + M};
        pg8::gemm_phase<EpiRes, pg8::StaticOrder, true, true>(lds, g, S, E);
        sample_gemm_res(BIG, (const bf16_t*)(ws + WS_WOUT0), 2048, a.in[1], a.out, XB, ssq + M); SEAM(5); }
    if (IN(6)) { pg8::Gemm g{XB, (const bf16_t*)(ws + WS_WGU0), M, NGU, 1024}; pg8::StaticOrder S; S.init(M, NGU, G, bx);
        EpiGU E{BIG, ssq + M};
        REP(6) pg8::gemm_phase<EpiGU, pg8::StaticOrder, true, true>(lds, g, S, E);
        { const int nfull = (M / 256) * (NGU / 256) - 5 * G;
          if (G == 256 && nfull > 0 && nfull < G) { if (bx >= nfull) convert_items(a, lds, TI_SET2A, TI_SET2, (bx - nfull) * 8 + (int)(threadIdx.x >> 6), (G - nfull) * 8); }
          else convert_items(a, lds, TI_SET2A, TI_SET2, bx * 8 + (int)(threadIdx.x >> 6), G * 8); }
        SEAM(6); }
    if (IN(7)) { pg8::Gemm g{BIG, (const bf16_t*)(ws + WS_WDN0), MP, 1024, FF}; pg8::StaticOrder S; S.init(MP, 1024, G, bx);
        EpiRes E{a.out, a.out + (size_t)MP * 1024, a.out, XB, ssq + 2 * M};
        pg8::gemm_phase<EpiRes, pg8::StaticOrder, true, true>(lds, g, S, E);
        sample_gemm_res(BIG, (const bf16_t*)(ws + WS_WDN0), FF, a.out + (size_t)MP * 1024, a.out, XB, ssq + 2 * M); SEAM(7); }
    if (IN(8)) { pg8::Gemm g{XB, (const bf16_t*)(ws + WS_WIN1), M, NIN1, 1024}; pg8::StaticOrder S; S.init(M, NIN1, G, bx);
        EpiIn1 E{BIG, ssq + 2 * M, a.in[16]};
        REP(8) pg8::gemm_phase<EpiIn1, pg8::StaticOrder, true, true>(lds, g, S, E);
        { const int nfull = (M / 256) * (NIN1 / 256) - 4 * G;
          if (G == 256 && nfull > 0 && nfull < G) { if (bx >= nfull) convert_items(a, lds, TI_SET2, TI_ALL, (bx - nfull) * 8 + (int)(threadIdx.x >> 6), (G - nfull) * 8); }
          else convert_items(a, lds, TI_SET2, TI_ALL, bx * 8 + (int)(threadIdx.x >> 6), G * 8); }
        SEAM(8); }
    if (IN(9)) { REP(9) for (int u = bx; u < 320; u += G) gla_unit<false>(a, lds, u);
        if (bx >= 64 && bx < 128) gla_unit<true>(a, lds, 192 + bx);
        SEAM(9); }
    if (IN(10)) { gla_pass(a); SEAM(10); }
    if (IN(11)) { for (int u = bx; u < 256; u += G) gla_unit<true>(a, lds, u); SEAM(11); }
    if (IN(12)) { pg8::Gemm g{BIG, (const bf16_t*)(ws + WS_WOUT1), MP, 1024, 1024}; pg8::StaticOrder S; S.init(MP, 1024, G, bx);
        EpiRes E{a.out, a.out + (size_t)MP * 1024, a.out, XB, ssq + 3 * M};
        pg8::gemm_phase<EpiRes, pg8::StaticOrder, true, true>(lds, g, S, E);
        sample_gemm_res(BIG, (const bf16_t*)(ws + WS_WOUT1), 1024, a.out + (size_t)MP * 1024, a.out, XB, ssq + 3 * M); SEAM(12); }
    if (IN(13)) { pg8::Gemm g{XB, (const bf16_t*)(ws + WS_WGU1), M, NGU, 1024}; pg8::StaticOrder S; S.init(M, NGU, G, bx);
        EpiGU E{BIG, ssq + 3 * M};
        pg8::gemm_phase<EpiGU, pg8::StaticOrder, true, true>(lds, g, S, E); SEAM(13); }
    if (IN(14)) { pg8::Gemm g{BIG, (const bf16_t*)(ws + WS_WDN1), MP, 1024, FF}; pg8::StaticOrder S; S.init(MP, 1024, G, bx);
        EpiRes E{a.out, a.out + (size_t)MP * 1024, a.out, nullptr, ssq + 4 * M};
        pg8::gemm_phase<EpiRes, pg8::StaticOrder, true, true>(lds, g, S, E);
        sample_gemm_res(BIG, (const bf16_t*)(ws + WS_WDN1), FF, a.out + (size_t)MP * 1024, a.out, nullptr, ssq + 4 * M); SEAM(14); }
    if (IN(15)) { final_norm(a); }
#undef IN
#undef SEAM
}

#ifndef MK_MULTI
#define MK_MULTI 0
#endif
extern "C" void kernel_launch(void* const* d_in, const int* in_sizes, int n_in, void* d_out, int out_size, void* d_ws, size_t ws_size, hipStream_t stream) {
    static int grid = 0;
    if (grid == 0) {
        if (n_in != 24 || ws_size < WS_END) { fprintf(stderr, "kernel_launch: unexpected n_in %d / ws_size %zu (need %zu)\n", n_in, ws_size, (size_t)WS_END); grid = -1; return; }
        int dev = 0, cus = 0, per_cu = 0;
        hipGetDevice(&dev); hipDeviceGetAttribute(&cus, hipDeviceAttributeMultiprocessorCount, dev);
        if (hipFuncSetAttribute((const void*)mk_fwd, hipFuncAttributeMaxDynamicSharedMemorySize, LDS_BYTES) != hipSuccess) { fprintf(stderr, "kernel_launch: hipFuncSetAttribute failed\n"); grid = -1; return; }
        if (hipOccupancyMaxActiveBlocksPerMultiprocessor(&per_cu, (const void*)mk_fwd, 512, LDS_BYTES) != hipSuccess || per_cu < 1) { fprintf(stderr, "kernel_launch: occupancy query says %d\n", per_cu); per_cu = 1; }
        (void)hipGetLastError();
        grid = cus * 1;
        fprintf(stderr, "kernel_launch: grid %d (cus %d, per_cu %d)\n", grid, cus, per_cu);
    }
    if (grid < 0) return;
    Args a{};
    for (int i = 0; i < 24; ++i) a.in[i] = (const float*)d_in[i];
    a.out = (float*)d_out; a.ws = (unsigned char*)d_ws;
#if MK_MULTI
    for (int ph = 0; ph < NPH; ++ph) { a.ph_lo = ph; a.ph_hi = ph + 1; hipLaunchKernelGGL(mk_fwd, dim3(grid), dim3(512), LDS_BYTES, stream, a); }
#else
    a.ph_lo = 0; a.ph_hi = NPH;
    if (hipMemsetAsync((char*)d_ws + WS_BAR, 0, 65536, stream) != hipSuccess) { fprintf(stderr, "kernel_launch: memset of barrier words failed\n"); return; }
    void* args[] = {&a};
    hipError_t e = hipLaunchCooperativeKernel((const void*)mk_fwd, dim3(grid), dim3(512), args, LDS_BYTES, stream);
    if (e != hipSuccess) fprintf(stderr, "cooperative launch failed: %s (grid %d)\n", hipGetErrorString(e), grid);
#endif
}
```

```cpp
#include <hip/hip_runtime.h>
#include <hip/hip_cooperative_groups.h>
#include <cstdio>
#include <cstdint>
namespace cg = cooperative_groups;
namespace pg8 {
#define PG8_LAS __attribute__((address_space(3)))
typedef unsigned short bf16_t;
typedef short bf16x8 __attribute__((ext_vector_type(8)));
typedef float f32x4 __attribute__((ext_vector_type(4)));
typedef unsigned u32x4 __attribute__((ext_vector_type(4)));
constexpr int BM = 256, BK = 64, HALF = 128, HTB = HALF * BK * 2  , STAGE_BYTES = 8 * HTB, NXCD = 8, WGM = 8;

__host__ __device__ __forceinline__ int lds_byte(int r, int c) { const int st = (r >> 4) * 2 + (c >> 5), rr = r & 15, cc = c & 31, ob = rr * 64 + cc * 2; return st * 1024 + (ob ^ (((ob >> 9) & 1) << 5)); }
__host__ __device__ __forceinline__ void stage_rc(int b, int& R, int& C) { const int st = b / 1024, sb = b % 1024, swz = sb ^ (((sb >> 9) & 1) << 5); R = (st >> 1) * 16 + swz / 64; C = (st & 1) * 32 + (swz % 64) / 2; }
__host__ __device__ __forceinline__ int perm32(int rho) { const int n = rho >> 4, i = rho & 15; return 8 * (i >> 2) + 4 * n + (i & 3); }

struct Unit { int pm, pn; };
struct Gemm { const bf16_t* A; const bf16_t* Bt; int M, N, K; };

struct StaticOrder {
    int nM, nN, nwg, G, c;
    __host__ __device__ void init(int M, int N, int G_, int c_) { nM = M / BM; nN = N / BM; nwg = nM * nN; G = G_; c = c_; }
    __host__ __device__ bool next(int i, Unit& u) const {
        const long L = (long)i * G + c; if (L >= nwg) return false;
        int wgid = (int)L; { const int q = nwg / NXCD, r = nwg % NXCD, xcd = wgid % NXCD, off = wgid / NXCD; wgid = (xcd < r ? xcd * (q + 1) : r * (q + 1) + (xcd - r) * q) + off; }
        const int nig = WGM * nN, gid = wgid / nig, fm = gid * WGM, gsz = (nM - fm) < WGM ? (nM - fm) : WGM;
        u.pm = fm + ((wgid % nig) % gsz); u.pn = (wgid % nig) / gsz; return true;
    }
    __device__ __forceinline__ void a_ready(const Unit&) const {}
    __device__ __forceinline__ void done(const Unit&) const {}
};
__device__ __forceinline__ unsigned cvt_pk_bf16(float lo, float hi) { unsigned r; asm volatile("v_cvt_pk_bf16_f32 %0, %1, %2" : "=v"(r) : "v"(lo), "v"(hi)); return r; }
typedef float f32x2 __attribute__((ext_vector_type(2)));
template <class Epi, class Sched, bool ALIGN_EPI = false, bool SP2 = false>
__device__ __forceinline__ void gemm_phase(PG8_LAS unsigned char* lds, const Gemm g, const Sched& S, const Epi& E) {
    const int tid = threadIdx.x, wid = __builtin_amdgcn_readfirstlane(tid >> 6), lane = tid & 63, wr = wid >> 2, wc = wid & 3, fr = lane & 15, fq = lane >> 4;
    const int K = g.K, nt = K / BK;
    unsigned voffA[2], voffB[2];
#pragma unroll
    for (int i = 0; i < 2; ++i) { int R, C; stage_rc(tid * 16 + i * 8192, R, C); const int Rb = Epi::PERM ? ((R & ~31) + perm32(R & 31)) : R;
        voffA[i] = (unsigned)(R * K + C) * 2u; voffB[i] = (unsigned)(Rb * K + C) * 2u; }
    const size_t kstep = (size_t)(BK * 2);
    const size_t hstep = (size_t)HALF * K * 2;
    const size_t tstep = 2 * hstep;
    const unsigned ldsw = (unsigned)wid * 1024u;
    const int aoff = lds_byte(wr * 64 + fr, fq * 8), boff = lds_byte(wc * 32 + fr, fq * 8);
#define PG8_SA(b, h) (((b) * 2 + (h)) * HTB)
#define PG8_SB(b, h) ((4 + (b) * 2 + (h)) * HTB)
#define PG8_STAGE(bufoff, gbase, voff) do { _Pragma("unroll") for (int _i = 0; _i < 2; ++_i) \
        __builtin_amdgcn_global_load_lds((const unsigned*)((const char*)(gbase) + (voff)[_i]), (PG8_LAS unsigned*)(lds + (bufoff) + ldsw + _i * 8192), 16, 0, 0); } while (0)
#define PG8_LDA(dst, b, h) do { _Pragma("unroll") for (int m = 0; m < 4; ++m) _Pragma("unroll") for (int k = 0; k < 2; ++k) dst[m][k] = *(const PG8_LAS bf16x8*)(lds + PG8_SA(b, h) + aoff + m * 2048 + k * 1024); } while (0)
#define PG8_LDB(dst, b, h) do { _Pragma("unroll") for (int n = 0; n < 2; ++n) _Pragma("unroll") for (int k = 0; k < 2; ++k) dst[n][k] = *(const PG8_LAS bf16x8*)(lds + PG8_SB(b, h) + boff + n * 2048 + k * 1024); } while (0)
#define PG8_MMA(ai, bj, At, Bt) do { __builtin_amdgcn_s_setprio(1); _Pragma("unroll") for (int m = 0; m < 4; ++m) _Pragma("unroll") for (int n = 0; n < 2; ++n) _Pragma("unroll") for (int k = 0; k < 2; ++k) \
        acc[ai][bj][m][n] = __builtin_amdgcn_mfma_f32_16x16x32_bf16(Bt[n][k], At[m][k], acc[ai][bj][m][n], 0, 0, 0); __builtin_amdgcn_s_setprio(0); } while (0)
#define PG8_WAIT_V(n) asm volatile("s_waitcnt vmcnt(" #n ")" ::: "memory")
#define PG8_WAIT_L(n) asm volatile("s_waitcnt lgkmcnt(" #n ")" ::: "memory")
#define PG8_BAR __builtin_amdgcn_s_barrier()
#define PG8_SCHED __builtin_amdgcn_sched_barrier(0)
    Unit cur, nxt; int ui = 0;
    if (!S.next(0, cur)) return;
    f32x4 acc[2][2][4][2];
#pragma unroll
    for (int a = 0; a < 2; ++a)
#pragma unroll
        for (int b = 0; b < 2; ++b)
#pragma unroll
            for (int m = 0; m < 4; ++m)
#pragma unroll
                for (int n = 0; n < 2; ++n) acc[a][b][m][n] = (f32x4){0.f, 0.f, 0.f, 0.f};
    bf16x8 At[4][2], B0[2][2], B1[2][2];
    const char* cA = (const char*)g.A + (size_t)cur.pm * tstep; const char* cB = (const char*)g.Bt + (size_t)cur.pn * tstep;
    S.a_ready(cur);
    if constexpr (SP2) {
        PG8_STAGE(PG8_SB(0, 0), cB, voffB); PG8_STAGE(PG8_SB(0, 1), cB + hstep, voffB); PG8_STAGE(PG8_SA(0, 0), cA, voffA); PG8_STAGE(PG8_SA(0, 1), cA + hstep, voffA);
        if (wr == 1) PG8_BAR;
        PG8_WAIT_V(2); PG8_BAR;
        PG8_STAGE(PG8_SB(1, 0), cB + kstep, voffB); PG8_STAGE(PG8_SA(1, 0), cA + kstep, voffA); PG8_STAGE(PG8_SB(1, 1), cB + hstep + kstep, voffB);
        PG8_WAIT_V(6); PG8_BAR;
    } else {
        PG8_STAGE(PG8_SB(0, 0), cB, voffB); PG8_STAGE(PG8_SA(0, 0), cA, voffA); PG8_STAGE(PG8_SB(0, 1), cB + hstep, voffB); PG8_STAGE(PG8_SA(0, 1), cA + hstep, voffA);
        if (wr == 1) PG8_BAR;
        PG8_WAIT_V(4); PG8_BAR;
        PG8_STAGE(PG8_SB(1, 0), cB + kstep, voffB); PG8_STAGE(PG8_SA(1, 0), cA + kstep, voffA); PG8_STAGE(PG8_SB(1, 1), cB + hstep + kstep, voffB);
        PG8_WAIT_V(6); PG8_BAR;
    }
    for (;;) {
        const bool has_next = S.next(ui + 1, nxt);
        const char* nA = has_next ? (const char*)g.A + (size_t)nxt.pm * tstep : cA; const char* nB = has_next ? (const char*)g.Bt + (size_t)nxt.pn * tstep : cB;
        for (int t = 0; t < nt; t += 2) {
            const bool last = (t == nt - 2);
            const char* a1 = cA + (size_t)(t + 1) * kstep;
            const char* a2 = last ? nA : cA + (size_t)(t + 2) * kstep; const char* b2 = last ? nB : cB + (size_t)(t + 2) * kstep;
            const char* a3 = a2 + kstep; const char* b3 = b2 + kstep;
            if (last && has_next) S.a_ready(nxt);
            if constexpr (SP2) {
            PG8_LDB(B0, 0, 0); PG8_LDB(B1, 0, 1); PG8_SCHED; PG8_LDA(At, 0, 0); PG8_STAGE(PG8_SA(1, 1), a1 + hstep, voffA);
            PG8_WAIT_V(8); PG8_WAIT_L(0); PG8_BAR; PG8_MMA(0, 0, At, B0); PG8_MMA(0, 1, At, B1); PG8_BAR; PG8_SCHED;
            PG8_LDA(At, 0, 1); PG8_STAGE(PG8_SB(0, 0), b2, voffB); PG8_STAGE(PG8_SB(0, 1), b2 + hstep, voffB); PG8_STAGE(PG8_SA(0, 0), a2, voffA);
            PG8_WAIT_V(8); PG8_WAIT_L(0); PG8_BAR; PG8_MMA(1, 0, At, B0); PG8_MMA(1, 1, At, B1); PG8_BAR; PG8_SCHED;
            PG8_LDB(B0, 1, 0); PG8_LDB(B1, 1, 1); PG8_SCHED; PG8_LDA(At, 1, 0); PG8_STAGE(PG8_SA(0, 1), a2 + hstep, voffA);
            PG8_WAIT_V(8); PG8_WAIT_L(0); PG8_BAR; PG8_MMA(0, 0, At, B0); PG8_MMA(0, 1, At, B1); PG8_BAR; PG8_SCHED;
            PG8_LDA(At, 1, 1); PG8_STAGE(PG8_SB(1, 0), b3, voffB); PG8_STAGE(PG8_SB(1, 1), b3 + hstep, voffB); PG8_STAGE(PG8_SA(1, 0), a3, voffA);
            PG8_WAIT_V(8); PG8_WAIT_L(0); PG8_BAR; PG8_MMA(1, 0, At, B0); PG8_MMA(1, 1, At, B1); PG8_BAR; PG8_SCHED;
            } else {
            PG8_LDB(B0, 0, 0); PG8_SCHED; PG8_LDA(At, 0, 0); PG8_STAGE(PG8_SA(1, 1), a1 + hstep, voffA);
            PG8_WAIT_L(8); PG8_BAR; PG8_WAIT_L(0); PG8_MMA(0, 0, At, B0); PG8_BAR; PG8_SCHED;
            PG8_LDB(B1, 0, 1); PG8_STAGE(PG8_SB(0, 0), b2, voffB);
            PG8_BAR; PG8_WAIT_L(0); PG8_MMA(0, 1, At, B1); PG8_BAR;
            PG8_LDA(At, 0, 1); PG8_STAGE(PG8_SA(0, 0), a2, voffA);
            PG8_BAR; PG8_WAIT_L(0); PG8_MMA(1, 0, At, B0); PG8_BAR; PG8_SCHED;
            PG8_STAGE(PG8_SB(0, 1), b2 + hstep, voffB);
            PG8_WAIT_V(6); PG8_BAR; PG8_MMA(1, 1, At, B1); PG8_BAR;
            PG8_LDB(B0, 1, 0); PG8_SCHED; PG8_LDA(At, 1, 0); PG8_STAGE(PG8_SA(0, 1), a2 + hstep, voffA);
            PG8_WAIT_L(8); PG8_BAR; PG8_WAIT_L(0); PG8_MMA(0, 0, At, B0); PG8_BAR; PG8_SCHED;
            PG8_LDB(B1, 1, 1); PG8_STAGE(PG8_SB(1, 0), b3, voffB);
            PG8_BAR; PG8_WAIT_L(0); PG8_MMA(0, 1, At, B1); PG8_BAR;
            PG8_LDA(At, 1, 1); PG8_STAGE(PG8_SA(1, 0), a3, voffA);
            PG8_BAR; PG8_WAIT_L(0); PG8_MMA(1, 0, At, B0); PG8_BAR; PG8_SCHED;
            PG8_STAGE(PG8_SB(1, 1), b3 + hstep, voffB);
            PG8_WAIT_V(6); PG8_BAR; PG8_MMA(1, 1, At, B1); PG8_BAR;
            }
        }
        if constexpr (ALIGN_EPI) { if (wr == 0) PG8_BAR; }
        if constexpr (!Epi::AFTER_DRAIN) { E(acc, cur, wr, wc, fr, fq); S.done(cur); }
        if (!has_next) break;
#pragma unroll
        for (int a = 0; a < 2; ++a)
#pragma unroll
            for (int b = 0; b < 2; ++b)
#pragma unroll
                for (int m = 0; m < 4; ++m)
#pragma unroll
                    for (int n = 0; n < 2; ++n) acc[a][b][m][n] = (f32x4){0.f, 0.f, 0.f, 0.f};
        cur = nxt; cA = nA; cB = nB; ++ui;
        if constexpr (ALIGN_EPI) { if (wr == 1) PG8_BAR; }
    }
    PG8_WAIT_V(0);
    if constexpr (!ALIGN_EPI) { if (wr == 0) PG8_BAR; }
    PG8_BAR;
    if constexpr (Epi::AFTER_DRAIN) { E.fused(acc, cur, wr, wc, fr, fq, lds, wid, lane); S.done(cur); }
#undef PG8_SA
#undef PG8_SB
#undef PG8_STAGE
#undef PG8_LDA
#undef PG8_LDB
#undef PG8_MMA
#undef PG8_WAIT_V
#undef PG8_WAIT_L
#undef PG8_BAR
#undef PG8_SCHED
}
}
#define DI __device__ __forceinline__
#define LAS __attribute__((address_space(3)))
typedef unsigned short bf16_t;
typedef short bf16x8 __attribute__((ext_vector_type(8)));
typedef float f32x4 __attribute__((ext_vector_type(4)));
typedef float f32x16 __attribute__((ext_vector_type(16)));
typedef unsigned u32x4 __attribute__((ext_vector_type(4)));
typedef unsigned u32x2 __attribute__((ext_vector_type(2)));
typedef __bf16 bf16v2 __attribute__((ext_vector_type(2)));
#define MFMA32(a, b, c) __builtin_amdgcn_mfma_f32_32x32x16_bf16((a), (b), (c), 0, 0, 0)

constexpr int MP = 16384, MS = 512, M = MP + MS;
constexpr int NIN0 = 5376, FF = 2816, NGU = 5632, NIN1 = 4096;
constexpr float EPS = 1e-6f;
constexpr int NPH = 16;
constexpr int LDS_BYTES = 155648;

constexpr size_t WS_WIN0 = 0;
constexpr size_t WS_WOUT0 = WS_WIN0 + (size_t)NIN0 * 1024 * 2;
constexpr size_t WS_WGU0 = WS_WOUT0 + (size_t)1024 * 2048 * 2;
constexpr size_t WS_WDN0 = WS_WGU0 + (size_t)NGU * 1024 * 2;
constexpr size_t WS_WIN1 = WS_WDN0 + (size_t)1024 * FF * 2;
constexpr size_t WS_WOUT1 = WS_WIN1 + (size_t)NIN1 * 1024 * 2;
constexpr size_t WS_WGU1 = WS_WOUT1 + (size_t)1024 * 1024 * 2;
constexpr size_t WS_WDN1 = WS_WGU1 + (size_t)NGU * 1024 * 2;
constexpr size_t WS_SSQ = WS_WDN1 + (size_t)1024 * FF * 2;
constexpr size_t WS_DTRAW = WS_SSQ + (size_t)5 * M * 4;
constexpr size_t WS_CDEC = WS_DTRAW + (size_t)M * 32 * 4;
constexpr size_t WS_BIG = WS_CDEC + (size_t)65536 * 4;
constexpr size_t BIG_XBC = (size_t)M * 2048 * 2;
constexpr size_t BIG_XB = (size_t)M * 1024 * 2 * 4;
constexpr size_t WS_BAR = WS_BIG + (size_t)M * 5120 * 2;
constexpr size_t WS_END = WS_BAR + 65536;
constexpr int LDS_MISC = LDS_BYTES - 64;
constexpr size_t O_Y = 0, O_SSDP = (size_t)M * 1024, O_CONVP = O_SSDP + 524288, O_HGP = O_CONVP + 18432, O_SSDS = O_HGP + 262144,
                 O_CONVS = O_SSDS + 4194304, O_HGS = O_CONVS + 147456;

struct Args { const float* in[24]; float* out; unsigned char* ws; int ph_lo, ph_hi; };

DI unsigned pk2(float lo, float hi) { bf16v2 v; v[0] = (__bf16)lo; v[1] = (__bf16)hi; return __builtin_bit_cast(unsigned, v); }
DI float bflo(unsigned u) { return __uint_as_float(u << 16); }
DI float bfhi(unsigned u) { return __uint_as_float(u & 0xffff0000u); }
DI float siluf(float x) { return x * __builtin_amdgcn_rcpf(1.f + __builtin_amdgcn_exp2f(-1.4426950408889634f * x)); }
DI float sigm(float x) { return __builtin_amdgcn_rcpf(1.f + __builtin_amdgcn_exp2f(-1.4426950408889634f * x)); }
DI int crow(int i, int h) { return (i & 3) + 8 * (i >> 2) + 4 * h; }
DI bf16x8 pack8(const f32x16& x, int s) { u32x4 p; p[0] = pk2(x[8 * s], x[8 * s + 1]); p[1] = pk2(x[8 * s + 2], x[8 * s + 3]); p[2] = pk2(x[8 * s + 4], x[8 * s + 5]); p[3] = pk2(x[8 * s + 6], x[8 * s + 7]); return __builtin_bit_cast(bf16x8, p); }
DI void unpack8(const bf16x8& b, f32x16& x, int s) { u32x4 p = __builtin_bit_cast(u32x4, b);
#pragma unroll
    for (int w = 0; w < 4; ++w) { x[8 * s + 2 * w] = bflo(p[w]); x[8 * s + 2 * w + 1] = bfhi(p[w]); } }
DI bf16x8 lds_b128(LAS unsigned char* p) { return *(LAS bf16x8*)p; }
DI bf16x8 lds_2b64(LAS unsigned char* p) { u32x2 a = *(LAS u32x2*)p, b = *(LAS u32x2*)(p + 16); u32x4 r; r[0] = a[0]; r[1] = a[1]; r[2] = b[0]; r[3] = b[1]; return __builtin_bit_cast(bf16x8, r); }
DI f32x16 zero16() { f32x16 z;
#pragma unroll
    for (int i = 0; i < 16; ++i) z[i] = 0.f;
    return z; }
DI float wave_sum(float v) {
#pragma unroll
    for (int o = 1; o < 64; o <<= 1) v += __shfl_xor(v, o);
    return v; }

struct TItem { const float* W; bf16_t* WT; const float* scale; int ld, K, mode, k0, n0; };
constexpr int TI_IN0 = 16 * 161, TI_OUT0 = 32 * 32, TI_G = 16 * 88, TI_DN = 44 * 32, TI_IN1 = 16 * 128, TI_OUT1 = 16 * 32;
constexpr int TI_SET1 = TI_IN0, TI_SET2A = TI_SET1 + TI_OUT0 + 2 * TI_G + TI_DN, TI_SET2 = TI_SET2A + TI_IN1, TI_ALL = TI_SET2 + TI_OUT1 + 2 * TI_G + TI_DN;
static_assert(TI_SET1 % 4 == 0 && TI_SET2A % 4 == 0 && TI_SET2 % 4 == 0 && TI_ALL % 4 == 0, "items go four per trip");
DI TItem p0_decode(const Args& a, int it) {
    unsigned char* ws = a.ws; TItem t; int r = it, nblk;
    if (r < TI_IN0) { t.W = a.in[6]; t.ld = 5152; t.K = 1024; t.WT = (bf16_t*)(ws + WS_WIN0); t.mode = 0; t.scale = a.in[5]; nblk = 161; }
    else { r -= TI_IN0; int layer = 0;
        if (r >= TI_OUT0 + 2 * TI_G + TI_DN) { r -= TI_OUT0 + 2 * TI_G + TI_DN;
            if (r < TI_IN1) { t.W = a.in[15]; t.ld = 4096; t.K = 1024; t.WT = (bf16_t*)(ws + WS_WIN1); t.mode = 0; t.scale = a.in[14]; nblk = 128; layer = -1; }
            else { r -= TI_IN1; layer = 1; } }
        if (layer >= 0) { const size_t woff = (size_t)layer * 1024 * FF; const int i_out = layer ? TI_OUT1 : TI_OUT0;
            if (r < i_out) { t.W = layer ? a.in[18] : a.in[13]; t.ld = 1024; t.K = layer ? 1024 : 2048; t.WT = (bf16_t*)(ws + (layer ? WS_WOUT1 : WS_WOUT0)); t.mode = 0; t.scale = nullptr; nblk = 32; }
            else if ((r -= i_out) < TI_G) { t.W = a.in[20] + woff; t.ld = FF; t.K = 1024; t.WT = (bf16_t*)(ws + (layer ? WS_WGU1 : WS_WGU0)); t.mode = 1; t.scale = a.in[19] + layer * 1024; nblk = 88; }
            else if ((r -= TI_G) < TI_G) { t.W = a.in[21] + woff; t.ld = FF; t.K = 1024; t.WT = (bf16_t*)(ws + (layer ? WS_WGU1 : WS_WGU0)); t.mode = 2; t.scale = a.in[19] + layer * 1024; nblk = 88; }
            else { r -= TI_G; t.W = a.in[22] + woff; t.ld = 1024; t.K = FF; t.WT = (bf16_t*)(ws + (layer ? WS_WDN1 : WS_WDN0)); t.mode = 0; t.scale = nullptr; nblk = 32; } } }
    t.k0 = 64 * (r / nblk); t.n0 = 32 * (r % nblk); return t;
}
DI void p0_load(const TItem& t, float (&v)[32], int lane) {
#pragma unroll
    for (int i = 0; i < 32; ++i) { const int kk = 2 * i + (lane >> 5); v[i] = t.W[(size_t)(t.k0 + kk) * t.ld + t.n0 + (lane & 31)]; }
    if (t.scale) {
#pragma unroll
        for (int i = 0; i < 32; ++i) v[i] *= t.scale[t.k0 + 2 * i + (lane >> 5)]; }
}
DI void p0_store(const TItem& t, const float (&v)[32], LAS float* scr, int lane) {
#pragma unroll
    for (int i = 0; i < 32; ++i) scr[(2 * i + (lane >> 5)) * 33 + (lane & 31)] = v[i];
    asm volatile("s_waitcnt lgkmcnt(0)" ::: "memory");
    const int c = lane & 7;
#pragma unroll
    for (int j = 0; j < 4; ++j) { const int n = (lane >> 3) + 8 * j; const LAS float* s = scr + (8 * c) * 33 + n;
        u32x4 o; o[0] = pk2(s[0 * 33], s[1 * 33]); o[1] = pk2(s[2 * 33], s[3 * 33]); o[2] = pk2(s[4 * 33], s[5 * 33]); o[3] = pk2(s[6 * 33], s[7 * 33]);
        const int nn = t.n0 + n; const int drow = t.mode == 0 ? nn : ((nn >> 7) * 256 + (nn & 127) + (t.mode == 2 ? 128 : 0));
        *(u32x4*)(t.WT + (size_t)drow * t.K + t.k0 + 8 * c) = o; }
    asm volatile("s_waitcnt lgkmcnt(0)" ::: "memory");
}

DI void convert_items(const Args& a, LAS unsigned char* lds, int lo, int hi, int gw, int NGW) {
    const int lane = threadIdx.x & 63, wave = threadIdx.x >> 6;
    LAS float* scr = (LAS float*)(lds + wave * 18432);
    for (int it = lo + 4 * gw; it < hi; it += 4 * NGW) {
        const TItem t0 = p0_decode(a, it), t1 = p0_decode(a, it + 1), t2 = p0_decode(a, it + 2), t3 = p0_decode(a, it + 3);
        float v0[32], v1[32], v2[32], v3[32];
        p0_load(t0, v0, lane); p0_load(t1, v1, lane); p0_load(t2, v2, lane); p0_load(t3, v3, lane);
        p0_store(t0, v0, scr, lane); p0_store(t1, v1, scr + 2112, lane); p0_store(t2, v2, scr, lane); p0_store(t3, v3, scr + 2112, lane);
    }
}
DI void p0_prologue(const Args& a, LAS unsigned char* lds) {
    const int tid = threadIdx.x, lane = tid & 63, wave = tid >> 6;
    const int gw = blockIdx.x * 8 + wave, NGW = gridDim.x * 8;
    unsigned char* ws = a.ws;
    convert_items(a, lds, 0, TI_SET1, gw, NGW);
    { u32x4* z = (u32x4*)(ws + WS_WIN0 + (size_t)5152 * 1024 * 2); const int n16 = 224 * 1024 * 2 / 16;
      for (int i = blockIdx.x * 512 + tid; i < n16; i += gridDim.x * 512) z[i] = (u32x4){0u, 0u, 0u, 0u}; }
    float* ssq = (float*)(ws + WS_SSQ); bf16_t* xb = (bf16_t*)a.out;
    for (int m0 = 4 * gw; m0 < M; m0 += 4 * NGW) {
        f32x4 v[4][4];
#pragma unroll
        for (int q = 0; q < 4; ++q) { const int m = m0 + q; const float* xr = m < MP ? a.in[0] + (size_t)m * 1024 : a.in[1] + (size_t)(m - MP) * 1024;
#pragma unroll
            for (int j = 0; j < 4; ++j) v[q][j] = *((const f32x4*)xr + lane + 64 * j); }
#pragma unroll
        for (int q = 0; q < 4; ++q) { const int m = m0 + q; float s = 0.f;
#pragma unroll
            for (int j = 0; j < 4; ++j) { const f32x4 x = v[q][j]; s += (x[0] * x[0] + x[1] * x[1]) + (x[2] * x[2] + x[3] * x[3]);
                u32x2 w; w[0] = pk2(x[0], x[1]); w[1] = pk2(x[2], x[3]); *((u32x2*)(xb + (size_t)m * 1024) + lane + 64 * j) = w; }
            s = wave_sum(s);
            if (lane == 0) { ssq[m] = s; ssq[M + m] = 0.f; ssq[2 * M + m] = 0.f; ssq[3 * M + m] = 0.f; ssq[4 * M + m] = 0.f; } }
    }
}

struct EpiIn0 { static constexpr bool PERM = true, AFTER_DRAIN = false;
    bf16_t* Z; bf16_t* XBC; float* dtraw; const float* ssq;
    DI void operator()(const f32x4 (&acc)[2][2][4][2], const pg8::Unit& u, int wr, int wc, int fr, int fq) const {
        const int row0 = u.pm * 256 + wr * 64 + fr;
#pragma unroll
        for (int ai = 0; ai < 2; ++ai)
#pragma unroll
            for (int m = 0; m < 4; ++m) { const int row = row0 + ai * 128 + m * 16; const float rs = rsqrtf(ssq[row] * (1.f / 1024.f) + EPS);
                if (u.pn < 20) { bf16_t* base; int ldc, colt; if (u.pn < 8) { base = Z; ldc = 2048; colt = u.pn * 256; } else { base = XBC; ldc = 3072; colt = (u.pn - 8) * 256; }
#pragma unroll
                    for (int bj = 0; bj < 2; ++bj) { const f32x4 v0 = acc[ai][bj][m][0] * rs, v1 = acc[ai][bj][m][1] * rs; u32x4 w; w[0] = pk2(v0[0], v0[1]); w[1] = pk2(v0[2], v0[3]); w[2] = pk2(v1[0], v1[1]); w[3] = pk2(v1[2], v1[3]);
                        *(u32x4*)(base + (size_t)row * ldc + colt + bj * 128 + wc * 32 + 8 * fq) = w; } }
                else if (wc == 0) { float* p = dtraw + (size_t)row * 32 + 8 * fq; *(f32x4*)p = acc[ai][0][m][0] * rs; *(f32x4*)(p + 4) = acc[ai][0][m][1] * rs; } }
    }
};
struct EpiRes { static constexpr bool PERM = false, AFTER_DRAIN = false;
    const float* base0; const float* base1; float* xf; bf16_t* xb; float* ssq_out;
    DI void operator()(const f32x4 (&acc)[2][2][4][2], const pg8::Unit& u, int wr, int wc, int fr, int fq) const {
        const int row0 = u.pm * 256 + wr * 64 + fr, col0 = u.pn * 256 + wc * 32 + 4 * fq;
#pragma unroll
        for (int ai = 0; ai < 2; ++ai)
#pragma unroll
            for (int m = 0; m < 4; ++m) { const int row = row0 + ai * 128 + m * 16; const float* bp = row < MP ? base0 + (size_t)row * 1024 : base1 + (size_t)(row - MP) * 1024; float s = 0.f;
#pragma unroll
                for (int bj = 0; bj < 2; ++bj)
#pragma unroll
                    for (int n = 0; n < 2; ++n) { const int col = col0 + bj * 128 + n * 16; const f32x4 v = *(const f32x4*)(bp + col) + acc[ai][bj][m][n];
                        *(f32x4*)(xf + (size_t)row * 1024 + col) = v; s += (v[0] * v[0] + v[1] * v[1]) + (v[2] * v[2] + v[3] * v[3]);
                        if (xb) { u32x2 w; w[0] = pk2(v[0], v[1]); w[1] = pk2(v[2], v[3]); *(u32x2*)(xb + (size_t)row * 1024 + col) = w; } }
                s += __shfl_xor(s, 16); s += __shfl_xor(s, 32);
                if (fq == 0) atomicAdd(ssq_out + row, s); }
    }
};
struct EpiGU { static constexpr bool PERM = true, AFTER_DRAIN = false;
    bf16_t* H; const float* ssq;
    DI void operator()(const f32x4 (&acc)[2][2][4][2], const pg8::Unit& u, int wr, int wc, int fr, int fq) const {
        const int row0 = u.pm * 256 + wr * 64 + fr, col0 = u.pn * 128 + wc * 32 + 8 * fq;
#pragma unroll
        for (int ai = 0; ai < 2; ++ai)
#pragma unroll
            for (int m = 0; m < 4; ++m) { const int row = row0 + ai * 128 + m * 16; const float rs = rsqrtf(ssq[row] * (1.f / 1024.f) + EPS); float h[8];
#pragma unroll
                for (int n = 0; n < 2; ++n)
#pragma unroll
                    for (int j = 0; j < 4; ++j) { const float g = acc[ai][0][m][n][j] * rs, up = acc[ai][1][m][n][j] * rs; h[4 * n + j] = siluf(g) * up; }
                u32x4 w; w[0] = pk2(h[0], h[1]); w[1] = pk2(h[2], h[3]); w[2] = pk2(h[4], h[5]); w[3] = pk2(h[6], h[7]);
                *(u32x4*)(H + (size_t)row * FF + col0) = w; }
    }
};
struct EpiIn1 { static constexpr bool PERM = true, AFTER_DRAIN = false;
    bf16_t* O4; const float* ssq; const float* lbraw;
    DI void operator()(const f32x4 (&acc)[2][2][4][2], const pg8::Unit& u, int wr, int wc, int fr, int fq) const {
        const int row0 = u.pm * 256 + wr * 64 + fr, type = u.pn >> 2, col0 = (u.pn & 3) * 256 + wc * 32 + 8 * fq;
        bf16_t* base = O4 + (size_t)type * M * 1024; const bool act = (type == 0 || type == 3);
#pragma unroll
        for (int ai = 0; ai < 2; ++ai)
#pragma unroll
            for (int m = 0; m < 4; ++m) { const int row = row0 + ai * 128 + m * 16; const float rs = rsqrtf(ssq[row] * (1.f / 1024.f) + EPS);
#pragma unroll
                for (int bj = 0; bj < 2; ++bj) { f32x4 v0 = acc[ai][bj][m][0] * rs, v1 = acc[ai][bj][m][1] * rs;
                    if (act) {
#pragma unroll
                        for (int j = 0; j < 4; ++j) { v0[j] = siluf(v0[j]); v1[j] = siluf(v1[j]); } }
                    if (type == 1) { const int cc = col0 + bj * 128;
#pragma unroll
                        for (int j = 0; j < 4; ++j) { const float lb0 = sigm(lbraw[1024 + cc + j] - lbraw[cc + j]), lb1 = sigm(lbraw[1024 + cc + 4 + j] - lbraw[cc + 4 + j]);
                            v0[j] = __builtin_amdgcn_logf(lb0 + (1.f - lb0) * sigm(v0[j])); v1[j] = __builtin_amdgcn_logf(lb1 + (1.f - lb1) * sigm(v1[j])); } }
                    u32x4 w; w[0] = pk2(v0[0], v0[1]); w[1] = pk2(v0[2], v0[3]); w[2] = pk2(v1[0], v1[1]); w[3] = pk2(v1[2], v1[3]);
                    *(u32x4*)(base + (size_t)row * 1024 + col0 + bj * 128) = w; } }
    }
};
#define XB_TMO      128
#define XB_XCNT(j)  (256  + 64 * (j))
#define XB_XSUB(j)  (1280 + 64 * (j))
#define XB_XGEN(j)  (2304 + 64 * (j))
#define XB_TOP      3328
#define XB_TOPGEN   3392
#define XCD_BAR_WORDS 3456
#define XB_SPIN_CAP (1u << 18)

__device__ __forceinline__ unsigned xb_ld(unsigned* p)              { return __hip_atomic_load(p, __ATOMIC_RELAXED, __HIP_MEMORY_SCOPE_AGENT); }
__device__ __forceinline__ unsigned xb_add(unsigned* p, unsigned v) { return __hip_atomic_fetch_add(p, v, __ATOMIC_RELAXED, __HIP_MEMORY_SCOPE_AGENT); }
__device__ __forceinline__ unsigned xb_xcc_id() { return (unsigned)__builtin_amdgcn_s_getreg((3 << 11) | 20) & 0xFu; }
#define XB_SPIN(cond, bar) do { unsigned _sp = 0; while (cond) { __builtin_amdgcn_s_sleep(1); \
    if ((++_sp & 255u) == 0u) { if (xb_ld(&(bar)[XB_TMO])) break; if (_sp > XB_SPIN_CAP) { atomicAdd(&(bar)[XB_TMO], 1u); break; } } } } while (0)

struct XcdBarrier {
    unsigned* bar; unsigned x;
    volatile LAS unsigned* st;
};

__device__ __forceinline__ XcdBarrier xcd_barrier_post(unsigned* bar, volatile LAS unsigned* st) {
    XcdBarrier b; b.bar = bar; b.x = xb_xcc_id(); b.st = st;
    if (threadIdx.x == 0) (void)xb_add(&bar[XB_XCNT(b.x)], 1u);
    return b;
}
__device__ __forceinline__ void xcd_barrier_complete(unsigned* bar, unsigned x, unsigned& nloc, unsigned& nx) {
    const unsigned G = gridDim.x * gridDim.y * gridDim.z;
    unsigned sum, cnt, mine, sp = 0u;
    for (;;) {
        sum = 0u; cnt = 0u; mine = 0u;
#pragma unroll
        for (unsigned j = 0; j < 16; ++j) { const unsigned c = xb_ld(&bar[XB_XCNT(j)]); sum += c; cnt += (c > 0u) ? 1u : 0u; mine = (j == x) ? c : mine; }
        if (sum == G) break;
        __builtin_amdgcn_s_sleep(1);
        if ((++sp & 255u) == 0u) { if (xb_ld(&bar[XB_TMO])) break; if (sp > XB_SPIN_CAP) { atomicAdd(&bar[XB_TMO], 1u); break; } }
    }
    nloc = mine > 0u ? mine : 1u; nx = cnt > 0u ? cnt : 1u;
}

__device__ __forceinline__ void xcd_barrier(const XcdBarrier& b) {
    asm volatile("s_waitcnt vmcnt(0)" ::: "memory");
    __syncthreads();
    if (threadIdx.x == 0) {
        unsigned* bar = b.bar;
        __builtin_amdgcn_s_waitcnt(0);
        unsigned nloc = b.st[0], nx = b.st[1];
        if (nloc == 0u) { xcd_barrier_complete(bar, b.x, nloc, nx); b.st[0] = nloc; b.st[1] = nx; }
        const unsigned old = xb_add(&bar[XB_XSUB(b.x)], 1u);
        const unsigned gen = old / nloc;
        if (old + 1u == (gen + 1u) * nloc) {
            __builtin_amdgcn_fence(__ATOMIC_RELEASE, "agent");
            asm volatile("s_waitcnt vmcnt(0)" ::: "memory");
            const unsigned og = xb_add(&bar[XB_TOP], 1u);
            const unsigned tg = og / nx;
            if (og + 1u == (tg + 1u) * nx) xb_add(&bar[XB_TOPGEN], 1u);
            else XB_SPIN(xb_ld(&bar[XB_TOPGEN]) == tg, bar);
            __builtin_amdgcn_fence(__ATOMIC_ACQUIRE, "agent");
            xb_add(&bar[XB_XGEN(b.x)], 1u);
            asm volatile("s_waitcnt vmcnt(0)" ::: "memory");
        } else {
            XB_SPIN(xb_ld(&bar[XB_XGEN(b.x)]) == gen, bar);
            __builtin_amdgcn_fence(__ATOMIC_ACQUIRE, "agent");
            asm volatile("s_waitcnt vmcnt(0)" ::: "memory");
        }
    }
    __syncthreads();
}
constexpr int L_XT = 0, L_BN = 73728, L_CN = 91136, L_BT = 108544, L_SDT = 126976, L_SCUM = 129024, L_SW = 131072, L_RED = 133120, L_GW = 135168;
template <bool OUT> DI void ssd_unit(const Args& a, LAS unsigned char* L, int unit) {
    const int tid = threadIdx.x, lane = tid & 63, wid = tid >> 6, r = lane & 31, h = lane >> 5;
    unsigned char* ws = a.ws;
    bf16_t* Z = (bf16_t*)(ws + WS_BIG); const bf16_t* XBC = (const bf16_t*)(ws + WS_BIG + BIG_XBC);
    const float* dtraw = (const float*)(ws + WS_DTRAW); float* cdec = (float*)(ws + WS_CDEC);
    bf16_t* LBUF = (bf16_t*)a.out;
    const bool prompt = unit < 256;
    int b, sc, g, row_base, nch, len;
    if (prompt) { b = unit >> 7; sc = (unit >> 2) & 31; g = unit & 3; row_base = b * 8192 + sc * 256; nch = 4; len = 64; }
    else { const int u2 = unit - 256; b = u2 >> 2; sc = 0; g = u2 & 3; row_base = MP + b * 32; nch = 1; len = 32; }
    const int hh = wid, head = g * 8 + hh;
    LAS float* SDT = (LAS float*)(L + L_SDT); LAS float* SCUM = (LAS float*)(L + L_SCUM); LAS float* SW = (LAS float*)(L + L_SW); LAS float* RED = (LAS float*)(L + L_RED);
    const float Dh = a.in[11][head];
    bf16x8 stp[4][2][2];
    const float* sprev = a.in[2] + (size_t)(b * 32 + head) * 8192; const bf16_t* sprevb = LBUF + (size_t)((b * 32 + sc) * 32 + head) * 8192;
#pragma unroll
    for (int nt = 0; nt < 4; ++nt)
#pragma unroll
        for (int pt = 0; pt < 2; ++pt) { f32x16 t = zero16();
            if (OUT && prompt) {
#pragma unroll
                for (int q = 0; q < 2; ++q) { const u32x2 lo = *(const u32x2*)(sprevb + (32 * pt + r) * 128 + 32 * nt + 16 * q + 4 * h), hi = *(const u32x2*)(sprevb + (32 * pt + r) * 128 + 32 * nt + 16 * q + 8 + 4 * h);
                    u32x4 wq; wq[0] = lo[0]; wq[1] = lo[1]; wq[2] = hi[0]; wq[3] = hi[1]; stp[nt][pt][q] = __builtin_bit_cast(bf16x8, wq); }
                if (pt == 1 && (nt & 1)) __builtin_amdgcn_sched_barrier(0);
                continue; }
            if (OUT) {
#pragma unroll
                for (int g4 = 0; g4 < 4; ++g4) { const f32x4 v = *(const f32x4*)(sprev + (32 * pt + r) * 128 + 32 * nt + 8 * g4 + 4 * h); t[4 * g4] = v[0]; t[4 * g4 + 1] = v[1]; t[4 * g4 + 2] = v[2]; t[4 * g4 + 3] = v[3]; } }
            stp[nt][pt][0] = pack8(t, 0); stp[nt][pt][1] = pack8(t, 1); if (pt == 1 && (nt & 1)) __builtin_amdgcn_sched_barrier(0); }
    float dsum = 0.f;
    if (OUT) __syncthreads();
    if (OUT && tid < 128) *(LAS f32x4*)(L + L_GW + tid * 16) = *(const f32x4*)(a.in[12] + g * 512 + tid * 4);
    for (int c = 0; c < nch; ++c) {
        int r_s = r, h_s = h, tid_s = tid; asm volatile("" : "+v"(r_s), "+v"(h_s), "+v"(tid_s));
        const int r = r_s, h = h_s, tid = tid_s;
        const int row0 = row_base + c * 64;
        __syncthreads();
        { const int s = tid >> 3, h8 = tid & 7, hd = g * 8 + h8; float dtv = 0.f;
          if (s < len) { const float xr = dtraw[(size_t)(row0 + s) * 32 + hd] + a.in[9][hd]; dtv = xr > 20.f ? xr : log1pf(__expf(xr)); }
          SDT[s * 8 + h8] = dtv; SCUM[s * 8 + h8] = -dtv * __expf(a.in[10][hd]); }
        __syncthreads();
        if (tid >= 448 && tid < 456) { const int h8 = tid - 448; float run = 0.f;
#pragma unroll 8
            for (int s2 = 0; s2 < 64; ++s2) { run += SCUM[s2 * 8 + h8]; SCUM[s2 * 8 + h8] = run; }
#pragma unroll 8
            for (int s2 = 0; s2 < 64; ++s2) SW[h8 * 64 + s2] = SDT[s2 * 8 + h8] * __expf(run - SCUM[s2 * 8 + h8]); }
        {
            const bool first_chunk = prompt ? (sc == 0 && c == 0) : true;
            const bool last_chunk = prompt ? (sc == 31 && c == 3) : true;
#pragma unroll 1
            for (int it = 0; it < 3; ++it) {
                const int id = tid + 512 * it, cg4 = id % 192, s0 = (id / 192) * 8; int kind, lc, col;
                if (cg4 < 128) { kind = 0; lc = cg4 * 4; col = g * 512 + lc; } else if (cg4 < 160) { kind = 1; lc = (cg4 - 128) * 4; col = 2048 + g * 128 + lc; } else { kind = 2; lc = (cg4 - 160) * 4; col = 2560 + g * 128 + lc; }
                u32x2 raw[11]; f32x4 w[4];
                const bf16_t* rp = XBC + (size_t)(row0 + s0 - 3) * 3072 + col;
#pragma unroll
                for (int i = 0; i < 11; ++i) { const int s = s0 - 3 + i; raw[i] = (u32x2){0u, 0u};
                    if (s >= 0 ? (s < len) : !first_chunk) raw[i] = *(const u32x2*)(rp + (size_t)i * 3072); }
#pragma unroll
                for (int t4 = 0; t4 < 4; ++t4) w[t4] = *(const f32x4*)(a.in[7] + t4 * 3072 + col);
                const f32x4 bias = *(const f32x4*)(a.in[8] + col);
                if (!prompt && s0 == 0) {
#pragma unroll
                    for (int i = 0; i < 3; ++i) { const f32x4 hv = *(const f32x4*)(a.in[3] + (size_t)(b * 3 + i) * 3072 + col); raw[i][0] = pk2(hv[0], hv[1]); raw[i][1] = pk2(hv[2], hv[3]); } }
                float* convout = a.out + (prompt ? O_CONVP : O_CONVS) + (size_t)b * 3 * 3072 + col;
                f32x4 win[3]; unsigned vbp[4][4]; f32x4 vprev = (f32x4){0.f, 0.f, 0.f, 0.f};
#pragma unroll
                for (int i = 0; i < 11; ++i) { const int s = s0 - 3 + i;
                    const f32x4 cur = (f32x4){bflo(raw[i][0]), bfhi(raw[i][0]), bflo(raw[i][1]), bfhi(raw[i][1])};
                    if (i < 3) { win[i] = cur; }
                    else { const int j8 = i - 3;
                        if (!OUT && last_chunk && s >= len - 3 && s < len) *(f32x4*)(convout + (size_t)(s - (len - 3)) * 3072) = cur;
                        f32x4 v = bias + w[0] * win[0] + w[1] * win[1] + w[2] * win[2] + w[3] * cur;
#pragma unroll
                        for (int j = 0; j < 4; ++j) v[j] = (s < len) ? siluf(v[j]) : 0.f;
                        if (kind != 0) { u32x2 o; o[0] = pk2(v[0], v[1]); o[1] = pk2(v[2], v[3]); *(LAS u32x2*)(L + (kind == 1 ? L_BN : L_CN) + (s * 136 + lc) * 2) = o; }
                        if (j8 & 1) {
#pragma unroll
                            for (int j = 0; j < 4; ++j) vbp[j][j8 >> 1] = pk2(vprev[j], v[j]); }
                        else vprev = v;
                        win[0] = win[1]; win[1] = win[2]; win[2] = cur;
                    }
                }
                if (kind != 2) { LAS unsigned char* tb = L + (kind == 0 ? L_XT : L_BT);
#pragma unroll
                    for (int j = 0; j < 4; ++j) { u32x4 o; o[0] = vbp[j][0]; o[1] = vbp[j][1]; o[2] = vbp[j][2]; o[3] = vbp[j][3]; *(LAS u32x4*)(tb + ((lc + j) * 72 + s0) * 2) = o; } }
            }
        }
        __syncthreads();
        const float clast = SCUM[63 * 8 + hh];
        if (OUT) {
#pragma unroll
            for (int tt = 0; tt < 2; ++tt) {
                f32x16 y[2] = {zero16(), zero16()};
                const bool valid = (32 * tt + r) < len; const size_t rowoff = (size_t)(row0 + 32 * tt + r) * 2048 + head * 64;
                u32x2 zpre[2][4];
#pragma unroll
                for (int pt = 0; pt < 2; ++pt)
#pragma unroll
                    for (int g4 = 0; g4 < 4; ++g4) { zpre[pt][g4] = (u32x2){0u, 0u}; if (valid) zpre[pt][g4] = *(const u32x2*)(Z + rowoff + 32 * pt + 8 * g4 + 4 * h); }
#pragma unroll
                for (int nt = 0; nt < 4; ++nt)
#pragma unroll
                    for (int q = 0; q < 2; ++q) { const bf16x8 pb = lds_2b64(L + L_CN + ((32 * tt + r) * 136 + 32 * nt + 16 * q + 4 * h) * 2);
#pragma unroll
                        for (int pt = 0; pt < 2; ++pt) y[pt] = MFMA32(stp[nt][pt][q], pb, y[pt]); }
                const float ct = SCUM[(32 * tt + r) * 8 + hh]; { const float e = __expf(ct); y[0] = y[0] * e; y[1] = y[1] * e; }
#pragma unroll
                for (int st = 0; st <= tt; ++st) {
                    f32x16 gm = zero16();
#pragma unroll
                    for (int ks = 0; ks < 8; ++ks) { const bf16x8 fa = lds_b128(L + L_BN + ((32 * st + r) * 136 + 16 * ks + 8 * h) * 2), fb = lds_b128(L + L_CN + ((32 * tt + r) * 136 + 16 * ks + 8 * h) * 2);
                        gm = MFMA32(fa, fb, gm); }
                    const int t = 32 * tt + r;
#pragma unroll
                    for (int i = 0; i < 16; ++i) { const int s = 32 * st + crow(i, h); const float cs = SCUM[s * 8 + hh], ds = SDT[s * 8 + hh];
                        float val = (s <= t) ? gm[i] * __expf(fminf(ct - cs, 0.f)) * ds : 0.f; if (s == t) val += Dh; gm[i] = val; }
#pragma unroll
                    for (int q = 0; q < 2; ++q) { const bf16x8 xs = pack8(gm, q);
#pragma unroll
                        for (int pt = 0; pt < 2; ++pt) { const bf16x8 pa = lds_2b64(L + L_XT + ((hh * 64 + 32 * pt + r) * 72 + 32 * st + 16 * q + 4 * h) * 2); y[pt] = MFMA32(pa, xs, y[pt]); } }
                }
                float ssum = 0.f;
#pragma unroll
                for (int pt = 0; pt < 2; ++pt)
#pragma unroll
                    for (int g4 = 0; g4 < 4; ++g4) { const u32x2 zz = zpre[pt][g4];
                        y[pt][4 * g4] *= siluf(bflo(zz[0])); y[pt][4 * g4 + 1] *= siluf(bfhi(zz[0])); y[pt][4 * g4 + 2] *= siluf(bflo(zz[1])); y[pt][4 * g4 + 3] *= siluf(bfhi(zz[1]));
#pragma unroll
                        for (int j = 0; j < 4; ++j) { const float v = valid ? y[pt][4 * g4 + j] : 0.f; ssum += v * v; } }
                ssum += __shfl_xor(ssum, 32);
                if (h == 0) RED[hh * 64 + 32 * tt + r] = ssum;
                __syncthreads();
                float tot = 0.f;
#pragma unroll
                for (int w8 = 0; w8 < 8; ++w8) tot += RED[w8 * 64 + 32 * tt + r];
                const float rstd = rsqrtf(tot * (1.f / 512.f) + EPS);
                if (valid) {
#pragma unroll
                    for (int pt = 0; pt < 2; ++pt)
#pragma unroll
                        for (int g4 = 0; g4 < 4; ++g4) { const int p0 = 32 * pt + 8 * g4 + 4 * h; const f32x4 gw = *(LAS f32x4*)(L + L_GW + (hh * 64 + p0) * 4);
                            u32x2 o; o[0] = pk2(y[pt][4 * g4] * rstd * gw[0], y[pt][4 * g4 + 1] * rstd * gw[1]); o[1] = pk2(y[pt][4 * g4 + 2] * rstd * gw[2], y[pt][4 * g4 + 3] * rstd * gw[3]);
                            *(u32x2*)(Z + rowoff + p0) = o; } }
            }
        }
        dsum += clast;
        if (!OUT || c + 1 < nch) {
            const float dec = __expf(clast);
            bf16x8 xs[2][4];
#pragma unroll
            for (int ks = 0; ks < 4; ++ks) { const f32x4 s0 = *(LAS f32x4*)(SW + hh * 64 + 16 * ks + 8 * h), s1 = *(LAS f32x4*)(SW + hh * 64 + 16 * ks + 8 * h + 4);
#pragma unroll
                for (int pt = 0; pt < 2; ++pt) { const u32x4 raw = *(LAS u32x4*)(L + L_XT + ((hh * 64 + 32 * pt + r) * 72 + 16 * ks + 8 * h) * 2);
                    u32x4 o; o[0] = pk2(bflo(raw[0]) * s0[0], bfhi(raw[0]) * s0[1]); o[1] = pk2(bflo(raw[1]) * s0[2], bfhi(raw[1]) * s0[3]); o[2] = pk2(bflo(raw[2]) * s1[0], bfhi(raw[2]) * s1[1]); o[3] = pk2(bflo(raw[3]) * s1[2], bfhi(raw[3]) * s1[3]);
                    xs[pt][ks] = __builtin_bit_cast(bf16x8, o); } }
#pragma unroll
            for (int nt = 0; nt < 4; ++nt) { bf16x8 af[4];
#pragma unroll
                for (int ks = 0; ks < 4; ++ks) af[ks] = lds_b128(L + L_BT + ((32 * nt + r) * 72 + 16 * ks + 8 * h) * 2);
#pragma unroll
                for (int pt = 0; pt < 2; ++pt) { f32x16 t; unpack8(stp[nt][pt][0], t, 0); unpack8(stp[nt][pt][1], t, 1); t = t * dec;
#pragma unroll
                    for (int ks = 0; ks < 4; ++ks) t = MFMA32(af[ks], xs[pt][ks], t);
                    stp[nt][pt][0] = pack8(t, 0); stp[nt][pt][1] = pack8(t, 1); } }
        }
    }
    if (!OUT) {
        const float dect = __expf(dsum);
        int loff = r * 128 + 4 * h; asm volatile("" : "+v"(loff) :: "memory");
        float* dstp = a.out + O_SSDS + (size_t)(prompt ? 0 : (b * 32 + head)) * 8192 + loff; bf16_t* lbp = LBUF + (size_t)((b * 32 + (prompt ? sc : 0)) * 32 + head) * 8192 + loff;
        const float* s0p = a.in[2] + (size_t)(prompt ? 0 : (b * 32 + head)) * 8192 + loff;
#pragma unroll
        for (int nt = 0; nt < 4; ++nt)
#pragma unroll
            for (int pt = 0; pt < 2; ++pt) { f32x16 t; unpack8(stp[nt][pt][0], t, 0); unpack8(stp[nt][pt][1], t, 1);
#pragma unroll
                for (int g4 = 0; g4 < 4; ++g4) { const int co = (32 * pt) * 128 + 32 * nt + 8 * g4; f32x4 v = (f32x4){t[4 * g4], t[4 * g4 + 1], t[4 * g4 + 2], t[4 * g4 + 3]};
                    if (!prompt) { const f32x4 s0 = *(const f32x4*)(s0p + co); v = s0 * dect + v; *(f32x4*)(dstp + co) = v; }
                    else { u32x2 o; o[0] = pk2(v[0], v[1]); o[1] = pk2(v[2], v[3]); *(u32x2*)(lbp + co) = o; } }
                __builtin_amdgcn_sched_barrier(0); }
        if (prompt && lane == 0) cdec[(b * 32 + sc) * 32 + head] = dect;
    }
}
DI void ssd_pass(const Args& a) {
    bf16_t* LBUF = (bf16_t*)a.out; const float* cdec = (const float*)(a.ws + WS_CDEC);
    for (int item = blockIdx.x * 512 + threadIdx.x; item < 131072; item += gridDim.x * 512) { const int b = item >> 16, head = (item >> 11) & 31, e4 = item & 2047;
        bf16_t* base = LBUF + (size_t)(b * 32 * 32 + head) * 8192 + e4 * 4; f32x4 run = (f32x4){0.f, 0.f, 0.f, 0.f};
#pragma unroll 1
        for (int sc0 = 0; sc0 < 32; sc0 += 8) { u32x2 l[8]; float dc[8];
#pragma unroll
            for (int j = 0; j < 8; ++j) { l[j] = *(const u32x2*)(base + (size_t)(sc0 + j) * 32 * 8192); dc[j] = cdec[(b * 32 + sc0 + j) * 32 + head]; }
#pragma unroll
            for (int j = 0; j < 8; ++j) { u32x2 o; o[0] = pk2(run[0], run[1]); o[1] = pk2(run[2], run[3]); *(u32x2*)(base + (size_t)(sc0 + j) * 32 * 8192) = o;
                run = run * dc[j] + (f32x4){bflo(l[j][0]), bfhi(l[j][0]), bflo(l[j][1]), bfhi(l[j][1])}; } }
        *(f32x4*)(a.out + O_SSDP + (size_t)(b * 32 + head) * 8192 + e4 * 4) = run; }
}

constexpr int G_QE = 0, G_KE = 17408, G_KDT = 34816, G_VT = 53248, G_HEAD = 71680, G_SDEC = 143360, G_RED = 144384, G_HT = 146432;
template <bool OUT> DI void gla_unit(const Args& a, LAS unsigned char* L, int unit) {
    const int tid = threadIdx.x, lane = tid & 63, wid = tid >> 6, r = lane & 31, h = lane >> 5;
    unsigned char* ws = a.ws;
    bf16_t* QS = (bf16_t*)(ws + WS_BIG); const bf16_t* FR = QS + (size_t)M * 1024; const bf16_t* VV = QS + (size_t)2 * M * 1024; const bf16_t* GS = QS + (size_t)3 * M * 1024;
    float* LBUF = (float*)(ws + WS_BIG + BIG_XB); float* cdec = (float*)(ws + WS_CDEC);
    const bool prompt = unit < 256;
    int b, sc, pr, row_base, nch, len;
    if (prompt) { b = unit >> 7; sc = (unit >> 2) & 31; pr = unit & 3; row_base = b * 8192 + sc * 256; nch = 4; len = 64; }
    else { const int u2 = unit - 256; b = u2 >> 2; sc = 0; pr = u2 & 3; row_base = MP + b * 32; nch = 1; len = 32; }
    const int hl = wid >> 2, vt = wid & 3, head = pr * 2 + hl;
    LAS unsigned char* LH = L + hl * G_HEAD;
    LAS float* SDEC = (LAS float*)(L + G_SDEC) + hl * 128; LAS float* RED = (LAS float*)(L + G_RED);
    const int phl = tid >> 8, ptt = tid & 255, phead = pr * 2 + phl; LAS unsigned char* PH = L + phl * G_HEAD;
    float bsum0 = 0.f, bsum1 = 0.f;
    bf16x8 stp[4][2];
    const float* sprev = prompt ? LBUF + (size_t)((b * 32 + sc) * 8 + head) * 16384 : a.in[4] + (size_t)(b * 8 + head) * 16384;
#pragma unroll
    for (int kt = 0; kt < 4; ++kt) { f32x16 t = zero16();
        if (OUT) {
#pragma unroll
            for (int i = 0; i < 16; ++i) t[i] = sprev[(32 * kt + crow(i, h)) * 128 + 32 * vt + r]; }
        stp[kt][0] = pack8(t, 0); stp[kt][1] = pack8(t, 1); }
    for (int c = 0; c < nch; ++c) {
        const int row0 = row_base + c * 64;
        __syncthreads();
        {
            const int cp = ptt & 63, rq = ptt >> 6, kc = 2 * cp; const size_t cb = (size_t)(row0 + 16 * rq) * 1024 + phead * 128 + kc;
            LAS float* HT = (LAS float*)(L + G_HT) + phl * 512;
            unsigned rf[16], rv[16], rqs[16];
#pragma unroll
            for (int j = 0; j < 16; ++j) { const bool ok = (16 * rq + j) < len; rf[j] = 0u; rv[j] = 0u; rqs[j] = 0u;
                if (ok) { rf[j] = *(const unsigned*)(FR + cb + (size_t)j * 1024); rv[j] = *(const unsigned*)(VV + cb + (size_t)j * 1024); rqs[j] = *(const unsigned*)(QS + cb + (size_t)j * 1024); } }
            float b0[16], b1[16]; float c0 = 0.f, c1 = 0.f;
#pragma unroll
            for (int j = 0; j < 16; ++j) { c0 += bflo(rf[j]); c1 += bfhi(rf[j]); b0[j] = c0; b1[j] = c1; }
            HT[rq * 128 + kc] = c0; HT[rq * 128 + kc + 1] = c1;
#pragma unroll
            for (int hf = 0; hf < 2; ++hf) { u32x4 o0, o1;
#pragma unroll
                for (int w2 = 0; w2 < 4; ++w2) { const unsigned x0 = rv[8 * hf + 2 * w2], x1 = rv[8 * hf + 2 * w2 + 1]; o0[w2] = (x0 & 0xffffu) | (x1 << 16); o1[w2] = (x0 >> 16) | (x1 & 0xffff0000u); }
                *(LAS u32x4*)(PH + G_VT + (kc * 72 + 16 * rq + 8 * hf) * 2) = o0; *(LAS u32x4*)(PH + G_VT + ((kc + 1) * 72 + 16 * rq + 8 * hf) * 2) = o1; }
            __syncthreads();
            float off0 = 0.f, off1 = 0.f, bl0 = 0.f, bl1 = 0.f;
#pragma unroll
            for (int q4 = 0; q4 < 4; ++q4) { const float t0 = HT[q4 * 128 + kc], t1 = HT[q4 * 128 + kc + 1]; bl0 += t0; bl1 += t1; if (q4 < rq) { off0 += t0; off1 += t1; } }
            const float ebl0 = __builtin_amdgcn_exp2f(bl0), ebl1 = __builtin_amdgcn_exp2f(bl1);
            if (rq == 0) { bsum0 += bl0; bsum1 += bl1; ((LAS float*)(L + G_SDEC))[phl * 128 + kc] = ebl0; ((LAS float*)(L + G_SDEC))[phl * 128 + kc + 1] = ebl1; }
#pragma unroll
            for (int hf = 0; hf < 2; ++hf) { u32x4 o0, o1; float kd0[8], kd1[8];
#pragma unroll
                for (int j = 0; j < 8; ++j) { const int jj = 8 * hf + j, s = 16 * rq + jj; const bool ok = s < len;
                    const float k0 = ok ? 1.f - __builtin_amdgcn_exp2f(bflo(rf[jj])) : 0.f, k1 = ok ? 1.f - __builtin_amdgcn_exp2f(bfhi(rf[jj])) : 0.f;
                    const float e0 = __builtin_amdgcn_exp2f(b0[jj] + off0), e1 = __builtin_amdgcn_exp2f(b1[jj] + off1), r0 = __builtin_amdgcn_rcpf(e0), r1 = __builtin_amdgcn_rcpf(e1);
                    const float ke0 = k0 * r0, ke1 = k1 * r1; kd0[j] = ke0 * ebl0; kd1[j] = ke1 * ebl1;
                    *(LAS unsigned*)(PH + G_QE + (s * 136 + kc) * 2) = pk2(bflo(rqs[jj]) * e0, bfhi(rqs[jj]) * e1); *(LAS unsigned*)(PH + G_KE + (s * 136 + kc) * 2) = pk2(ke0, ke1); }
                o0[0] = pk2(kd0[0], kd0[1]); o0[1] = pk2(kd0[2], kd0[3]); o0[2] = pk2(kd0[4], kd0[5]); o0[3] = pk2(kd0[6], kd0[7]);
                o1[0] = pk2(kd1[0], kd1[1]); o1[1] = pk2(kd1[2], kd1[3]); o1[2] = pk2(kd1[4], kd1[5]); o1[3] = pk2(kd1[6], kd1[7]);
                *(LAS u32x4*)(PH + G_KDT + (kc * 72 + 16 * rq + 8 * hf) * 2) = o0; *(LAS u32x4*)(PH + G_KDT + ((kc + 1) * 72 + 16 * rq + 8 * hf) * 2) = o1; }
        }
        __syncthreads();
        if (OUT) {
            f32x16 o[2] = {zero16(), zero16()};
            u32x2 gpre[2][4]; f32x4 gwv[4];
#pragma unroll
            for (int g4 = 0; g4 < 4; ++g4) { gwv[g4] = *(const f32x4*)(a.in[17] + 32 * vt + 8 * g4 + 4 * h);
#pragma unroll
                for (int tt = 0; tt < 2; ++tt) { gpre[tt][g4] = (u32x2){0u, 0u}; if ((32 * tt + r) < len) gpre[tt][g4] = *(const u32x2*)(GS + (size_t)(row0 + 32 * tt + r) * 1024 + head * 128 + 32 * vt + 8 * g4 + 4 * h); } }
#pragma unroll
            for (int kt = 0; kt < 4; ++kt)
#pragma unroll
                for (int q = 0; q < 2; ++q)
#pragma unroll
                    for (int tt = 0; tt < 2; ++tt) { const bf16x8 pb = lds_2b64(LH + G_QE + ((32 * tt + r) * 136 + 32 * kt + 16 * q + 4 * h) * 2); o[tt] = MFMA32(stp[kt][q], pb, o[tt]); }
#pragma unroll
            for (int cmb = 0; cmb < 3; ++cmb) { const int st = cmb >> 1, tt = (cmb + 1) >> 1;
                f32x16 gm = zero16();
#pragma unroll
                for (int ks = 0; ks < 8; ++ks) { const bf16x8 fa = lds_b128(LH + G_KE + ((32 * st + r) * 136 + 16 * ks + 8 * h) * 2), fb = lds_b128(LH + G_QE + ((32 * tt + r) * 136 + 16 * ks + 8 * h) * 2);
                    gm = MFMA32(fa, fb, gm); }
                const int t = 32 * tt + r;
#pragma unroll
                for (int i = 0; i < 16; ++i) { const int s = 32 * st + crow(i, h); gm[i] = (s <= t) ? gm[i] : 0.f; }
#pragma unroll
                for (int q = 0; q < 2; ++q) { const bf16x8 xs = pack8(gm, q); const bf16x8 pa = lds_2b64(LH + G_VT + ((32 * vt + r) * 72 + 32 * st + 16 * q + 4 * h) * 2); o[tt] = MFMA32(pa, xs, o[tt]); }
            }
#pragma unroll
            for (int tt = 0; tt < 2; ++tt) { float ss = 0.f;
#pragma unroll
                for (int i = 0; i < 16; ++i) ss += o[tt][i] * o[tt][i];
                ss += __shfl_xor(ss, 32); if (h == 0) RED[wid * 64 + 32 * tt + r] = ss; }
            __syncthreads();
#pragma unroll
            for (int tt = 0; tt < 2; ++tt) { const bool valid = (32 * tt + r) < len; float tot = 0.f;
#pragma unroll
                for (int w4 = 0; w4 < 4; ++w4) tot += RED[(hl * 4 + w4) * 64 + 32 * tt + r];
                const float rstd = rsqrtf(tot * (1.f / 128.f) + EPS); const size_t rowoff = (size_t)(row0 + 32 * tt + r) * 1024 + head * 128;
                if (valid) {
#pragma unroll
                    for (int g4 = 0; g4 < 4; ++g4) { const int v0 = 32 * vt + 8 * g4 + 4 * h; const f32x4 gw = gwv[g4]; const u32x2 gg = gpre[tt][g4];
                        u32x2 w; w[0] = pk2(o[tt][4 * g4] * rstd * gw[0] * bflo(gg[0]), o[tt][4 * g4 + 1] * rstd * gw[1] * bfhi(gg[0])); w[1] = pk2(o[tt][4 * g4 + 2] * rstd * gw[2] * bflo(gg[1]), o[tt][4 * g4 + 3] * rstd * gw[3] * bfhi(gg[1]));
                        *(u32x2*)(QS + rowoff + v0) = w; } } }
        }
        if (!OUT || c + 1 < nch) {
#pragma unroll
            for (int kt = 0; kt < 4; ++kt) { f32x16 t; unpack8(stp[kt][0], t, 0); unpack8(stp[kt][1], t, 1);
#pragma unroll
                for (int i = 0; i < 16; ++i) t[i] *= SDEC[32 * kt + crow(i, h)];
#pragma unroll
                for (int ks = 0; ks < 4; ++ks) { const bf16x8 fa = lds_b128(LH + G_KDT + ((32 * kt + r) * 72 + 16 * ks + 8 * h) * 2), fb = lds_b128(LH + G_VT + ((32 * vt + r) * 72 + 16 * ks + 8 * h) * 2); t = MFMA32(fa, fb, t); }
                stp[kt][0] = pack8(t, 0); stp[kt][1] = pack8(t, 1); }
        }
    }
    if (!OUT) {
#pragma unroll
        for (int kt = 0; kt < 4; ++kt) { f32x16 t; unpack8(stp[kt][0], t, 0); unpack8(stp[kt][1], t, 1);
#pragma unroll
            for (int i = 0; i < 16; ++i) { const int k = 32 * kt + crow(i, h); const size_t off = (size_t)k * 128 + 32 * vt + r;
                if (prompt) LBUF[(size_t)((b * 32 + sc) * 8 + head) * 16384 + off] = t[i];
                else a.out[O_HGS + (size_t)(b * 8 + head) * 16384 + off] = SDEC[k] * a.in[4][(size_t)(b * 8 + head) * 16384 + off] + t[i]; } }
        if (prompt && ptt < 64) { cdec[((b * 32 + sc) * 8 + phead) * 128 + 2 * ptt] = __builtin_amdgcn_exp2f(bsum0); cdec[((b * 32 + sc) * 8 + phead) * 128 + 2 * ptt + 1] = __builtin_amdgcn_exp2f(bsum1); }
    }
}
DI void gla_pass(const Args& a) {
    float* LBUF = (float*)(a.ws + WS_BIG + BIG_XB); const float* cdec = (const float*)(a.ws + WS_CDEC);
    for (int item = blockIdx.x * 512 + threadIdx.x; item < 65536; item += gridDim.x * 512) { const int b = item >> 15, head = (item >> 12) & 7, e4 = item & 4095, k = e4 >> 5;
        float* base = LBUF + (size_t)(b * 32 * 8 + head) * 16384 + e4 * 4; f32x4 run = (f32x4){0.f, 0.f, 0.f, 0.f};
#pragma unroll 1
        for (int sc0 = 0; sc0 < 32; sc0 += 8) { f32x4 l[8]; float dc[8];
#pragma unroll
            for (int j = 0; j < 8; ++j) { l[j] = *(const f32x4*)(base + (size_t)(sc0 + j) * 8 * 16384); dc[j] = cdec[((b * 32 + sc0 + j) * 8 + head) * 128 + k]; }
#pragma unroll
            for (int j = 0; j < 8; ++j) { *(f32x4*)(base + (size_t)(sc0 + j) * 8 * 16384) = run; run = run * dc[j] + l[j]; } }
        *(f32x4*)(a.out + O_HGP + (size_t)(b * 8 + head) * 16384 + e4 * 4) = run; }
}
DI void final_norm(const Args& a) {
    const int lane = threadIdx.x & 63, gw = blockIdx.x * 8 + (threadIdx.x >> 6), NGW = gridDim.x * 8; const float* ssq = (const float*)(a.ws + WS_SSQ) + 4 * (size_t)M;
    for (int m = gw; m < M; m += NGW) { const float rs = rsqrtf(ssq[m] * (1.f / 1024.f) + EPS); f32x4* row = (f32x4*)(a.out + (size_t)m * 1024);
#pragma unroll
        for (int j = 0; j < 4; ++j) { const f32x4 w = *((const f32x4*)a.in[23] + lane + 64 * j); row[lane + 64 * j] = row[lane + 64 * j] * rs * w; } }
}


DI void sample_gemm_res(const bf16_t* A, const bf16_t* Bt, int K, const float* base, float* xf, bf16_t* xb, float* ssq_out) {
    const int lane = threadIdx.x & 63, wid = threadIdx.x >> 6, c16 = lane & 15, q = lane >> 4;
    for (int tile = blockIdx.x * 8 + wid; tile < 2048; tile += gridDim.x * 8) { const int rt = tile >> 6, ct = tile & 63;
        const bf16_t* ap = A + (size_t)(MP + rt * 16 + c16) * K + 8 * q; const bf16_t* bp = Bt + (size_t)(ct * 16 + c16) * K + 8 * q;
        f32x4 acc0 = (f32x4){0.f, 0.f, 0.f, 0.f}, acc1 = acc0;
#pragma unroll 8
        for (int k = 0; k < K; k += 64) { const bf16x8 a0 = *(const bf16x8*)(ap + k), b0 = *(const bf16x8*)(bp + k), a1 = *(const bf16x8*)(ap + k + 32), b1 = *(const bf16x8*)(bp + k + 32);
            acc0 = __builtin_amdgcn_mfma_f32_16x16x32_bf16(a0, b0, acc0, 0, 0, 0); acc1 = __builtin_amdgcn_mfma_f32_16x16x32_bf16(a1, b1, acc1, 0, 0, 0); }
        const f32x4 acc = acc0 + acc1; const int col = ct * 16 + c16;
#pragma unroll
        for (int i = 0; i < 4; ++i) { const int rl = rt * 16 + 4 * q + i; const size_t o = (size_t)(MP + rl) * 1024 + col; const float v = base[(size_t)rl * 1024 + col] + acc[i];
            xf[o] = v; if (xb) xb[o] = (bf16_t)(pk2(v, 0.f) & 0xffffu);
            float s = v * v; s += __shfl_xor(s, 1); s += __shfl_xor(s, 2); s += __shfl_xor(s, 4); s += __shfl_xor(s, 8);
            if (c16 == 0) atomicAdd(ssq_out + MP + rl, s); } }
}
__global__ void __launch_bounds__(512, 2) mk_fwd(Args a) {
    extern __shared__ __attribute__((aligned(16))) unsigned char lds_raw[];
    LAS unsigned char* lds = (LAS unsigned char*)lds_raw;
    unsigned char* ws = a.ws; float* ssq = (float*)(ws + WS_SSQ);
    if (threadIdx.x < 16) ((LAS unsigned*)(lds + LDS_MISC))[threadIdx.x] = 0u;
    __syncthreads();
    XcdBarrier xbar; xbar.bar = (unsigned*)(ws + WS_BAR); xbar.x = 0; xbar.st = nullptr;
    if (a.ph_hi - a.ph_lo > 1) xbar = xcd_barrier_post((unsigned*)(ws + WS_BAR), (volatile LAS unsigned*)(lds + LDS_MISC));
    const int lo = a.ph_lo, hi = a.ph_hi, G = gridDim.x, bx = blockIdx.x;
    if (lo < 0) cg::this_grid().sync();
#ifndef DUPMASK
#define DUPMASK 0
#endif
#define REP(k) for (int rep_ = 0; rep_ < 1 + ((DUPMASK >> (k)) & 1); ++rep_)
#ifdef ONLY
#define IN(k) ((k) == ONLY && lo <= (k) && (k) < hi)
#else
#define IN(k) (lo <= (k) && (k) < hi)
#endif
#ifndef DUPSYNC
#define DUPSYNC 0
#endif
#define SEAM(k) do { if (IN((k) + 1)) { xcd_barrier(xbar); if (DUPSYNC) xcd_barrier(xbar); } } while (0)
    bf16_t* BIG = (bf16_t*)(ws + WS_BIG); bf16_t* XB = (bf16_t*)(ws + WS_BIG + BIG_XB);
    if (IN(0)) { REP(0) p0_prologue(a, lds); SEAM(0); }
    if (IN(1)) { pg8::Gemm g{(const bf16_t*)a.out, (const bf16_t*)(ws + WS_WIN0), M, NIN0, 1024}; pg8::StaticOrder S; S.init(M, NIN0, G, bx);
        EpiIn0 E{BIG, (bf16_t*)(ws + WS_BIG + BIG_XBC), (float*)(ws + WS_DTRAW), ssq};
        REP(1) pg8::gemm_phase<EpiIn0, pg8::StaticOrder, true, true>(lds, g, S, E);
        { const int nfull = (M / 256) * (NIN0 / 256) - 5 * G;
          if (G == 256 && nfull > 0 && nfull < G) { if (bx >= nfull) convert_items(a, lds, TI_SET1, TI_SET2A, (bx - nfull) * 8 + (int)(threadIdx.x >> 6), (G - nfull) * 8); }
          else convert_items(a, lds, TI_SET1, TI_SET2A, bx * 8 + (int)(threadIdx.x >> 6), G * 8); }
        SEAM(1); }
    if (IN(2)) { REP(2) for (int u = bx; u < 320; u += G) ssd_unit<false>(a, lds, u);
        if (bx >= 64 && bx < 128) ssd_unit<true>(a, lds, 192 + bx);
        SEAM(2); }
    if (IN(3)) { ssd_pass(a); SEAM(3); }
    if (IN(4)) { for (int u = bx; u < 256; u += G) ssd_unit<true>(a, lds, u); SEAM(4); }
    if (IN(5)) { pg8::Gemm g{BIG, (const bf16_t*)(ws + WS_WOUT0), MP, 1024, 2048}; pg8::StaticOrder S; S.init(MP, 1024, G, bx);
        EpiRes E{a.in[0], a.in[1], a.out, XB, ssq + M};
        pg8::gemm_phase<EpiRes, pg8::StaticOrder, true, true>(lds, g, S, E);
        sample_gemm_res(BIG, (const bf16_t*)(ws + WS_WOUT0), 2048, a.in[1], a.out, XB, ssq + M); SEAM(5); }
    if (IN(6)) { pg8::Gemm g{XB, (const bf16_t*)(ws + WS_WGU0), M, NGU, 1024}; pg8::StaticOrder S; S.init(M, NGU, G, bx);
        EpiGU E{BIG, ssq + M};
        REP(6) pg8::gemm_phase<EpiGU, pg8::StaticOrder, true, true>(lds, g, S, E);
        { const int nfull = (M / 256) * (NGU / 256) - 5 * G;
          if (G == 256 && nfull > 0 && nfull < G) { if (bx >= nfull) convert_items(a, lds, TI_SET2A, TI_SET2, (bx - nfull) * 8 + (int)(threadIdx.x >> 6), (G - nfull) * 8); }
          else convert_items(a, lds, TI_SET2A, TI_SET2, bx * 8 + (int)(threadIdx.x >> 6), G * 8); }
        SEAM(6); }
    if (IN(7)) { pg8::Gemm g{BIG, (const bf16_t*)(ws + WS_WDN0), MP, 1024, FF}; pg8::StaticOrder S; S.init(MP, 1024, G, bx);
        EpiRes E{a.out, a.out + (size_t)MP * 1024, a.out, XB, ssq + 2 * M};
        pg8::gemm_phase<EpiRes, pg8::StaticOrder, true, true>(lds, g, S, E);
        sample_gemm_res(BIG, (const bf16_t*)(ws + WS_WDN0), FF, a.out + (size_t)MP * 1024, a.out, XB, ssq + 2 * M); SEAM(7); }
    if (IN(8)) { pg8::Gemm g{XB, (const bf16_t*)(ws + WS_WIN1), M, NIN1, 1024}; pg8::StaticOrder S; S.init(M, NIN1, G, bx);
        EpiIn1 E{BIG, ssq + 2 * M, a.in[16]};
        REP(8) pg8::gemm_phase<EpiIn1, pg8::StaticOrder, true, true>(lds, g, S, E);
        { const int nfull = (M / 256) * (NIN1 / 256) - 4 * G;
          if (G == 256 && nfull > 0 && nfull < G) { if (bx >= nfull) convert_items(a, lds, TI_SET2, TI_ALL, (bx - nfull) * 8 + (int)(threadIdx.x >> 6), (G - nfull) * 8); }
          else convert_items(a, lds, TI_SET2, TI_ALL, bx * 8 + (int)(threadIdx.x >> 6), G * 8); }
        SEAM(8); }
    if (IN(9)) { REP(9) for (int u = bx; u < 320; u += G) gla_unit<false>(a, lds, u);
        if (bx >= 64 && bx < 128) gla_unit<true>(a, lds, 192 + bx);
        SEAM(9); }
    if (IN(10)) { gla_pass(a); SEAM(10); }
    if (IN(11)) { for (int u = bx; u < 256; u += G) gla_unit<true>(a, lds, u); SEAM(11); }
    if (IN(12)) { pg8::Gemm g{BIG, (const bf16_t*)(ws + WS_WOUT1), MP, 1024, 1024}; pg8::StaticOrder S; S.init(MP, 1024, G, bx);
        EpiRes E{a.out, a.out + (size_t)MP * 1024, a.out, XB, ssq + 3 * M};
        pg8::gemm_phase<EpiRes, pg8::StaticOrder, true, true>(lds, g, S, E);
        sample_gemm_res(BIG, (const bf16_t*)(ws + WS_WOUT1), 1024, a.out + (size_t)MP * 1024, a.out, XB, ssq + 3 * M); SEAM(12); }
    if (IN(13)) { pg8::Gemm g{XB, (const bf16_t*)(ws + WS_WGU1), M, NGU, 1024}; pg8::StaticOrder S; S.init(M, NGU, G, bx);
        EpiGU E{BIG, ssq + 3 * M};
        pg8::gemm_phase<EpiGU, pg8::StaticOrder, true, true>(lds, g, S, E); SEAM(13); }
    if (IN(14)) { pg8::Gemm g{BIG, (const bf16_t*)(ws + WS_WDN1), MP, 1024, FF}; pg8::StaticOrder S; S.init(MP, 1024, G, bx);
        EpiRes E{a.out, a.out + (size_t)MP * 1024, a.out, nullptr, ssq + 4 * M};
        pg8::gemm_phase<EpiRes, pg8::StaticOrder, true, true>(lds, g, S, E);
        sample_gemm_res(BIG, (const bf16_t*)(ws + WS_WDN1), FF, a.out + (size_t)MP * 1024, a.out, nullptr, ssq + 4 * M); SEAM(14); }
    if (IN(15)) { final_norm(a); }
#undef IN
#undef SEAM
}

#ifndef MK_MULTI
#define MK_MULTI 0
#endif
extern "C" void kernel_launch(void* const* d_in, const int* in_sizes, int n_in, void* d_out, int out_size, void* d_ws, size_t ws_size, hipStream_t stream) {
    static int grid = 0;
    if (grid == 0) {
        if (n_in != 24 || ws_size < WS_END) { fprintf(stderr, "kernel_launch: unexpected n_in %d / ws_size %zu (need %zu)\n", n_in, ws_size, (size_t)WS_END); grid = -1; return; }
        int dev = 0, cus = 0, per_cu = 0;
        hipGetDevice(&dev); hipDeviceGetAttribute(&cus, hipDeviceAttributeMultiprocessorCount, dev);
        if (hipFuncSetAttribute((const void*)mk_fwd, hipFuncAttributeMaxDynamicSharedMemorySize, LDS_BYTES) != hipSuccess) { fprintf(stderr, "kernel_launch: hipFuncSetAttribute failed\n"); grid = -1; return; }
        if (hipOccupancyMaxActiveBlocksPerMultiprocessor(&per_cu, (const void*)mk_fwd, 512, LDS_BYTES) != hipSuccess || per_cu < 1) { fprintf(stderr, "kernel_launch: occupancy query says %d\n", per_cu); per_cu = 1; }
        (void)hipGetLastError();
        grid = cus * 1;
        fprintf(stderr, "kernel_launch: grid %d (cus %d, per_cu %d)\n", grid, cus, per_cu);
    }
    if (grid < 0) return;
    Args a{};
    for (int i = 0; i < 24; ++i) a.in[i] = (const float*)d_in[i];
    a.out = (float*)d_out; a.ws = (unsigned char*)d_ws;
#if MK_MULTI
    for (int ph = 0; ph < NPH; ++ph) { a.ph_lo = ph; a.ph_hi = ph + 1; hipLaunchKernelGGL(mk_fwd, dim3(grid), dim3(512), LDS_BYTES, stream, a); }
#else
    a.ph_lo = 0; a.ph_hi = NPH;
    if (hipMemsetAsync((char*)d_ws + WS_BAR, 0, 65536, stream) != hipSuccess) { fprintf(stderr, "kernel_launch: memset of barrier words failed\n"); return; }
    void* args[] = {&a};
    hipError_t e = hipLaunchCooperativeKernel((const void*)mk_fwd, dim3(grid), dim3(512), args, LDS_BYTES, stream);
    if (e != hipSuccess) fprintf(stderr, "cooperative launch failed: %s (grid %d)\n", hipGetErrorString(e), grid);
#endif
}
```

```cpp
#include <hip/hip_runtime.h>
#include <hip/hip_cooperative_groups.h>
#include <cstdio>
#include <cstdint>
namespace cg = cooperative_groups;
namespace pg8 {
#define PG8_LAS __attribute__((address_space(3)))
typedef unsigned short bf16_t;
typedef short bf16x8 __attribute__((ext_vector_type(8)));
typedef float f32x4 __attribute__((ext_vector_type(4)));
typedef unsigned u32x4 __attribute__((ext_vector_type(4)));
constexpr int BM = 256, BK = 64, HALF = 128, HTB = HALF * BK * 2  , STAGE_BYTES = 8 * HTB, NXCD = 8, WGM = 8;

__host__ __device__ __forceinline__ int lds_byte(int r, int c) { const int st = (r >> 4) * 2 + (c >> 5), rr = r & 15, cc = c & 31, ob = rr * 64 + cc * 2; return st * 1024 + (ob ^ (((ob >> 9) & 1) << 5)); }
__host__ __device__ __forceinline__ void stage_rc(int b, int& R, int& C) { const int st = b / 1024, sb = b % 1024, swz = sb ^ (((sb >> 9) & 1) << 5); R = (st >> 1) * 16 + swz / 64; C = (st & 1) * 32 + (swz % 64) / 2; }
__host__ __device__ __forceinline__ int perm32(int rho) { const int n = rho >> 4, i = rho & 15; return 8 * (i >> 2) + 4 * n + (i & 3); }

struct Unit { int pm, pn; };
struct Gemm { const bf16_t* A; const bf16_t* Bt; int M, N, K; };

struct StaticOrder {
    int nM, nN, nwg, G, c;
    __host__ __device__ void init(int M, int N, int G_, int c_) { nM = M / BM; nN = N / BM; nwg = nM * nN; G = G_; c = c_; }
    __host__ __device__ bool next(int i, Unit& u) const {
        const long L = (long)i * G + c; if (L >= nwg) return false;
        int wgid = (int)L; { const int q = nwg / NXCD, r = nwg % NXCD, xcd = wgid % NXCD, off = wgid / NXCD; wgid = (xcd < r ? xcd * (q + 1) : r * (q + 1) + (xcd - r) * q) + off; }
        const int nig = WGM * nN, gid = wgid / nig, fm = gid * WGM, gsz = (nM - fm) < WGM ? (nM - fm) : WGM;
        u.pm = fm + ((wgid % nig) % gsz); u.pn = (wgid % nig) / gsz; return true;
    }
    __device__ __forceinline__ void a_ready(const Unit&) const {}
    __device__ __forceinline__ void done(const Unit&) const {}
};
__device__ __forceinline__ unsigned cvt_pk_bf16(float lo, float hi) { unsigned r; asm volatile("v_cvt_pk_bf16_f32 %0, %1, %2" : "=v"(r) : "v"(lo), "v"(hi)); return r; }
typedef float f32x2 __attribute__((ext_vector_type(2)));
template <class Epi, class Sched, bool ALIGN_EPI = false, bool SP2 = false>
__device__ __forceinline__ void gemm_phase(PG8_LAS unsigned char* lds, const Gemm g, const Sched& S, const Epi& E) {
    const int tid = threadIdx.x, wid = __builtin_amdgcn_readfirstlane(tid >> 6), lane = tid & 63, wr = wid >> 2, wc = wid & 3, fr = lane & 15, fq = lane >> 4;
    const int K = g.K, nt = K / BK;
    unsigned voffA[2], voffB[2];
#pragma unroll
    for (int i = 0; i < 2; ++i) { int R, C; stage_rc(tid * 16 + i * 8192, R, C); const int Rb = Epi::PERM ? ((R & ~31) + perm32(R & 31)) : R;
        voffA[i] = (unsigned)(R * K + C) * 2u; voffB[i] = (unsigned)(Rb * K + C) * 2u; }
    const size_t kstep = (size_t)(BK * 2);
    const size_t hstep = (size_t)HALF * K * 2;
    const size_t tstep = 2 * hstep;
    const unsigned ldsw = (unsigned)wid * 1024u;
    const int aoff = lds_byte(wr * 64 + fr, fq * 8), boff = lds_byte(wc * 32 + fr, fq * 8);
#define PG8_SA(b, h) (((b) * 2 + (h)) * HTB)
#define PG8_SB(b, h) ((4 + (b) * 2 + (h)) * HTB)
#define PG8_STAGE(bufoff, gbase, voff) do { _Pragma("unroll") for (int _i = 0; _i < 2; ++_i) \
        __builtin_amdgcn_global_load_lds((const unsigned*)((const char*)(gbase) + (voff)[_i]), (PG8_LAS unsigned*)(lds + (bufoff) + ldsw + _i * 8192), 16, 0, 0); } while (0)
#define PG8_LDA(dst, b, h) do { _Pragma("unroll") for (int m = 0; m < 4; ++m) _Pragma("unroll") for (int k = 0; k < 2; ++k) dst[m][k] = *(const PG8_LAS bf16x8*)(lds + PG8_SA(b, h) + aoff + m * 2048 + k * 1024); } while (0)
#define PG8_LDB(dst, b, h) do { _Pragma("unroll") for (int n = 0; n < 2; ++n) _Pragma("unroll") for (int k = 0; k < 2; ++k) dst[n][k] = *(const PG8_LAS bf16x8*)(lds + PG8_SB(b, h) + boff + n * 2048 + k * 1024); } while (0)
#define PG8_MMA(ai, bj, At, Bt) do { __builtin_amdgcn_s_setprio(1); _Pragma("unroll") for (int m = 0; m < 4; ++m) _Pragma("unroll") for (int n = 0; n < 2; ++n) _Pragma("unroll") for (int k = 0; k < 2; ++k) \
        acc[ai][bj][m][n] = __builtin_amdgcn_mfma_f32_16x16x32_bf16(Bt[n][k], At[m][k], acc[ai][bj][m][n], 0, 0, 0); __builtin_amdgcn_s_setprio(0); } while (0)
#define PG8_WAIT_V(n) asm volatile("s_waitcnt vmcnt(" #n ")" ::: "memory")
#define PG8_WAIT_L(n) asm volatile("s_waitcnt lgkmcnt(" #n ")" ::: "memory")
#define PG8_BAR __builtin_amdgcn_s_barrier()
#define PG8_SCHED __builtin_amdgcn_sched_barrier(0)
    Unit cur, nxt; int ui = 0;
    if (!S.next(0, cur)) return;
    f32x4 acc[2][2][4][2];
#pragma unroll
    for (int a = 0; a < 2; ++a)
#pragma unroll
        for (int b = 0; b < 2; ++b)
#pragma unroll
            for (int m = 0; m < 4; ++m)
#pragma unroll
                for (int n = 0; n < 2; ++n) acc[a][b][m][n] = (f32x4){0.f, 0.f, 0.f, 0.f};
    bf16x8 At[4][2], B0[2][2], B1[2][2];
    const char* cA = (const char*)g.A + (size_t)cur.pm * tstep; const char* cB = (const char*)g.Bt + (size_t)cur.pn * tstep;
    S.a_ready(cur);
    if constexpr (SP2) {
        PG8_STAGE(PG8_SB(0, 0), cB, voffB); PG8_STAGE(PG8_SB(0, 1), cB + hstep, voffB); PG8_STAGE(PG8_SA(0, 0), cA, voffA); PG8_STAGE(PG8_SA(0, 1), cA + hstep, voffA);
        if (wr == 1) PG8_BAR;
        PG8_WAIT_V(2); PG8_BAR;
        PG8_STAGE(PG8_SB(1, 0), cB + kstep, voffB); PG8_STAGE(PG8_SA(1, 0), cA + kstep, voffA); PG8_STAGE(PG8_SB(1, 1), cB + hstep + kstep, voffB);
        PG8_WAIT_V(6); PG8_BAR;
    } else {
        PG8_STAGE(PG8_SB(0, 0), cB, voffB); PG8_STAGE(PG8_SA(0, 0), cA, voffA); PG8_STAGE(PG8_SB(0, 1), cB + hstep, voffB); PG8_STAGE(PG8_SA(0, 1), cA + hstep, voffA);
        if (wr == 1) PG8_BAR;
        PG8_WAIT_V(4); PG8_BAR;
        PG8_STAGE(PG8_SB(1, 0), cB + kstep, voffB); PG8_STAGE(PG8_SA(1, 0), cA + kstep, voffA); PG8_STAGE(PG8_SB(1, 1), cB + hstep + kstep, voffB);
        PG8_WAIT_V(6); PG8_BAR;
    }
    for (;;) {
        const bool has_next = S.next(ui + 1, nxt);
        const char* nA = has_next ? (const char*)g.A + (size_t)nxt.pm * tstep : cA; const char* nB = has_next ? (const char*)g.Bt + (size_t)nxt.pn * tstep : cB;
        for (int t = 0; t < nt; t += 2) {
            const bool last = (t == nt - 2);
            const char* a1 = cA + (size_t)(t + 1) * kstep;
            const char* a2 = last ? nA : cA + (size_t)(t + 2) * kstep; const char* b2 = last ? nB : cB + (size_t)(t + 2) * kstep;
            const char* a3 = a2 + kstep; const char* b3 = b2 + kstep;
            if (last && has_next) S.a_ready(nxt);
            if constexpr (SP2) {
            PG8_LDB(B0, 0, 0); PG8_LDB(B1, 0, 1); PG8_SCHED; PG8_LDA(At, 0, 0); PG8_STAGE(PG8_SA(1, 1), a1 + hstep, voffA);
            PG8_WAIT_V(8); PG8_WAIT_L(0); PG8_BAR; PG8_MMA(0, 0, At, B0); PG8_MMA(0, 1, At, B1); PG8_BAR; PG8_SCHED;
            PG8_LDA(At, 0, 1); PG8_STAGE(PG8_SB(0, 0), b2, voffB); PG8_STAGE(PG8_SB(0, 1), b2 + hstep, voffB); PG8_STAGE(PG8_SA(0, 0), a2, voffA);
            PG8_WAIT_V(8); PG8_WAIT_L(0); PG8_BAR; PG8_MMA(1, 0, At, B0); PG8_MMA(1, 1, At, B1); PG8_BAR; PG8_SCHED;
            PG8_LDB(B0, 1, 0); PG8_LDB(B1, 1, 1); PG8_SCHED; PG8_LDA(At, 1, 0); PG8_STAGE(PG8_SA(0, 1), a2 + hstep, voffA);
            PG8_WAIT_V(8); PG8_WAIT_L(0); PG8_BAR; PG8_MMA(0, 0, At, B0); PG8_MMA(0, 1, At, B1); PG8_BAR; PG8_SCHED;
            PG8_LDA(At, 1, 1); PG8_STAGE(PG8_SB(1, 0), b3, voffB); PG8_STAGE(PG8_SB(1, 1), b3 + hstep, voffB); PG8_STAGE(PG8_SA(1, 0), a3, voffA);
            PG8_WAIT_V(8); PG8_WAIT_L(0); PG8_BAR; PG8_MMA(1, 0, At, B0); PG8_MMA(1, 1, At, B1); PG8_BAR; PG8_SCHED;
            } else {
            PG8_LDB(B0, 0, 0); PG8_SCHED; PG8_LDA(At, 0, 0); PG8_STAGE(PG8_SA(1, 1), a1 + hstep, voffA);
            PG8_WAIT_L(8); PG8_BAR; PG8_WAIT_L(0); PG8_MMA(0, 0, At, B0); PG8_BAR; PG8_SCHED;
            PG8_LDB(B1, 0, 1); PG8_STAGE(PG8_SB(0, 0), b2, voffB);
            PG8_BAR; PG8_WAIT_L(0); PG8_MMA(0, 1, At, B1); PG8_BAR;
            PG8_LDA(At, 0, 1); PG8_STAGE(PG8_SA(0, 0), a2, voffA);
            PG8_BAR; PG8_WAIT_L(0); PG8_MMA(1, 0, At, B0); PG8_BAR; PG8_SCHED;
            PG8_STAGE(PG8_SB(0, 1), b2 + hstep, voffB);
            PG8_WAIT_V(6); PG8_BAR; PG8_MMA(1, 1, At, B1); PG8_BAR;
            PG8_LDB(B0, 1, 0); PG8_SCHED; PG8_LDA(At, 1, 0); PG8_STAGE(PG8_SA(0, 1), a2 + hstep, voffA);
            PG8_WAIT_L(8); PG8_BAR; PG8_WAIT_L(0); PG8_MMA(0, 0, At, B0); PG8_BAR; PG8_SCHED;
            PG8_LDB(B1, 1, 1); PG8_STAGE(PG8_SB(1, 0), b3, voffB);
            PG8_BAR; PG8_WAIT_L(0); PG8_MMA(0, 1, At, B1); PG8_BAR;
            PG8_LDA(At, 1, 1); PG8_STAGE(PG8_SA(1, 0), a3, voffA);
            PG8_BAR; PG8_WAIT_L(0); PG8_MMA(1, 0, At, B0); PG8_BAR; PG8_SCHED;
            PG8_STAGE(PG8_SB(1, 1), b3 + hstep, voffB);
            PG8_WAIT_V(6); PG8_BAR; PG8_MMA(1, 1, At, B1); PG8_BAR;
            }
        }
        if constexpr (ALIGN_EPI) { if (wr == 0) PG8_BAR; }
        if constexpr (!Epi::AFTER_DRAIN) { E(acc, cur, wr, wc, fr, fq); S.done(cur); }
        if (!has_next) break;
#pragma unroll
        for (int a = 0; a < 2; ++a)
#pragma unroll
            for (int b = 0; b < 2; ++b)
#pragma unroll
                for (int m = 0; m < 4; ++m)
#pragma unroll
                    for (int n = 0; n < 2; ++n) acc[a][b][m][n] = (f32x4){0.f, 0.f, 0.f, 0.f};
        cur = nxt; cA = nA; cB = nB; ++ui;
        if constexpr (ALIGN_EPI) { if (wr == 1) PG8_BAR; }
    }
    PG8_WAIT_V(0);
    if constexpr (!ALIGN_EPI) { if (wr == 0) PG8_BAR; }
    PG8_BAR;
    if constexpr (Epi::AFTER_DRAIN) { E.fused(acc, cur, wr, wc, fr, fq, lds, wid, lane); S.done(cur); }
#undef PG8_SA
#undef PG8_SB
#undef PG8_STAGE
#undef PG8_LDA
#undef PG8_LDB
#undef PG8_MMA
#undef PG8_WAIT_V
#undef PG8_WAIT_L
#undef PG8_BAR
#undef PG8_SCHED
}
}
#define DI __device__ __forceinline__
#define LAS __attribute__((address_space(3)))
typedef unsigned short bf16_t;
typedef short bf16x8 __attribute__((ext_vector_type(8)));
typedef float f32x4 __attribute__((ext_vector_type(4)));
typedef float f32x16 __attribute__((ext_vector_type(16)));
typedef unsigned u32x4 __attribute__((ext_vector_type(4)));
typedef unsigned u32x2 __attribute__((ext_vector_type(2)));
typedef __bf16 bf16v2 __attribute__((ext_vector_type(2)));
#define MFMA32(a, b, c) __builtin_amdgcn_mfma_f32_32x32x16_bf16((a), (b), (c), 0, 0, 0)

constexpr int MP = 16384, MS = 512, M = MP + MS;
constexpr int NIN0 = 5376, FF = 2816, NGU = 5632, NIN1 = 4096;
constexpr float EPS = 1e-6f;
constexpr int NPH = 16;
constexpr int LDS_BYTES = 155648;

constexpr size_t WS_WIN0 = 0;
constexpr size_t WS_WOUT0 = WS_WIN0 + (size_t)NIN0 * 1024 * 2;
constexpr size_t WS_WGU0 = WS_WOUT0 + (size_t)1024 * 2048 * 2;
constexpr size_t WS_WDN0 = WS_WGU0 + (size_t)NGU * 1024 * 2;
constexpr size_t WS_WIN1 = WS_WDN0 + (size_t)1024 * FF * 2;
constexpr size_t WS_WOUT1 = WS_WIN1 + (size_t)NIN1 * 1024 * 2;
constexpr size_t WS_WGU1 = WS_WOUT1 + (size_t)1024 * 1024 * 2;
constexpr size_t WS_WDN1 = WS_WGU1 + (size_t)NGU * 1024 * 2;
constexpr size_t WS_SSQ = WS_WDN1 + (size_t)1024 * FF * 2;
constexpr size_t WS_DTRAW = WS_SSQ + (size_t)5 * M * 4;
constexpr size_t WS_CDEC = WS_DTRAW + (size_t)M * 32 * 4;
constexpr size_t WS_BIG = WS_CDEC + (size_t)65536 * 4;
constexpr size_t BIG_XBC = (size_t)M * 2048 * 2;
constexpr size_t BIG_XB = (size_t)M * 1024 * 2 * 4;
constexpr size_t WS_BAR = WS_BIG + (size_t)M * 5120 * 2;
constexpr size_t WS_END = WS_BAR + 65536;
constexpr int LDS_MISC = LDS_BYTES - 64;
constexpr size_t O_Y = 0, O_SSDP = (size_t)M * 1024, O_CONVP = O_SSDP + 524288, O_HGP = O_CONVP + 18432, O_SSDS = O_HGP + 262144,
                 O_CONVS = O_SSDS + 4194304, O_HGS = O_CONVS + 147456;

struct Args { const float* in[24]; float* out; unsigned char* ws; int ph_lo, ph_hi; };

DI unsigned pk2(float lo, float hi) { bf16v2 v; v[0] = (__bf16)lo; v[1] = (__bf16)hi; return __builtin_bit_cast(unsigned, v); }
DI float bflo(unsigned u) { return __uint_as_float(u << 16); }
DI float bfhi(unsigned u) { return __uint_as_float(u & 0xffff0000u); }
DI float siluf(float x) { return x * __builtin_amdgcn_rcpf(1.f + __builtin_amdgcn_exp2f(-1.4426950408889634f * x)); }
DI float sigm(float x) { return __builtin_amdgcn_rcpf(1.f + __builtin_amdgcn_exp2f(-1.4426950408889634f * x)); }
DI int crow(int i, int h) { return (i & 3) + 8 * (i >> 2) + 4 * h; }
DI bf16x8 pack8(const f32x16& x, int s) { u32x4 p; p[0] = pk2(x[8 * s], x[8 * s + 1]); p[1] = pk2(x[8 * s + 2], x[8 * s + 3]); p[2] = pk2(x[8 * s + 4], x[8 * s + 5]); p[3] = pk2(x[8 * s + 6], x[8 * s + 7]); return __builtin_bit_cast(bf16x8, p); }
DI void unpack8(const bf16x8& b, f32x16& x, int s) { u32x4 p = __builtin_bit_cast(u32x4, b);
#pragma unroll
    for (int w = 0; w < 4; ++w) { x[8 * s + 2 * w] = bflo(p[w]); x[8 * s + 2 * w + 1] = bfhi(p[w]); } }
DI bf16x8 lds_b128(LAS unsigned char* p) { return *(LAS bf16x8*)p; }
DI bf16x8 lds_2b64(LAS unsigned char* p) { u32x2 a = *(LAS u32x2*)p, b = *(LAS u32x2*)(p + 16); u32x4 r; r[0] = a[0]; r[1] = a[1]; r[2] = b[0]; r[3] = b[1]; return __builtin_bit_cast(bf16x8, r); }
DI f32x16 zero16() { f32x16 z;
#pragma unroll
    for (int i = 0; i < 16; ++i) z[i] = 0.f;
    return z; }
DI float wave_sum(float v) {
#pragma unroll
    for (int o = 1; o < 64; o <<= 1) v += __shfl_xor(v, o);
    return v; }

struct TItem { const float* W; bf16_t* WT; const float* scale; int ld, K, mode, k0, n0; };
constexpr int TI_IN0 = 16 * 161, TI_OUT0 = 32 * 32, TI_G = 16 * 88, TI_DN = 44 * 32, TI_IN1 = 16 * 128, TI_OUT1 = 16 * 32;
constexpr int TI_SET1 = TI_IN0, TI_SET2A = TI_SET1 + TI_OUT0 + 2 * TI_G + TI_DN, TI_SET2 = TI_SET2A + TI_IN1, TI_ALL = TI_SET2 + TI_OUT1 + 2 * TI_G + TI_DN;
static_assert(TI_SET1 % 4 == 0 && TI_SET2A % 4 == 0 && TI_SET2 % 4 == 0 && TI_ALL % 4 == 0, "items go four per trip");
DI TItem p0_decode(const Args& a, int it) {
    unsigned char* ws = a.ws; TItem t; int r = it, nblk;
    if (r < TI_IN0) { t.W = a.in[6]; t.ld = 5152; t.K = 1024; t.WT = (bf16_t*)(ws + WS_WIN0); t.mode = 0; t.scale = a.in[5]; nblk = 161; }
    else { r -= TI_IN0; int layer = 0;
        if (r >= TI_OUT0 + 2 * TI_G + TI_DN) { r -= TI_OUT0 + 2 * TI_G + TI_DN;
            if (r < TI_IN1) { t.W = a.in[15]; t.ld = 4096; t.K = 1024; t.WT = (bf16_t*)(ws + WS_WIN1); t.mode = 0; t.scale = a.in[14]; nblk = 128; layer = -1; }
            else { r -= TI_IN1; layer = 1; } }
        if (layer >= 0) { const size_t woff = (size_t)layer * 1024 * FF; const int i_out = layer ? TI_OUT1 : TI_OUT0;
            if (r < i_out) { t.W = layer ? a.in[18] : a.in[13]; t.ld = 1024; t.K = layer ? 1024 : 2048; t.WT = (bf16_t*)(ws + (layer ? WS_WOUT1 : WS_WOUT0)); t.mode = 0; t.scale = nullptr; nblk = 32; }
            else if ((r -= i_out) < TI_G) { t.W = a.in[20] + woff; t.ld = FF; t.K = 1024; t.WT = (bf16_t*)(ws + (layer ? WS_WGU1 : WS_WGU0)); t.mode = 1; t.scale = a.in[19] + layer * 1024; nblk = 88; }
            else if ((r -= TI_G) < TI_G) { t.W = a.in[21] + woff; t.ld = FF; t.K = 1024; t.WT = (bf16_t*)(ws + (layer ? WS_WGU1 : WS_WGU0)); t.mode = 2; t.scale = a.in[19] + layer * 1024; nblk = 88; }
            else { r -= TI_G; t.W = a.in[22] + woff; t.ld = 1024; t.K = FF; t.WT = (bf16_t*)(ws + (layer ? WS_WDN1 : WS_WDN0)); t.mode = 0; t.scale = nullptr; nblk = 32; } } }
    t.k0 = 64 * (r / nblk); t.n0 = 32 * (r % nblk); return t;
}
DI void p0_load(const TItem& t, float (&v)[32], int lane) {
#pragma unroll
    for (int i = 0; i < 32; ++i) { const int kk = 2 * i + (lane >> 5); v[i] = t.W[(size_t)(t.k0 + kk) * t.ld + t.n0 + (lane & 31)]; }
    if (t.scale) {
#pragma unroll
        for (int i = 0; i < 32; ++i) v[i] *= t.scale[t.k0 + 2 * i + (lane >> 5)]; }
}
DI void p0_store(const TItem& t, const float (&v)[32], LAS float* scr, int lane) {
#pragma unroll
    for (int i = 0; i < 32; ++i) scr[(2 * i + (lane >> 5)) * 33 + (lane & 31)] = v[i];
    asm volatile("s_waitcnt lgkmcnt(0)" ::: "memory");
    const int c = lane & 7;
#pragma unroll
    for (int j = 0; j < 4; ++j) { const int n = (lane >> 3) + 8 * j; const LAS float* s = scr + (8 * c) * 33 + n;
        u32x4 o; o[0] = pk2(s[0 * 33], s[1 * 33]); o[1] = pk2(s[2 * 33], s[3 * 33]); o[2] = pk2(s[4 * 33], s[5 * 33]); o[3] = pk2(s[6 * 33], s[7 * 33]);
        const int nn = t.n0 + n; const int drow = t.mode == 0 ? nn : ((nn >> 7) * 256 + (nn & 127) + (t.mode == 2 ? 128 : 0));
        *(u32x4*)(t.WT + (size_t)drow * t.K + t.k0 + 8 * c) = o; }
    asm volatile("s_waitcnt lgkmcnt(0)" ::: "memory");
}

DI void convert_items(const Args& a, LAS unsigned char* lds, int lo, int hi, int gw, int NGW) {
    const int lane = threadIdx.x & 63, wave = threadIdx.x >> 6;
    LAS float* scr = (LAS float*)(lds + wave * 18432);
    for (int it = lo + 4 * gw; it < hi; it += 4 * NGW) {
        const TItem t0 = p0_decode(a, it), t1 = p0_decode(a, it + 1), t2 = p0_decode(a, it + 2), t3 = p0_decode(a, it + 3);
        float v0[32], v1[32], v2[32], v3[32];
        p0_load(t0, v0, lane); p0_load(t1, v1, lane); p0_load(t2, v2, lane); p0_load(t3, v3, lane);
        p0_store(t0, v0, scr, lane); p0_store(t1, v1, scr + 2112, lane); p0_store(t2, v2, scr, lane); p0_store(t3, v3, scr + 2112, lane);
    }
}
DI void p0_prologue(const Args& a, LAS unsigned char* lds) {
    const int tid = threadIdx.x, lane = tid & 63, wave = tid >> 6;
    const int gw = blockIdx.x * 8 + wave, NGW = gridDim.x * 8;
    unsigned char* ws = a.ws;
    convert_items(a, lds, 0, TI_SET1, gw, NGW);
    { u32x4* z = (u32x4*)(ws + WS_WIN0 + (size_t)5152 * 1024 * 2); const int n16 = 224 * 1024 * 2 / 16;
      for (int i = blockIdx.x * 512 + tid; i < n16; i += gridDim.x * 512) z[i] = (u32x4){0u, 0u, 0u, 0u}; }
    float* ssq = (float*)(ws + WS_SSQ); bf16_t* xb = (bf16_t*)a.out;
    for (int m0 = 4 * gw; m0 < M; m0 += 4 * NGW) {
        f32x4 v[4][4];
#pragma unroll
        for (int q = 0; q < 4; ++q) { const int m = m0 + q; const float* xr = m < MP ? a.in[0] + (size_t)m * 1024 : a.in[1] + (size_t)(m - MP) * 1024;
#pragma unroll
            for (int j = 0; j < 4; ++j) v[q][j] = *((const f32x4*)xr + lane + 64 * j); }
#pragma unroll
        for (int q = 0; q < 4; ++q) { const int m = m0 + q; float s = 0.f;
#pragma unroll
            for (int j = 0; j < 4; ++j) { const f32x4 x = v[q][j]; s += (x[0] * x[0] + x[1] * x[1]) + (x[2] * x[2] + x[3] * x[3]);
                u32x2 w; w[0] = pk2(x[0], x[1]); w[1] = pk2(x[2], x[3]); *((u32x2*)(xb + (size_t)m * 1024) + lane + 64 * j) = w; }
            s = wave_sum(s);
            if (lane == 0) { ssq[m] = s; ssq[M + m] = 0.f; ssq[2 * M + m] = 0.f; ssq[3 * M + m] = 0.f; ssq[4 * M + m] = 0.f; } }
    }
}

struct EpiIn0 { static constexpr bool PERM = true, AFTER_DRAIN = false;
    bf16_t* Z; bf16_t* XBC; float* dtraw; const float* ssq;
    DI void operator()(const f32x4 (&acc)[2][2][4][2], const pg8::Unit& u, int wr, int wc, int fr, int fq) const {
        const int row0 = u.pm * 256 + wr * 64 + fr;
#pragma unroll
        for (int ai = 0; ai < 2; ++ai)
#pragma unroll
            for (int m = 0; m < 4; ++m) { const int row = row0 + ai * 128 + m * 16; const float rs = rsqrtf(ssq[row] * (1.f / 1024.f) + EPS);
                if (u.pn < 20) { bf16_t* base; int ldc, colt; if (u.pn < 8) { base = Z; ldc = 2048; colt = u.pn * 256; } else { base = XBC; ldc = 3072; colt = (u.pn - 8) * 256; }
#pragma unroll
                    for (int bj = 0; bj < 2; ++bj) { const f32x4 v0 = acc[ai][bj][m][0] * rs, v1 = acc[ai][bj][m][1] * rs; u32x4 w; w[0] = pk2(v0[0], v0[1]); w[1] = pk2(v0[2], v0[3]); w[2] = pk2(v1[0], v1[1]); w[3] = pk2(v1[2], v1[3]);
                        *(u32x4*)(base + (size_t)row * ldc + colt + bj * 128 + wc * 32 + 8 * fq) = w; } }
                else if (wc == 0) { float* p = dtraw + (size_t)row * 32 + 8 * fq; *(f32x4*)p = acc[ai][0][m][0] * rs; *(f32x4*)(p + 4) = acc[ai][0][m][1] * rs; } }
    }
};
struct EpiRes { static constexpr bool PERM = false, AFTER_DRAIN = false;
    const float* base0; const float* base1; float* xf; bf16_t* xb; float* ssq_out;
    DI void operator()(const f32x4 (&acc)[2][2][4][2], const pg8::Unit& u, int wr, int wc, int fr, int fq) const {
        const int row0 = u.pm * 256 + wr * 64 + fr, col0 = u.pn * 256 + wc * 32 + 4 * fq;
#pragma unroll
        for (int ai = 0; ai < 2; ++ai)
#pragma unroll
            for (int m = 0; m < 4; ++m) { const int row = row0 + ai * 128 + m * 16; const float* bp = row < MP ? base0 + (size_t)row * 1024 : base1 + (size_t)(row - MP) * 1024; float s = 0.f;
#pragma unroll
                for (int bj = 0; bj < 2; ++bj)
#pragma unroll
                    for (int n = 0; n < 2; ++n) { const int col = col0 + bj * 128 + n * 16; const f32x4 v = *(const f32x4*)(bp + col) + acc[ai][bj][m][n];
                        *(f32x4*)(xf + (size_t)row * 1024 + col) = v; s += (v[0] * v[0] + v[1] * v[1]) + (v[2] * v[2] + v[3] * v[3]);
                        if (xb) { u32x2 w; w[0] = pk2(v[0], v[1]); w[1] = pk2(v[2], v[3]); *(u32x2*)(xb + (size_t)row * 1024 + col) = w; } }
                s += __shfl_xor(s, 16); s += __shfl_xor(s, 32);
                if (fq == 0) atomicAdd(ssq_out + row, s); }
    }
};
struct EpiGU { static constexpr bool PERM = true, AFTER_DRAIN = false;
    bf16_t* H; const float* ssq;
    DI void operator()(const f32x4 (&acc)[2][2][4][2], const pg8::Unit& u, int wr, int wc, int fr, int fq) const {
        const int row0 = u.pm * 256 + wr * 64 + fr, col0 = u.pn * 128 + wc * 32 + 8 * fq;
#pragma unroll
        for (int ai = 0; ai < 2; ++ai)
#pragma unroll
            for (int m = 0; m < 4; ++m) { const int row = row0 + ai * 128 + m * 16; const float rs = rsqrtf(ssq[row] * (1.f / 1024.f) + EPS); float h[8];
#pragma unroll
                for (int n = 0; n < 2; ++n)
#pragma unroll
                    for (int j = 0; j < 4; ++j) { const float g = acc[ai][0][m][n][j] * rs, up = acc[ai][1][m][n][j] * rs; h[4 * n + j] = siluf(g) * up; }
                u32x4 w; w[0] = pk2(h[0], h[1]); w[1] = pk2(h[2], h[3]); w[2] = pk2(h[4], h[5]); w[3] = pk2(h[6], h[7]);
                *(u32x4*)(H + (size_t)row * FF + col0) = w; }
    }
};
struct EpiIn1 { static constexpr bool PERM = true, AFTER_DRAIN = false;
    bf16_t* O4; const float* ssq; const float* lbraw;
    DI void operator()(const f32x4 (&acc)[2][2][4][2], const pg8::Unit& u, int wr, int wc, int fr, int fq) const {
        const int row0 = u.pm * 256 + wr * 64 + fr, type = u.pn >> 2, col0 = (u.pn & 3) * 256 + wc * 32 + 8 * fq;
        bf16_t* base = O4 + (size_t)type * M * 1024; const bool act = (type == 0 || type == 3);
#pragma unroll
        for (int ai = 0; ai < 2; ++ai)
#pragma unroll
            for (int m = 0; m < 4; ++m) { const int row = row0 + ai * 128 + m * 16; const float rs = rsqrtf(ssq[row] * (1.f / 1024.f) + EPS);
#pragma unroll
                for (int bj = 0; bj < 2; ++bj) { f32x4 v0 = acc[ai][bj][m][0] * rs, v1 = acc[ai][bj][m][1] * rs;
                    if (act) {
#pragma unroll
                        for (int j = 0; j < 4; ++j) { v0[j] = siluf(v0[j]); v1[j] = siluf(v1[j]); } }
                    if (type == 1) { const int cc = col0 + bj * 128;
#pragma unroll
                        for (int j = 0; j < 4; ++j) { const float lb0 = sigm(lbraw[1024 + cc + j] - lbraw[cc + j]), lb1 = sigm(lbraw[1024 + cc + 4 + j] - lbraw[cc + 4 + j]);
                            v0[j] = __builtin_amdgcn_logf(lb0 + (1.f - lb0) * sigm(v0[j])); v1[j] = __builtin_amdgcn_logf(lb1 + (1.f - lb1) * sigm(v1[j])); } }
                    u32x4 w; w[0] = pk2(v0[0], v0[1]); w[1] = pk2(v0[2], v0[3]); w[2] = pk2(v1[0], v1[1]); w[3] = pk2(v1[2], v1[3]);
                    *(u32x4*)(base + (size_t)row * 1024 + col0 + bj * 128) = w; } }
    }
};
#define XB_TMO      128
#define XB_XCNT(j)  (256  + 64 * (j))
#define XB_XSUB(j)  (1280 + 64 * (j))
#define XB_XGEN(j)  (2304 + 64 * (j))
#define XB_TOP      3328
#define XB_TOPGEN   3392
#define XCD_BAR_WORDS 3456
#define XB_SPIN_CAP (1u << 18)

__device__ __forceinline__ unsigned xb_ld(unsigned* p)              { return __hip_atomic_load(p, __ATOMIC_RELAXED, __HIP_MEMORY_SCOPE_AGENT); }
__device__ __forceinline__ unsigned xb_add(unsigned* p, unsigned v) { return __hip_atomic_fetch_add(p, v, __ATOMIC_RELAXED, __HIP_MEMORY_SCOPE_AGENT); }
__device__ __forceinline__ unsigned xb_xcc_id() { return (unsigned)__builtin_amdgcn_s_getreg((3 << 11) | 20) & 0xFu; }
#define XB_SPIN(cond, bar) do { unsigned _sp = 0; while (cond) { __builtin_amdgcn_s_sleep(1); \
    if ((++_sp & 255u) == 0u) { if (xb_ld(&(bar)[XB_TMO])) break; if (_sp > XB_SPIN_CAP) { atomicAdd(&(bar)[XB_TMO], 1u); break; } } } } while (0)

struct XcdBarrier {
    unsigned* bar; unsigned x;
    volatile LAS unsigned* st;
};

__device__ __forceinline__ XcdBarrier xcd_barrier_post(unsigned* bar, volatile LAS unsigned* st) {
    XcdBarrier b; b.bar = bar; b.x = xb_xcc_id(); b.st = st;
    if (threadIdx.x == 0) (void)xb_add(&bar[XB_XCNT(b.x)], 1u);
    return b;
}
__device__ __forceinline__ void xcd_barrier_complete(unsigned* bar, unsigned x, unsigned& nloc, unsigned& nx) {
    const unsigned G = gridDim.x * gridDim.y * gridDim.z;
    unsigned sum, cnt, mine, sp = 0u;
    for (;;) {
        sum = 0u; cnt = 0u; mine = 0u;
#pragma unroll
        for (unsigned j = 0; j < 16; ++j) { const unsigned c = xb_ld(&bar[XB_XCNT(j)]); sum += c; cnt += (c > 0u) ? 1u : 0u; mine = (j == x) ? c : mine; }
        if (sum == G) break;
        __builtin_amdgcn_s_sleep(1);
        if ((++sp & 255u) == 0u) { if (xb_ld(&bar[XB_TMO])) break; if (sp > XB_SPIN_CAP) { atomicAdd(&bar[XB_TMO], 1u); break; } }
    }
    nloc = mine > 0u ? mine : 1u; nx = cnt > 0u ? cnt : 1u;
}

__device__ __forceinline__ void xcd_barrier(const XcdBarrier& b) {
    asm volatile("s_waitcnt vmcnt(0)" ::: "memory");
    __syncthreads();
    if (threadIdx.x == 0) {
        unsigned* bar = b.bar;
        __builtin_amdgcn_s_waitcnt(0);
        unsigned nloc = b.st[0], nx = b.st[1];
        if (nloc == 0u) { xcd_barrier_complete(bar, b.x, nloc, nx); b.st[0] = nloc; b.st[1] = nx; }
        const unsigned old = xb_add(&bar[XB_XSUB(b.x)], 1u);
        const unsigned gen = old / nloc;
        if (old + 1u == (gen + 1u) * nloc) {
            __builtin_amdgcn_fence(__ATOMIC_RELEASE, "agent");
            asm volatile("s_waitcnt vmcnt(0)" ::: "memory");
            const unsigned og = xb_add(&bar[XB_TOP], 1u);
            const unsigned tg = og / nx;
            if (og + 1u == (tg + 1u) * nx) xb_add(&bar[XB_TOPGEN], 1u);
            else XB_SPIN(xb_ld(&bar[XB_TOPGEN]) == tg, bar);
            __builtin_amdgcn_fence(__ATOMIC_ACQUIRE, "agent");
            xb_add(&bar[XB_XGEN(b.x)], 1u);
            asm volatile("s_waitcnt vmcnt(0)" ::: "memory");
        } else {
            XB_SPIN(xb_ld(&bar[XB_XGEN(b.x)]) == gen, bar);
            __builtin_amdgcn_fence(__ATOMIC_ACQUIRE, "agent");
            asm volatile("s_waitcnt vmcnt(0)" ::: "memory");
        }
    }
    __syncthreads();
}
constexpr int L_XT = 0, L_BN = 73728, L_CN = 91136, L_BT = 108544, L_SDT = 126976, L_SCUM = 129024, L_SW = 131072, L_RED = 133120, L_GW = 135168;
template <bool OUT> DI void ssd_unit(const Args& a, LAS unsigned char* L, int unit) {
    const int tid = threadIdx.x, lane = tid & 63, wid = tid >> 6, r = lane & 31, h = lane >> 5;
    unsigned char* ws = a.ws;
    bf16_t* Z = (bf16_t*)(ws + WS_BIG); const bf16_t* XBC = (const bf16_t*)(ws + WS_BIG + BIG_XBC);
    const float* dtraw = (const float*)(ws + WS_DTRAW); float* cdec = (float*)(ws + WS_CDEC);
    bf16_t* LBUF = (bf16_t*)a.out;
    const bool prompt = unit < 256;
    int b, sc, g, row_base, nch, len;
    if (prompt) { b = unit >> 7; sc = (unit >> 2) & 31; g = unit & 3; row_base = b * 8192 + sc * 256; nch = 4; len = 64; }
    else { const int u2 = unit - 256; b = u2 >> 2; sc = 0; g = u2 & 3; row_base = MP + b * 32; nch = 1; len = 32; }
    const int hh = wid, head = g * 8 + hh;
    LAS float* SDT = (LAS float*)(L + L_SDT); LAS float* SCUM = (LAS float*)(L + L_SCUM); LAS float* SW = (LAS float*)(L + L_SW); LAS float* RED = (LAS float*)(L + L_RED);
    const float Dh = a.in[11][head];
    bf16x8 stp[4][2][2];
    const float* sprev = a.in[2] + (size_t)(b * 32 + head) * 8192; const bf16_t* sprevb = LBUF + (size_t)((b * 32 + sc) * 32 + head) * 8192;
#pragma unroll
    for (int nt = 0; nt < 4; ++nt)
#pragma unroll
        for (int pt = 0; pt < 2; ++pt) { f32x16 t = zero16();
            if (OUT && prompt) {
#pragma unroll
                for (int q = 0; q < 2; ++q) { const u32x2 lo = *(const u32x2*)(sprevb + (32 * pt + r) * 128 + 32 * nt + 16 * q + 4 * h), hi = *(const u32x2*)(sprevb + (32 * pt + r) * 128 + 32 * nt + 16 * q + 8 + 4 * h);
                    u32x4 wq; wq[0] = lo[0]; wq[1] = lo[1]; wq[2] = hi[0]; wq[3] = hi[1]; stp[nt][pt][q] = __builtin_bit_cast(bf16x8, wq); }
                if (pt == 1 && (nt & 1)) __builtin_amdgcn_sched_barrier(0);
                continue; }
            if (OUT) {
#pragma unroll
                for (int g4 = 0; g4 < 4; ++g4) { const f32x4 v = *(const f32x4*)(sprev + (32 * pt + r) * 128 + 32 * nt + 8 * g4 + 4 * h); t[4 * g4] = v[0]; t[4 * g4 + 1] = v[1]; t[4 * g4 + 2] = v[2]; t[4 * g4 + 3] = v[3]; } }
            stp[nt][pt][0] = pack8(t, 0); stp[nt][pt][1] = pack8(t, 1); if (pt == 1 && (nt & 1)) __builtin_amdgcn_sched_barrier(0); }
    float dsum = 0.f;
    if (OUT) __syncthreads();
    if (OUT && tid < 128) *(LAS f32x4*)(L + L_GW + tid * 16) = *(const f32x4*)(a.in[12] + g * 512 + tid * 4);
    for (int c = 0; c < nch; ++c) {
        int r_s = r, h_s = h, tid_s = tid; asm volatile("" : "+v"(r_s), "+v"(h_s), "+v"(tid_s));
        const int r = r_s, h = h_s, tid = tid_s;
        const int row0 = row_base + c * 64;
        __syncthreads();
        { const int s = tid >> 3, h8 = tid & 7, hd = g * 8 + h8; float dtv = 0.f;
          if (s < len) { const float xr = dtraw[(size_t)(row0 + s) * 32 + hd] + a.in[9][hd]; dtv = xr > 20.f ? xr : log1pf(__expf(xr)); }
          SDT[s * 8 + h8] = dtv; SCUM[s * 8 + h8] = -dtv * __expf(a.in[10][hd]); }
        __syncthreads();
        if (tid >= 448 && tid < 456) { const int h8 = tid - 448; float run = 0.f;
#pragma unroll 8
            for (int s2 = 0; s2 < 64; ++s2) { run += SCUM[s2 * 8 + h8]; SCUM[s2 * 8 + h8] = run; }
#pragma unroll 8
            for (int s2 = 0; s2 < 64; ++s2) SW[h8 * 64 + s2] = SDT[s2 * 8 + h8] * __expf(run - SCUM[s2 * 8 + h8]); }
        {
            const bool first_chunk = prompt ? (sc == 0 && c == 0) : true;
            const bool last_chunk = prompt ? (sc == 31 && c == 3) : true;
#pragma unroll 1
            for (int it = 0; it < 3; ++it) {
                const int id = tid + 512 * it, cg4 = id % 192, s0 = (id / 192) * 8; int kind, lc, col;
                if (cg4 < 128) { kind = 0; lc = cg4 * 4; col = g * 512 + lc; } else if (cg4 < 160) { kind = 1; lc = (cg4 - 128) * 4; col = 2048 + g * 128 + lc; } else { kind = 2; lc = (cg4 - 160) * 4; col = 2560 + g * 128 + lc; }
                u32x2 raw[11]; f32x4 w[4];
                const bf16_t* rp = XBC + (size_t)(row0 + s0 - 3) * 3072 + col;
#pragma unroll
                for (int i = 0; i < 11; ++i) { const int s = s0 - 3 + i; raw[i] = (u32x2){0u, 0u};
                    if (s >= 0 ? (s < len) : !first_chunk) raw[i] = *(const u32x2*)(rp + (size_t)i * 3072); }
#pragma unroll
                for (int t4 = 0; t4 < 4; ++t4) w[t4] = *(const f32x4*)(a.in[7] + t4 * 3072 + col);
                const f32x4 bias = *(const f32x4*)(a.in[8] + col);
                if (!prompt && s0 == 0) {
#pragma unroll
                    for (int i = 0; i < 3; ++i) { const f32x4 hv = *(const f32x4*)(a.in[3] + (size_t)(b * 3 + i) * 3072 + col); raw[i][0] = pk2(hv[0], hv[1]); raw[i][1] = pk2(hv[2], hv[3]); } }
                float* convout = a.out + (prompt ? O_CONVP : O_CONVS) + (size_t)b * 3 * 3072 + col;
                f32x4 win[3]; unsigned vbp[4][4]; f32x4 vprev = (f32x4){0.f, 0.f, 0.f, 0.f};
#pragma unroll
                for (int i = 0; i < 11; ++i) { const int s = s0 - 3 + i;
                    const f32x4 cur = (f32x4){bflo(raw[i][0]), bfhi(raw[i][0]), bflo(raw[i][1]), bfhi(raw[i][1])};
                    if (i < 3) { win[i] = cur; }
                    else { const int j8 = i - 3;
                        if (!OUT && last_chunk && s >= len - 3 && s < len) *(f32x4*)(convout + (size_t)(s - (len - 3)) * 3072) = cur;
                        f32x4 v = bias + w[0] * win[0] + w[1] * win[1] + w[2] * win[2] + w[3] * cur;
#pragma unroll
                        for (int j = 0; j < 4; ++j) v[j] = (s < len) ? siluf(v[j]) : 0.f;
                        if (kind != 0) { u32x2 o; o[0] = pk2(v[0], v[1]); o[1] = pk2(v[2], v[3]); *(LAS u32x2*)(L + (kind == 1 ? L_BN : L_CN) + (s * 136 + lc) * 2) = o; }
                        if (j8 & 1) {
#pragma unroll
                            for (int j = 0; j < 4; ++j) vbp[j][j8 >> 1] = pk2(vprev[j], v[j]); }
                        else vprev = v;
                        win[0] = win[1]; win[1] = win[2]; win[2] = cur;
                    }
                }
                if (kind != 2) { LAS unsigned char* tb = L + (kind == 0 ? L_XT : L_BT);
#pragma unroll
                    for (int j = 0; j < 4; ++j) { u32x4 o; o[0] = vbp[j][0]; o[1] = vbp[j][1]; o[2] = vbp[j][2]; o[3] = vbp[j][3]; *(LAS u32x4*)(tb + ((lc + j) * 72 + s0) * 2) = o; } }
            }
        }
        __syncthreads();
        const float clast = SCUM[63 * 8 + hh];
        if (OUT) {
#pragma unroll
            for (int tt = 0; tt < 2; ++tt) {
                f32x16 y[2] = {zero16(), zero16()};
                const bool valid = (32 * tt + r) < len; const size_t rowoff = (size_t)(row0 + 32 * tt + r) * 2048 + head * 64;
                u32x2 zpre[2][4];
#pragma unroll
                for (int pt = 0; pt < 2; ++pt)
#pragma unroll
                    for (int g4 = 0; g4 < 4; ++g4) { zpre[pt][g4] = (u32x2){0u, 0u}; if (valid) zpre[pt][g4] = *(const u32x2*)(Z + rowoff + 32 * pt + 8 * g4 + 4 * h); }
#pragma unroll
                for (int nt = 0; nt < 4; ++nt)
#pragma unroll
                    for (int q = 0; q < 2; ++q) { const bf16x8 pb = lds_2b64(L + L_CN + ((32 * tt + r) * 136 + 32 * nt + 16 * q + 4 * h) * 2);
#pragma unroll
                        for (int pt = 0; pt < 2; ++pt) y[pt] = MFMA32(stp[nt][pt][q], pb, y[pt]); }
                const float ct = SCUM[(32 * tt + r) * 8 + hh]; { const float e = __expf(ct); y[0] = y[0] * e; y[1] = y[1] * e; }
#pragma unroll
                for (int st = 0; st <= tt; ++st) {
                    f32x16 gm = zero16();
#pragma unroll
                    for (int ks = 0; ks < 8; ++ks) { const bf16x8 fa = lds_b128(L + L_BN + ((32 * st + r) * 136 + 16 * ks + 8 * h) * 2), fb = lds_b128(L + L_CN + ((32 * tt + r) * 136 + 16 * ks + 8 * h) * 2);
                        gm = MFMA32(fa, fb, gm); }
                    const int t = 32 * tt + r;
#pragma unroll
                    for (int i = 0; i < 16; ++i) { const int s = 32 * st + crow(i, h); const float cs = SCUM[s * 8 + hh], ds = SDT[s * 8 + hh];
                        float val = (s <= t) ? gm[i] * __expf(fminf(ct - cs, 0.f)) * ds : 0.f; if (s == t) val += Dh; gm[i] = val; }
#pragma unroll
                    for (int q = 0; q < 2; ++q) { const bf16x8 xs = pack8(gm, q);
#pragma unroll
                        for (int pt = 0; pt < 2; ++pt) { const bf16x8 pa = lds_2b64(L + L_XT + ((hh * 64 + 32 * pt + r) * 72 + 32 * st + 16 * q + 4 * h) * 2); y[pt] = MFMA32(pa, xs, y[pt]); } }
                }
                float ssum = 0.f;
#pragma unroll
                for (int pt = 0; pt < 2; ++pt)
#pragma unroll
                    for (int g4 = 0; g4 < 4; ++g4) { const u32x2 zz = zpre[pt][g4];
                        y[pt][4 * g4] *= siluf(bflo(zz[0])); y[pt][4 * g4 + 1] *= siluf(bfhi(zz[0])); y[pt][4 * g4 + 2] *= siluf(bflo(zz[1])); y[pt][4 * g4 + 3] *= siluf(bfhi(zz[1]));
#pragma unroll
                        for (int j = 0; j < 4; ++j) { const float v = valid ? y[pt][4 * g4 + j] : 0.f; ssum += v * v; } }
                ssum += __shfl_xor(ssum, 32);
                if (h == 0) RED[hh * 64 + 32 * tt + r] = ssum;
                __syncthreads();
                float tot = 0.f;
#pragma unroll
                for (int w8 = 0; w8 < 8; ++w8) tot += RED[w8 * 64 + 32 * tt + r];
                const float rstd = rsqrtf(tot * (1.f / 512.f) + EPS);
                if (valid) {
#pragma unroll
                    for (int pt = 0; pt < 2; ++pt)
#pragma unroll
                        for (int g4 = 0; g4 < 4; ++g4) { const int p0 = 32 * pt + 8 * g4 + 4 * h; const f32x4 gw = *(LAS f32x4*)(L + L_GW + (hh * 64 + p0) * 4);
                            u32x2 o; o[0] = pk2(y[pt][4 * g4] * rstd * gw[0], y[pt][4 * g4 + 1] * rstd * gw[1]); o[1] = pk2(y[pt][4 * g4 + 2] * rstd * gw[2], y[pt][4 * g4 + 3] * rstd * gw[3]);
                            *(u32x2*)(Z + rowoff + p0) = o; } }
            }
        }
        dsum += clast;
        if (!OUT || c + 1 < nch) {
            const float dec = __expf(clast);
            bf16x8 xs[2][4];
#pragma unroll
            for (int ks = 0; ks < 4; ++ks) { const f32x4 s0 = *(LAS f32x4*)(SW + hh * 64 + 16 * ks + 8 * h), s1 = *(LAS f32x4*)(SW + hh * 64 + 16 * ks + 8 * h + 4);
#pragma unroll
                for (int pt = 0; pt < 2; ++pt) { const u32x4 raw = *(LAS u32x4*)(L + L_XT + ((hh * 64 + 32 * pt + r) * 72 + 16 * ks + 8 * h) * 2);
                    u32x4 o; o[0] = pk2(bflo(raw[0]) * s0[0], bfhi(raw[0]) * s0[1]); o[1] = pk2(bflo(raw[1]) * s0[2], bfhi(raw[1]) * s0[3]); o[2] = pk2(bflo(raw[2]) * s1[0], bfhi(raw[2]) * s1[1]); o[3] = pk2(bflo(raw[3]) * s1[2], bfhi(raw[3]) * s1[3]);
                    xs[pt][ks] = __builtin_bit_cast(bf16x8, o); } }
#pragma unroll
            for (int nt = 0; nt < 4; ++nt) { bf16x8 af[4];
#pragma unroll
                for (int ks = 0; ks < 4; ++ks) af[ks] = lds_b128(L + L_BT + ((32 * nt + r) * 72 + 16 * ks + 8 * h) * 2);
#pragma unroll
                for (int pt = 0; pt < 2; ++pt) { f32x16 t; unpack8(stp[nt][pt][0], t, 0); unpack8(stp[nt][pt][1], t, 1); t = t * dec;
#pragma unroll
                    for (int ks = 0; ks < 4; ++ks) t = MFMA32(af[ks], xs[pt][ks], t);
                    stp[nt][pt][0] = pack8(t, 0); stp[nt][pt][1] = pack8(t, 1); } }
        }
    }
    if (!OUT) {
        const float dect = __expf(dsum);
        int loff = r * 128 + 4 * h; asm volatile("" : "+v"(loff) :: "memory");
        float* dstp = a.out + O_SSDS + (size_t)(prompt ? 0 : (b * 32 + head)) * 8192 + loff; bf16_t* lbp = LBUF + (size_t)((b * 32 + (prompt ? sc : 0)) * 32 + head) * 8192 + loff;
        const float* s0p = a.in[2] + (size_t)(prompt ? 0 : (b * 32 + head)) * 8192 + loff;
#pragma unroll
        for (int nt = 0; nt < 4; ++nt)
#pragma unroll
            for (int pt = 0; pt < 2; ++pt) { f32x16 t; unpack8(stp[nt][pt][0], t, 0); unpack8(stp[nt][pt][1], t, 1);
#pragma unroll
                for (int g4 = 0; g4 < 4; ++g4) { const int co = (32 * pt) * 128 + 32 * nt + 8 * g4; f32x4 v = (f32x4){t[4 * g4], t[4 * g4 + 1], t[4 * g4 + 2], t[4 * g4 + 3]};
                    if (!prompt) { const f32x4 s0 = *(const f32x4*)(s0p + co); v = s0 * dect + v; *(f32x4*)(dstp + co) = v; }
                    else { u32x2 o; o[0] = pk2(v[0], v[1]); o[1] = pk2(v[2], v[3]); *(u32x2*)(lbp + co) = o; } }
                __builtin_amdgcn_sched_barrier(0); }
        if (prompt && lane == 0) cdec[(b * 32 + sc) * 32 + head] = dect;
    }
}
DI void ssd_pass(const Args& a) {
    bf16_t* LBUF = (bf16_t*)a.out; const float* cdec = (const float*)(a.ws + WS_CDEC);
    for (int item = blockIdx.x * 512 + threadIdx.x; item < 131072; item += gridDim.x * 512) { const int b = item >> 16, head = (item >> 11) & 31, e4 = item & 2047;
        bf16_t* base = LBUF + (size_t)(b * 32 * 32 + head) * 8192 + e4 * 4; f32x4 run = (f32x4){0.f, 0.f, 0.f, 0.f};
#pragma unroll 1
        for (int sc0 = 0; sc0 < 32; sc0 += 8) { u32x2 l[8]; float dc[8];
#pragma unroll
            for (int j = 0; j < 8; ++j) { l[j] = *(const u32x2*)(base + (size_t)(sc0 + j) * 32 * 8192); dc[j] = cdec[(b * 32 + sc0 + j) * 32 + head]; }
#pragma unroll
            for (int j = 0; j < 8; ++j) { u32x2 o; o[0] = pk2(run[0], run[1]); o[1] = pk2(run[2], run[3]); *(u32x2*)(base + (size_t)(sc0 + j) * 32 * 8192) = o;
                run = run * dc[j] + (f32x4){bflo(l[j][0]), bfhi(l[j][0]), bflo(l[j][1]), bfhi(l[j][1])}; } }
        *(f32x4*)(a.out + O_SSDP + (size_t)(b * 32 + head) * 8192 + e4 * 4) = run; }
}

constexpr int G_QE = 0, G_KE = 17408, G_KDT = 34816, G_VT = 53248, G_HEAD = 71680, G_SDEC = 143360, G_RED = 144384, G_HT = 146432;
template <bool OUT> DI void gla_unit(const Args& a, LAS unsigned char* L, int unit) {
    const int tid = threadIdx.x, lane = tid & 63, wid = tid >> 6, r = lane & 31, h = lane >> 5;
    unsigned char* ws = a.ws;
    bf16_t* QS = (bf16_t*)(ws + WS_BIG); const bf16_t* FR = QS + (size_t)M * 1024; const bf16_t* VV = QS + (size_t)2 * M * 1024; const bf16_t* GS = QS + (size_t)3 * M * 1024;
    bf16_t* LBUF = (bf16_t*)(ws + WS_BIG + BIG_XB); float* cdec = (float*)(ws + WS_CDEC);
    const bool prompt = unit < 256;
    int b, sc, pr, row_base, nch, len;
    if (prompt) { b = unit >> 7; sc = (unit >> 2) & 31; pr = unit & 3; row_base = b * 8192 + sc * 256; nch = 4; len = 64; }
    else { const int u2 = unit - 256; b = u2 >> 2; sc = 0; pr = u2 & 3; row_base = MP + b * 32; nch = 1; len = 32; }
    const int hl = wid >> 2, vt = wid & 3, head = pr * 2 + hl;
    LAS unsigned char* LH = L + hl * G_HEAD;
    LAS float* SDEC = (LAS float*)(L + G_SDEC) + hl * 128; LAS float* RED = (LAS float*)(L + G_RED);
    const int phl = tid >> 8, ptt = tid & 255, phead = pr * 2 + phl; LAS unsigned char* PH = L + phl * G_HEAD;
    float bsum0 = 0.f, bsum1 = 0.f;
    bf16x8 stp[4][2];
    const float* sprev = a.in[4] + (size_t)(b * 8 + head) * 16384; const bf16_t* sprevb = LBUF + (size_t)((b * 32 + sc) * 8 + head) * 16384;
#pragma unroll
    for (int kt = 0; kt < 4; ++kt) { f32x16 t = zero16();
        if (OUT) {
#pragma unroll
            for (int i = 0; i < 16; ++i) t[i] = prompt ? bflo((unsigned)sprevb[(32 * kt + crow(i, h)) * 128 + 32 * vt + r]) : sprev[(32 * kt + crow(i, h)) * 128 + 32 * vt + r]; }
        stp[kt][0] = pack8(t, 0); stp[kt][1] = pack8(t, 1); }
    for (int c = 0; c < nch; ++c) {
        const int row0 = row_base + c * 64;
        __syncthreads();
        {
            const int cp = ptt & 63, rq = ptt >> 6, kc = 2 * cp; const size_t cb = (size_t)(row0 + 16 * rq) * 1024 + phead * 128 + kc;
            LAS float* HT = (LAS float*)(L + G_HT) + phl * 512;
            unsigned rf[16], rv[16], rqs[16];
#pragma unroll
            for (int j = 0; j < 16; ++j) { const bool ok = (16 * rq + j) < len; rf[j] = 0u; rv[j] = 0u; rqs[j] = 0u;
                if (ok) { rf[j] = *(const unsigned*)(FR + cb + (size_t)j * 1024); rv[j] = *(const unsigned*)(VV + cb + (size_t)j * 1024); rqs[j] = *(const unsigned*)(QS + cb + (size_t)j * 1024); } }
            float b0[16], b1[16]; float c0 = 0.f, c1 = 0.f;
#pragma unroll
            for (int j = 0; j < 16; ++j) { c0 += bflo(rf[j]); c1 += bfhi(rf[j]); b0[j] = c0; b1[j] = c1; }
            HT[rq * 128 + kc] = c0; HT[rq * 128 + kc + 1] = c1;
#pragma unroll
            for (int hf = 0; hf < 2; ++hf) { u32x4 o0, o1;
#pragma unroll
                for (int w2 = 0; w2 < 4; ++w2) { const unsigned x0 = rv[8 * hf + 2 * w2], x1 = rv[8 * hf + 2 * w2 + 1]; o0[w2] = (x0 & 0xffffu) | (x1 << 16); o1[w2] = (x0 >> 16) | (x1 & 0xffff0000u); }
                *(LAS u32x4*)(PH + G_VT + (kc * 72 + 16 * rq + 8 * hf) * 2) = o0; *(LAS u32x4*)(PH + G_VT + ((kc + 1) * 72 + 16 * rq + 8 * hf) * 2) = o1; }
            __syncthreads();
            float off0 = 0.f, off1 = 0.f, bl0 = 0.f, bl1 = 0.f;
#pragma unroll
            for (int q4 = 0; q4 < 4; ++q4) { const float t0 = HT[q4 * 128 + kc], t1 = HT[q4 * 128 + kc + 1]; bl0 += t0; bl1 += t1; if (q4 < rq) { off0 += t0; off1 += t1; } }
            const float ebl0 = __builtin_amdgcn_exp2f(bl0), ebl1 = __builtin_amdgcn_exp2f(bl1);
            if (rq == 0) { bsum0 += bl0; bsum1 += bl1; ((LAS float*)(L + G_SDEC))[phl * 128 + kc] = ebl0; ((LAS float*)(L + G_SDEC))[phl * 128 + kc + 1] = ebl1; }
#pragma unroll
            for (int hf = 0; hf < 2; ++hf) { u32x4 o0, o1; float kd0[8], kd1[8];
#pragma unroll
                for (int j = 0; j < 8; ++j) { const int jj = 8 * hf + j, s = 16 * rq + jj; const bool ok = s < len;
                    const float k0 = ok ? 1.f - __builtin_amdgcn_exp2f(bflo(rf[jj])) : 0.f, k1 = ok ? 1.f - __builtin_amdgcn_exp2f(bfhi(rf[jj])) : 0.f;
                    const float e0 = __builtin_amdgcn_exp2f(b0[jj] + off0), e1 = __builtin_amdgcn_exp2f(b1[jj] + off1), r0 = __builtin_amdgcn_rcpf(e0), r1 = __builtin_amdgcn_rcpf(e1);
                    const float ke0 = k0 * r0, ke1 = k1 * r1; kd0[j] = ke0 * ebl0; kd1[j] = ke1 * ebl1;
                    *(LAS unsigned*)(PH + G_QE + (s * 136 + kc) * 2) = pk2(bflo(rqs[jj]) * e0, bfhi(rqs[jj]) * e1); *(LAS unsigned*)(PH + G_KE + (s * 136 + kc) * 2) = pk2(ke0, ke1); }
                o0[0] = pk2(kd0[0], kd0[1]); o0[1] = pk2(kd0[2], kd0[3]); o0[2] = pk2(kd0[4], kd0[5]); o0[3] = pk2(kd0[6], kd0[7]);
                o1[0] = pk2(kd1[0], kd1[1]); o1[1] = pk2(kd1[2], kd1[3]); o1[2] = pk2(kd1[4], kd1[5]); o1[3] = pk2(kd1[6], kd1[7]);
                *(LAS u32x4*)(PH + G_KDT + (kc * 72 + 16 * rq + 8 * hf) * 2) = o0; *(LAS u32x4*)(PH + G_KDT + ((kc + 1) * 72 + 16 * rq + 8 * hf) * 2) = o1; }
        }
        __syncthreads();
        if (OUT) {
            f32x16 o[2] = {zero16(), zero16()};
            u32x2 gpre[2][4]; f32x4 gwv[4];
#pragma unroll
            for (int g4 = 0; g4 < 4; ++g4) { gwv[g4] = *(const f32x4*)(a.in[17] + 32 * vt + 8 * g4 + 4 * h);
#pragma unroll
                for (int tt = 0; tt < 2; ++tt) { gpre[tt][g4] = (u32x2){0u, 0u}; if ((32 * tt + r) < len) gpre[tt][g4] = *(const u32x2*)(GS + (size_t)(row0 + 32 * tt + r) * 1024 + head * 128 + 32 * vt + 8 * g4 + 4 * h); } }
#pragma unroll
            for (int kt = 0; kt < 4; ++kt)
#pragma unroll
                for (int q = 0; q < 2; ++q)
#pragma unroll
                    for (int tt = 0; tt < 2; ++tt) { const bf16x8 pb = lds_2b64(LH + G_QE + ((32 * tt + r) * 136 + 32 * kt + 16 * q + 4 * h) * 2); o[tt] = MFMA32(stp[kt][q], pb, o[tt]); }
#pragma unroll
            for (int cmb = 0; cmb < 3; ++cmb) { const int st = cmb >> 1, tt = (cmb + 1) >> 1;
                f32x16 gm = zero16();
#pragma unroll
                for (int ks = 0; ks < 8; ++ks) { const bf16x8 fa = lds_b128(LH + G_KE + ((32 * st + r) * 136 + 16 * ks + 8 * h) * 2), fb = lds_b128(LH + G_QE + ((32 * tt + r) * 136 + 16 * ks + 8 * h) * 2);
                    gm = MFMA32(fa, fb, gm); }
                const int t = 32 * tt + r;
#pragma unroll
                for (int i = 0; i < 16; ++i) { const int s = 32 * st + crow(i, h); gm[i] = (s <= t) ? gm[i] : 0.f; }
#pragma unroll
                for (int q = 0; q < 2; ++q) { const bf16x8 xs = pack8(gm, q); const bf16x8 pa = lds_2b64(LH + G_VT + ((32 * vt + r) * 72 + 32 * st + 16 * q + 4 * h) * 2); o[tt] = MFMA32(pa, xs, o[tt]); }
            }
#pragma unroll
            for (int tt = 0; tt < 2; ++tt) { float ss = 0.f;
#pragma unroll
                for (int i = 0; i < 16; ++i) ss += o[tt][i] * o[tt][i];
                ss += __shfl_xor(ss, 32); if (h == 0) RED[wid * 64 + 32 * tt + r] = ss; }
            __syncthreads();
#pragma unroll
            for (int tt = 0; tt < 2; ++tt) { const bool valid = (32 * tt + r) < len; float tot = 0.f;
#pragma unroll
                for (int w4 = 0; w4 < 4; ++w4) tot += RED[(hl * 4 + w4) * 64 + 32 * tt + r];
                const float rstd = rsqrtf(tot * (1.f / 128.f) + EPS); const size_t rowoff = (size_t)(row0 + 32 * tt + r) * 1024 + head * 128;
                if (valid) {
#pragma unroll
                    for (int g4 = 0; g4 < 4; ++g4) { const int v0 = 32 * vt + 8 * g4 + 4 * h; const f32x4 gw = gwv[g4]; const u32x2 gg = gpre[tt][g4];
                        u32x2 w; w[0] = pk2(o[tt][4 * g4] * rstd * gw[0] * bflo(gg[0]), o[tt][4 * g4 + 1] * rstd * gw[1] * bfhi(gg[0])); w[1] = pk2(o[tt][4 * g4 + 2] * rstd * gw[2] * bflo(gg[1]), o[tt][4 * g4 + 3] * rstd * gw[3] * bfhi(gg[1]));
                        *(u32x2*)(QS + rowoff + v0) = w; } } }
        }
        if (!OUT || c + 1 < nch) {
#pragma unroll
            for (int kt = 0; kt < 4; ++kt) { f32x16 t; unpack8(stp[kt][0], t, 0); unpack8(stp[kt][1], t, 1);
#pragma unroll
                for (int i = 0; i < 16; ++i) t[i] *= SDEC[32 * kt + crow(i, h)];
#pragma unroll
                for (int ks = 0; ks < 4; ++ks) { const bf16x8 fa = lds_b128(LH + G_KDT + ((32 * kt + r) * 72 + 16 * ks + 8 * h) * 2), fb = lds_b128(LH + G_VT + ((32 * vt + r) * 72 + 16 * ks + 8 * h) * 2); t = MFMA32(fa, fb, t); }
                stp[kt][0] = pack8(t, 0); stp[kt][1] = pack8(t, 1); }
        }
    }
    if (!OUT) {
#pragma unroll
        for (int kt = 0; kt < 4; ++kt) { f32x16 t; unpack8(stp[kt][0], t, 0); unpack8(stp[kt][1], t, 1);
#pragma unroll
            for (int i = 0; i < 16; ++i) { const int k = 32 * kt + crow(i, h); const size_t off = (size_t)k * 128 + 32 * vt + r;
                if (prompt) LBUF[(size_t)((b * 32 + sc) * 8 + head) * 16384 + off] = (bf16_t)(__float_as_uint(t[i]) >> 16);
                else a.out[O_HGS + (size_t)(b * 8 + head) * 16384 + off] = SDEC[k] * a.in[4][(size_t)(b * 8 + head) * 16384 + off] + t[i]; } }
        if (prompt && ptt < 64) { cdec[((b * 32 + sc) * 8 + phead) * 128 + 2 * ptt] = __builtin_amdgcn_exp2f(bsum0); cdec[((b * 32 + sc) * 8 + phead) * 128 + 2 * ptt + 1] = __builtin_amdgcn_exp2f(bsum1); }
    }
}
DI void gla_pass(const Args& a) {
    bf16_t* LBUF = (bf16_t*)(a.ws + WS_BIG + BIG_XB); const float* cdec = (const float*)(a.ws + WS_CDEC);
    for (int item = blockIdx.x * 512 + threadIdx.x; item < 65536; item += gridDim.x * 512) { const int b = item >> 15, head = (item >> 12) & 7, e4 = item & 4095, k = e4 >> 5;
        bf16_t* base = LBUF + (size_t)(b * 32 * 8 + head) * 16384 + e4 * 4; f32x4 run = (f32x4){0.f, 0.f, 0.f, 0.f};
#pragma unroll 1
        for (int sc0 = 0; sc0 < 32; sc0 += 8) { u32x2 l[8]; float dc[8];
#pragma unroll
            for (int j = 0; j < 8; ++j) { l[j] = *(const u32x2*)(base + (size_t)(sc0 + j) * 8 * 16384); dc[j] = cdec[((b * 32 + sc0 + j) * 8 + head) * 128 + k]; }
#pragma unroll
            for (int j = 0; j < 8; ++j) { u32x2 o; o[0] = pk2(run[0], run[1]); o[1] = pk2(run[2], run[3]); *(u32x2*)(base + (size_t)(sc0 + j) * 8 * 16384) = o;
                run = run * dc[j] + (f32x4){bflo(l[j][0]), bfhi(l[j][0]), bflo(l[j][1]), bfhi(l[j][1])}; } }
        *(f32x4*)(a.out + O_HGP + (size_t)(b * 8 + head) * 16384 + e4 * 4) = run; }
}
DI void final_norm(const Args& a) {
    const int lane = threadIdx.x & 63, gw = blockIdx.x * 8 + (threadIdx.x >> 6), NGW = gridDim.x * 8; const float* ssq = (const float*)(a.ws + WS_SSQ) + 4 * (size_t)M;
    for (int m = gw; m < M; m += NGW) { const float rs = rsqrtf(ssq[m] * (1.f / 1024.f) + EPS); f32x4* row = (f32x4*)(a.out + (size_t)m * 1024);
#pragma unroll
        for (int j = 0; j < 4; ++j) { const f32x4 w = *((const f32x4*)a.in[23] + lane + 64 * j); row[lane + 64 * j] = row[lane + 64 * j] * rs * w; } }
}


DI void sample_gemm_res(const bf16_t* A, const bf16_t* Bt, int K, const float* base, float* xf, bf16_t* xb, float* ssq_out) {
    const int lane = threadIdx.x & 63, wid = threadIdx.x >> 6, c16 = lane & 15, q = lane >> 4;
    for (int tile = blockIdx.x * 8 + wid; tile < 2048; tile += gridDim.x * 8) { const int rt = tile >> 6, ct = tile & 63;
        const bf16_t* ap = A + (size_t)(MP + rt * 16 + c16) * K + 8 * q; const bf16_t* bp = Bt + (size_t)(ct * 16 + c16) * K + 8 * q;
        f32x4 acc0 = (f32x4){0.f, 0.f, 0.f, 0.f}, acc1 = acc0;
#pragma unroll 8
        for (int k = 0; k < K; k += 64) { const bf16x8 a0 = *(const bf16x8*)(ap + k), b0 = *(const bf16x8*)(bp + k), a1 = *(const bf16x8*)(ap + k + 32), b1 = *(const bf16x8*)(bp + k + 32);
            acc0 = __builtin_amdgcn_mfma_f32_16x16x32_bf16(a0, b0, acc0, 0, 0, 0); acc1 = __builtin_amdgcn_mfma_f32_16x16x32_bf16(a1, b1, acc1, 0, 0, 0); }
        const f32x4 acc = acc0 + acc1; const int col = ct * 16 + c16;
#pragma unroll
        for (int i = 0; i < 4; ++i) { const int rl = rt * 16 + 4 * q + i; const size_t o = (size_t)(MP + rl) * 1024 + col; const float v = base[(size_t)rl * 1024 + col] + acc[i];
            xf[o] = v; if (xb) xb[o] = (bf16_t)(pk2(v, 0.f) & 0xffffu);
            float s = v * v; s += __shfl_xor(s, 1); s += __shfl_xor(s, 2); s += __shfl_xor(s, 4); s += __shfl_xor(s, 8);
            if (c16 == 0) atomicAdd(ssq_out + MP + rl, s); } }
}
__global__ void __launch_bounds__(512, 2) mk_fwd(Args a) {
    extern __shared__ __attribute__((aligned(16))) unsigned char lds_raw[];
    LAS unsigned char* lds = (LAS unsigned char*)lds_raw;
    unsigned char* ws = a.ws; float* ssq = (float*)(ws + WS_SSQ);
    if (threadIdx.x < 16) ((LAS unsigned*)(lds + LDS_MISC))[threadIdx.x] = 0u;
    __syncthreads();
    XcdBarrier xbar; xbar.bar = (unsigned*)(ws + WS_BAR); xbar.x = 0; xbar.st = nullptr;
    if (a.ph_hi - a.ph_lo > 1) xbar = xcd_barrier_post((unsigned*)(ws + WS_BAR), (volatile LAS unsigned*)(lds + LDS_MISC));
    const int lo = a.ph_lo, hi = a.ph_hi, G = gridDim.x, bx = blockIdx.x;
    if (lo < 0) cg::this_grid().sync();
#ifndef DUPMASK
#define DUPMASK 0
#endif
#define REP(k) for (int rep_ = 0; rep_ < 1 + ((DUPMASK >> (k)) & 1); ++rep_)
#ifdef ONLY
#define IN(k) ((k) == ONLY && lo <= (k) && (k) < hi)
#else
#define IN(k) (lo <= (k) && (k) < hi)
#endif
#ifndef DUPSYNC
#define DUPSYNC 0
#endif
#define SEAM(k) do { if (IN((k) + 1)) { xcd_barrier(xbar); if (DUPSYNC) xcd_barrier(xbar); } } while (0)
    bf16_t* BIG = (bf16_t*)(ws + WS_BIG); bf16_t* XB = (bf16_t*)(ws + WS_BIG + BIG_XB);
    if (IN(0)) { REP(0) p0_prologue(a, lds); SEAM(0); }
    if (IN(1)) { pg8::Gemm g{(const bf16_t*)a.out, (const bf16_t*)(ws + WS_WIN0), M, NIN0, 1024}; pg8::StaticOrder S; S.init(M, NIN0, G, bx);
        EpiIn0 E{BIG, (bf16_t*)(ws + WS_BIG + BIG_XBC), (float*)(ws + WS_DTRAW), ssq};
        REP(1) pg8::gemm_phase<EpiIn0, pg8::StaticOrder, true, true>(lds, g, S, E);
        { const int nfull = (M / 256) * (NIN0 / 256) - 5 * G;
          if (G == 256 && nfull > 0 && nfull < G) { if (bx >= nfull) convert_items(a, lds, TI_SET1, TI_SET2A, (bx - nfull) * 8 + (int)(threadIdx.x >> 6), (G - nfull) * 8); }
          else convert_items(a, lds, TI_SET1, TI_SET2A, bx * 8 + (int)(threadIdx.x >> 6), G * 8); }
        SEAM(1); }
    if (IN(2)) { REP(2) for (int u = bx; u < 320; u += G) ssd_unit<false>(a, lds, u);
        if (bx >= 64 && bx < 128) ssd_unit<true>(a, lds, 192 + bx);
        SEAM(2); }
    if (IN(3)) { ssd_pass(a); SEAM(3); }
    if (IN(4)) { for (int u = bx; u < 256; u += G) ssd_unit<true>(a, lds, u); SEAM(4); }
    if (IN(5)) { pg8::Gemm g{BIG, (const bf16_t*)(ws + WS_WOUT0), MP, 1024, 2048}; pg8::StaticOrder S; S.init(MP, 1024, G, bx);
        EpiRes E{a.in[0], a.in[1], a.out, XB, ssq + M};
        pg8::gemm_phase<EpiRes, pg8::StaticOrder, true, true>(lds, g, S, E);
        sample_gemm_res(BIG, (const bf16_t*)(ws + WS_WOUT0), 2048, a.in[1], a.out, XB, ssq + M); SEAM(5); }
    if (IN(6)) { pg8::Gemm g{XB, (const bf16_t*)(ws + WS_WGU0), M, NGU, 1024}; pg8::StaticOrder S; S.init(M, NGU, G, bx);
        EpiGU E{BIG, ssq + M};
        REP(6) pg8::gemm_phase<EpiGU, pg8::StaticOrder, true, true>(lds, g, S, E);
        { const int nfull = (M / 256) * (NGU / 256) - 5 * G;
          if (G == 256 && nfull > 0 && nfull < G) { if (bx >= nfull) convert_items(a, lds, TI_SET2A, TI_SET2, (bx - nfull) * 8 + (int)(threadIdx.x >> 6), (G - nfull) * 8); }
          else convert_items(a, lds, TI_SET2A, TI_SET2, bx * 8 + (int)(threadIdx.x >> 6), G * 8); }
        SEAM(6); }
    if (IN(7)) { pg8::Gemm g{BIG, (const bf16_t*)(ws + WS_WDN0), MP, 1024, FF}; pg8::StaticOrder S; S.init(MP, 1024, G, bx);
        EpiRes E{a.out, a.out + (size_t)MP * 1024, a.out, XB, ssq + 2 * M};
        pg8::gemm_phase<EpiRes, pg8::StaticOrder, true, true>(lds, g, S, E);
        sample_gemm_res(BIG, (const bf16_t*)(ws + WS_WDN0), FF, a.out + (size_t)MP * 1024, a.out, XB, ssq + 2 * M); SEAM(7); }
    if (IN(8)) { pg8::Gemm g{XB, (const bf16_t*)(ws + WS_WIN1), M, NIN1, 1024}; pg8::StaticOrder S; S.init(M, NIN1, G, bx);
        EpiIn1 E{BIG, ssq + 2 * M, a.in[16]};
        REP(8) pg8::gemm_phase<EpiIn1, pg8::StaticOrder, true, true>(lds, g, S, E);
        { const int nfull = (M / 256) * (NIN1 / 256) - 4 * G;
          if (G == 256 && nfull > 0 && nfull < G) { if (bx >= nfull) convert_items(a, lds, TI_SET2, TI_ALL, (bx - nfull) * 8 + (int)(threadIdx.x >> 6), (G - nfull) * 8); }
          else convert_items(a, lds, TI_SET2, TI_ALL, bx * 8 + (int)(threadIdx.x >> 6), G * 8); }
        SEAM(8); }
    if (IN(9)) { REP(9) for (int u = bx; u < 320; u += G) gla_unit<false>(a, lds, u);
        if (bx >= 64 && bx < 128) gla_unit<true>(a, lds, 192 + bx);
        SEAM(9); }
    if (IN(10)) { gla_pass(a); SEAM(10); }
    if (IN(11)) { for (int u = bx; u < 256; u += G) gla_unit<true>(a, lds, u); SEAM(11); }
    if (IN(12)) { pg8::Gemm g{BIG, (const bf16_t*)(ws + WS_WOUT1), MP, 1024, 1024}; pg8::StaticOrder S; S.init(MP, 1024, G, bx);
        EpiRes E{a.out, a.out + (size_t)MP * 1024, a.out, XB, ssq + 3 * M};
        pg8::gemm_phase<EpiRes, pg8::StaticOrder, true, true>(lds, g, S, E);
        sample_gemm_res(BIG, (const bf16_t*)(ws + WS_WOUT1), 1024, a.out + (size_t)MP * 1024, a.out, XB, ssq + 3 * M); SEAM(12); }
    if (IN(13)) { pg8::Gemm g{XB, (const bf16_t*)(ws + WS_WGU1), M, NGU, 1024}; pg8::StaticOrder S; S.init(M, NGU, G, bx);
        EpiGU E{BIG, ssq + 3 * M};
        pg8::gemm_phase<EpiGU, pg8::StaticOrder, true, true>(lds, g, S, E); SEAM(13); }
    if (IN(14)) { pg8::Gemm g{BIG, (const bf16_t*)(ws + WS_WDN1), MP, 1024, FF}; pg8::StaticOrder S; S.init(MP, 1024, G, bx);
        EpiRes E{a.out, a.out + (size_t)MP * 1024, a.out, nullptr, ssq + 4 * M};
        pg8::gemm_phase<EpiRes, pg8::StaticOrder, true, true>(lds, g, S, E);
        sample_gemm_res(BIG, (const bf16_t*)(ws + WS_WDN1), FF, a.out + (size_t)MP * 1024, a.out, nullptr, ssq + 4 * M); SEAM(14); }
    if (IN(15)) { final_norm(a); }
#undef IN
#undef SEAM
}

#ifndef MK_MULTI
#define MK_MULTI 0
#endif
extern "C" void kernel_launch(void* const* d_in, const int* in_sizes, int n_in, void* d_out, int out_size, void* d_ws, size_t ws_size, hipStream_t stream) {
    static int grid = 0;
    if (grid == 0) {
        if (n_in != 24 || ws_size < WS_END) { fprintf(stderr, "kernel_launch: unexpected n_in %d / ws_size %zu (need %zu)\n", n_in, ws_size, (size_t)WS_END); grid = -1; return; }
        int dev = 0, cus = 0, per_cu = 0;
        hipGetDevice(&dev); hipDeviceGetAttribute(&cus, hipDeviceAttributeMultiprocessorCount, dev);
        if (hipFuncSetAttribute((const void*)mk_fwd, hipFuncAttributeMaxDynamicSharedMemorySize, LDS_BYTES) != hipSuccess) { fprintf(stderr, "kernel_launch: hipFuncSetAttribute failed\n"); grid = -1; return; }
        if (hipOccupancyMaxActiveBlocksPerMultiprocessor(&per_cu, (const void*)mk_fwd, 512, LDS_BYTES) != hipSuccess || per_cu < 1) { fprintf(stderr, "kernel_launch: occupancy query says %d\n", per_cu); per_cu = 1; }
        (void)hipGetLastError();
        grid = cus * 1;
        fprintf(stderr, "kernel_launch: grid %d (cus %d, per_cu %d)\n", grid, cus, per_cu);
    }
    if (grid < 0) return;
    Args a{};
    for (int i = 0; i < 24; ++i) a.in[i] = (const float*)d_in[i];
    a.out = (float*)d_out; a.ws = (unsigned char*)d_ws;
#if MK_MULTI
    for (int ph = 0; ph < NPH; ++ph) { a.ph_lo = ph; a.ph_hi = ph + 1; hipLaunchKernelGGL(mk_fwd, dim3(grid), dim3(512), LDS_BYTES, stream, a); }
#else
    a.ph_lo = 0; a.ph_hi = NPH;
    if (hipMemsetAsync((char*)d_ws + WS_BAR, 0, 65536, stream) != hipSuccess) { fprintf(stderr, "kernel_launch: memset of barrier words failed\n"); return; }
    void* args[] = {&a};
    hipError_t e = hipLaunchCooperativeKernel((const void*)mk_fwd, dim3(grid), dim3(512), args, LDS_BYTES, stream);
    if (e != hipSuccess) fprintf(stderr, "cooperative launch failed: %s (grid %d)\n", hipGetErrorString(e), grid);
#endif
}
```

```cpp
#include <hip/hip_runtime.h>
#include <hip/hip_cooperative_groups.h>
#include <cstdio>
#include <cstdint>
namespace cg = cooperative_groups;
namespace pg8 {
#define PG8_LAS __attribute__((address_space(3)))
typedef unsigned short bf16_t;
typedef short bf16x8 __attribute__((ext_vector_type(8)));
typedef float f32x4 __attribute__((ext_vector_type(4)));
typedef unsigned u32x4 __attribute__((ext_vector_type(4)));
constexpr int BM = 256, BK = 64, HALF = 128, HTB = HALF * BK * 2  , STAGE_BYTES = 8 * HTB, NXCD = 8, WGM = 8;

__host__ __device__ __forceinline__ int lds_byte(int r, int c) { const int st = (r >> 4) * 2 + (c >> 5), rr = r & 15, cc = c & 31, ob = rr * 64 + cc * 2; return st * 1024 + (ob ^ (((ob >> 9) & 1) << 5)); }
__host__ __device__ __forceinline__ void stage_rc(int b, int& R, int& C) { const int st = b / 1024, sb = b % 1024, swz = sb ^ (((sb >> 9) & 1) << 5); R = (st >> 1) * 16 + swz / 64; C = (st & 1) * 32 + (swz % 64) / 2; }
__host__ __device__ __forceinline__ int perm32(int rho) { const int n = rho >> 4, i = rho & 15; return 8 * (i >> 2) + 4 * n + (i & 3); }

struct Unit { int pm, pn; };
struct Gemm { const bf16_t* A; const bf16_t* Bt; int M, N, K; };

struct StaticOrder {
    int nM, nN, nwg, G, c;
    __host__ __device__ void init(int M, int N, int G_, int c_) { nM = M / BM; nN = N / BM; nwg = nM * nN; G = G_; c = c_; }
    __host__ __device__ bool next(int i, Unit& u) const {
        const long L = (long)i * G + c; if (L >= nwg) return false;
        int wgid = (int)L; { const int q = nwg / NXCD, r = nwg % NXCD, xcd = wgid % NXCD, off = wgid / NXCD; wgid = (xcd < r ? xcd * (q + 1) : r * (q + 1) + (xcd - r) * q) + off; }
        const int nig = WGM * nN, gid = wgid / nig, fm = gid * WGM, gsz = (nM - fm) < WGM ? (nM - fm) : WGM;
        u.pm = fm + ((wgid % nig) % gsz); u.pn = (wgid % nig) / gsz; return true;
    }
    __device__ __forceinline__ void a_ready(const Unit&) const {}
    __device__ __forceinline__ void done(const Unit&) const {}
};
__device__ __forceinline__ unsigned cvt_pk_bf16(float lo, float hi) { unsigned r; asm volatile("v_cvt_pk_bf16_f32 %0, %1, %2" : "=v"(r) : "v"(lo), "v"(hi)); return r; }
typedef float f32x2 __attribute__((ext_vector_type(2)));
template <class Epi, class Sched, bool ALIGN_EPI = false, bool SP2 = false>
__device__ __forceinline__ void gemm_phase(PG8_LAS unsigned char* lds, const Gemm g, const Sched& S, const Epi& E) {
    const int tid = threadIdx.x, wid = __builtin_amdgcn_readfirstlane(tid >> 6), lane = tid & 63, wr = wid >> 2, wc = wid & 3, fr = lane & 15, fq = lane >> 4;
    const int K = g.K, nt = K / BK;
    unsigned voffA[2], voffB[2];
#pragma unroll
    for (int i = 0; i < 2; ++i) { int R, C; stage_rc(tid * 16 + i * 8192, R, C); const int Rb = Epi::PERM ? ((R & ~31) + perm32(R & 31)) : R;
        voffA[i] = (unsigned)(R * K + C) * 2u; voffB[i] = (unsigned)(Rb * K + C) * 2u; }
    const size_t kstep = (size_t)(BK * 2);
    const size_t hstep = (size_t)HALF * K * 2;
    const size_t tstep = 2 * hstep;
    const unsigned ldsw = (unsigned)wid * 1024u;
    const int aoff = lds_byte(wr * 64 + fr, fq * 8), boff = lds_byte(wc * 32 + fr, fq * 8);
#define PG8_SA(b, h) (((b) * 2 + (h)) * HTB)
#define PG8_SB(b, h) ((4 + (b) * 2 + (h)) * HTB)
#define PG8_STAGE(bufoff, gbase, voff) do { _Pragma("unroll") for (int _i = 0; _i < 2; ++_i) \
        __builtin_amdgcn_global_load_lds((const unsigned*)((const char*)(gbase) + (voff)[_i]), (PG8_LAS unsigned*)(lds + (bufoff) + ldsw + _i * 8192), 16, 0, 0); } while (0)
#define PG8_LDA(dst, b, h) do { _Pragma("unroll") for (int m = 0; m < 4; ++m) _Pragma("unroll") for (int k = 0; k < 2; ++k) dst[m][k] = *(const PG8_LAS bf16x8*)(lds + PG8_SA(b, h) + aoff + m * 2048 + k * 1024); } while (0)
#define PG8_LDB(dst, b, h) do { _Pragma("unroll") for (int n = 0; n < 2; ++n) _Pragma("unroll") for (int k = 0; k < 2; ++k) dst[n][k] = *(const PG8_LAS bf16x8*)(lds + PG8_SB(b, h) + boff + n * 2048 + k * 1024); } while (0)
#define PG8_MMA(ai, bj, At, Bt) do { __builtin_amdgcn_s_setprio(1); _Pragma("unroll") for (int m = 0; m < 4; ++m) _Pragma("unroll") for (int n = 0; n < 2; ++n) _Pragma("unroll") for (int k = 0; k < 2; ++k) \
        acc[ai][bj][m][n] = __builtin_amdgcn_mfma_f32_16x16x32_bf16(Bt[n][k], At[m][k], acc[ai][bj][m][n], 0, 0, 0); __builtin_amdgcn_s_setprio(0); } while (0)
#define PG8_WAIT_V(n) asm volatile("s_waitcnt vmcnt(" #n ")" ::: "memory")
#define PG8_WAIT_L(n) asm volatile("s_waitcnt lgkmcnt(" #n ")" ::: "memory")
#define PG8_BAR __builtin_amdgcn_s_barrier()
#define PG8_SCHED __builtin_amdgcn_sched_barrier(0)
    Unit cur, nxt; int ui = 0;
    if (!S.next(0, cur)) return;
    f32x4 acc[2][2][4][2];
#pragma unroll
    for (int a = 0; a < 2; ++a)
#pragma unroll
        for (int b = 0; b < 2; ++b)
#pragma unroll
            for (int m = 0; m < 4; ++m)
#pragma unroll
                for (int n = 0; n < 2; ++n) acc[a][b][m][n] = (f32x4){0.f, 0.f, 0.f, 0.f};
    bf16x8 At[4][2], B0[2][2], B1[2][2];
    const char* cA = (const char*)g.A + (size_t)cur.pm * tstep; const char* cB = (const char*)g.Bt + (size_t)cur.pn * tstep;
    S.a_ready(cur);
    if constexpr (SP2) {
        PG8_STAGE(PG8_SB(0, 0), cB, voffB); PG8_STAGE(PG8_SB(0, 1), cB + hstep, voffB); PG8_STAGE(PG8_SA(0, 0), cA, voffA); PG8_STAGE(PG8_SA(0, 1), cA + hstep, voffA);
        if (wr == 1) PG8_BAR;
        PG8_WAIT_V(2); PG8_BAR;
        PG8_STAGE(PG8_SB(1, 0), cB + kstep, voffB); PG8_STAGE(PG8_SA(1, 0), cA + kstep, voffA); PG8_STAGE(PG8_SB(1, 1), cB + hstep + kstep, voffB);
        PG8_WAIT_V(6); PG8_BAR;
    } else {
        PG8_STAGE(PG8_SB(0, 0), cB, voffB); PG8_STAGE(PG8_SA(0, 0), cA, voffA); PG8_STAGE(PG8_SB(0, 1), cB + hstep, voffB); PG8_STAGE(PG8_SA(0, 1), cA + hstep, voffA);
        if (wr == 1) PG8_BAR;
        PG8_WAIT_V(4); PG8_BAR;
        PG8_STAGE(PG8_SB(1, 0), cB + kstep, voffB); PG8_STAGE(PG8_SA(1, 0), cA + kstep, voffA); PG8_STAGE(PG8_SB(1, 1), cB + hstep + kstep, voffB);
        PG8_WAIT_V(6); PG8_BAR;
    }
    for (;;) {
        const bool has_next = S.next(ui + 1, nxt);
        const char* nA = has_next ? (const char*)g.A + (size_t)nxt.pm * tstep : cA; const char* nB = has_next ? (const char*)g.Bt + (size_t)nxt.pn * tstep : cB;
        for (int t = 0; t < nt; t += 2) {
            const bool last = (t == nt - 2);
            const char* a1 = cA + (size_t)(t + 1) * kstep;
            const char* a2 = last ? nA : cA + (size_t)(t + 2) * kstep; const char* b2 = last ? nB : cB + (size_t)(t + 2) * kstep;
            const char* a3 = a2 + kstep; const char* b3 = b2 + kstep;
            if (last && has_next) S.a_ready(nxt);
            if constexpr (SP2) {
            PG8_LDB(B0, 0, 0); PG8_LDB(B1, 0, 1); PG8_SCHED; PG8_LDA(At, 0, 0); PG8_STAGE(PG8_SA(1, 1), a1 + hstep, voffA);
            PG8_WAIT_V(8); PG8_WAIT_L(0); PG8_BAR; PG8_MMA(0, 0, At, B0); PG8_MMA(0, 1, At, B1); PG8_BAR; PG8_SCHED;
            PG8_LDA(At, 0, 1); PG8_STAGE(PG8_SB(0, 0), b2, voffB); PG8_STAGE(PG8_SB(0, 1), b2 + hstep, voffB); PG8_STAGE(PG8_SA(0, 0), a2, voffA);
            PG8_WAIT_V(8); PG8_WAIT_L(0); PG8_BAR; PG8_MMA(1, 0, At, B0); PG8_MMA(1, 1, At, B1); PG8_BAR; PG8_SCHED;
            PG8_LDB(B0, 1, 0); PG8_LDB(B1, 1, 1); PG8_SCHED; PG8_LDA(At, 1, 0); PG8_STAGE(PG8_SA(0, 1), a2 + hstep, voffA);
            PG8_WAIT_V(8); PG8_WAIT_L(0); PG8_BAR; PG8_MMA(0, 0, At, B0); PG8_MMA(0, 1, At, B1); PG8_BAR; PG8_SCHED;
            PG8_LDA(At, 1, 1); PG8_STAGE(PG8_SB(1, 0), b3, voffB); PG8_STAGE(PG8_SB(1, 1), b3 + hstep, voffB); PG8_STAGE(PG8_SA(1, 0), a3, voffA);
            PG8_WAIT_V(8); PG8_WAIT_L(0); PG8_BAR; PG8_MMA(1, 0, At, B0); PG8_MMA(1, 1, At, B1); PG8_BAR; PG8_SCHED;
            } else {
            PG8_LDB(B0, 0, 0); PG8_SCHED; PG8_LDA(At, 0, 0); PG8_STAGE(PG8_SA(1, 1), a1 + hstep, voffA);
            PG8_WAIT_L(8); PG8_BAR; PG8_WAIT_L(0); PG8_MMA(0, 0, At, B0); PG8_BAR; PG8_SCHED;
            PG8_LDB(B1, 0, 1); PG8_STAGE(PG8_SB(0, 0), b2, voffB);
            PG8_BAR; PG8_WAIT_L(0); PG8_MMA(0, 1, At, B1); PG8_BAR;
            PG8_LDA(At, 0, 1); PG8_STAGE(PG8_SA(0, 0), a2, voffA);
            PG8_BAR; PG8_WAIT_L(0); PG8_MMA(1, 0, At, B0); PG8_BAR; PG8_SCHED;
            PG8_STAGE(PG8_SB(0, 1), b2 + hstep, voffB);
            PG8_WAIT_V(6); PG8_BAR; PG8_MMA(1, 1, At, B1); PG8_BAR;
            PG8_LDB(B0, 1, 0); PG8_SCHED; PG8_LDA(At, 1, 0); PG8_STAGE(PG8_SA(0, 1), a2 + hstep, voffA);
            PG8_WAIT_L(8); PG8_BAR; PG8_WAIT_L(0); PG8_MMA(0, 0, At, B0); PG8_BAR; PG8_SCHED;
            PG8_LDB(B1, 1, 1); PG8_STAGE(PG8_SB(1, 0), b3, voffB);
            PG8_BAR; PG8_WAIT_L(0); PG8_MMA(0, 1, At, B1); PG8_BAR;
            PG8_LDA(At, 1, 1); PG8_STAGE(PG8_SA(1, 0), a3, voffA);
            PG8_BAR; PG8_WAIT_L(0); PG8_MMA(1, 0, At, B0); PG8_BAR; PG8_SCHED;
            PG8_STAGE(PG8_SB(1, 1), b3 + hstep, voffB);
            PG8_WAIT_V(6); PG8_BAR; PG8_MMA(1, 1, At, B1); PG8_BAR;
            }
        }
        if constexpr (ALIGN_EPI) { if (wr == 0) PG8_BAR; }
        if constexpr (!Epi::AFTER_DRAIN) { E(acc, cur, wr, wc, fr, fq); S.done(cur); }
        if (!has_next) break;
#pragma unroll
        for (int a = 0; a < 2; ++a)
#pragma unroll
            for (int b = 0; b < 2; ++b)
#pragma unroll
                for (int m = 0; m < 4; ++m)
#pragma unroll
                    for (int n = 0; n < 2; ++n) acc[a][b][m][n] = (f32x4){0.f, 0.f, 0.f, 0.f};
        cur = nxt; cA = nA; cB = nB; ++ui;
        if constexpr (ALIGN_EPI) { if (wr == 1) PG8_BAR; }
    }
    PG8_WAIT_V(0);
    if constexpr (!ALIGN_EPI) { if (wr == 0) PG8_BAR; }
    PG8_BAR;
    if constexpr (Epi::AFTER_DRAIN) { E.fused(acc, cur, wr, wc, fr, fq, lds, wid, lane); S.done(cur); }
#undef PG8_SA
#undef PG8_SB
#undef PG8_STAGE
#undef PG8_LDA
#undef PG8_LDB
#undef PG8_MMA
#undef PG8_WAIT_V
#undef PG8_WAIT_L
#undef PG8_BAR
#undef PG8_SCHED
}
}
#define DI __device__ __forceinline__
#define LAS __attribute__((address_space(3)))
typedef unsigned short bf16_t;
typedef short bf16x8 __attribute__((ext_vector_type(8)));
typedef float f32x4 __attribute__((ext_vector_type(4)));
typedef float f32x16 __attribute__((ext_vector_type(16)));
typedef unsigned u32x4 __attribute__((ext_vector_type(4)));
typedef unsigned u32x2 __attribute__((ext_vector_type(2)));
typedef __bf16 bf16v2 __attribute__((ext_vector_type(2)));
#define MFMA32(a, b, c) __builtin_amdgcn_mfma_f32_32x32x16_bf16((a), (b), (c), 0, 0, 0)

constexpr int MP = 16384, MS = 512, M = MP + MS;
constexpr int NIN0 = 5376, FF = 2816, NGU = 5632, NIN1 = 4096;
constexpr float EPS = 1e-6f;
constexpr int NPH = 16;
constexpr int LDS_BYTES = 155648;

constexpr size_t WS_WIN0 = 0;
constexpr size_t WS_WOUT0 = WS_WIN0 + (size_t)NIN0 * 1024 * 2;
constexpr size_t WS_WGU0 = WS_WOUT0 + (size_t)1024 * 2048 * 2;
constexpr size_t WS_WDN0 = WS_WGU0 + (size_t)NGU * 1024 * 2;
constexpr size_t WS_WIN1 = WS_WDN0 + (size_t)1024 * FF * 2;
constexpr size_t WS_WOUT1 = WS_WIN1 + (size_t)NIN1 * 1024 * 2;
constexpr size_t WS_WGU1 = WS_WOUT1 + (size_t)1024 * 1024 * 2;
constexpr size_t WS_WDN1 = WS_WGU1 + (size_t)NGU * 1024 * 2;
constexpr size_t WS_SSQ = WS_WDN1 + (size_t)1024 * FF * 2;
constexpr size_t WS_DTRAW = WS_SSQ + (size_t)5 * M * 4;
constexpr size_t WS_CDEC = WS_DTRAW + (size_t)M * 32 * 4;
constexpr size_t WS_BIG = WS_CDEC + (size_t)65536 * 4;
constexpr size_t BIG_XBC = (size_t)M * 2048 * 2;
constexpr size_t BIG_XB = (size_t)M * 1024 * 2 * 4;
constexpr size_t WS_BAR = WS_BIG + (size_t)M * 5120 * 2;
constexpr size_t WS_END = WS_BAR + 65536;
constexpr int LDS_MISC = LDS_BYTES - 64;
constexpr size_t O_Y = 0, O_SSDP = (size_t)M * 1024, O_CONVP = O_SSDP + 524288, O_HGP = O_CONVP + 18432, O_SSDS = O_HGP + 262144,
                 O_CONVS = O_SSDS + 4194304, O_HGS = O_CONVS + 147456;

struct Args { const float* in[24]; float* out; unsigned char* ws; int ph_lo, ph_hi; };

DI unsigned pk2(float lo, float hi) { bf16v2 v; v[0] = (__bf16)lo; v[1] = (__bf16)hi; return __builtin_bit_cast(unsigned, v); }
DI float bflo(unsigned u) { return __uint_as_float(u << 16); }
DI float bfhi(unsigned u) { return __uint_as_float(u & 0xffff0000u); }
DI float siluf(float x) { return x * __builtin_amdgcn_rcpf(1.f + __builtin_amdgcn_exp2f(-1.4426950408889634f * x)); }
DI float sigm(float x) { return __builtin_amdgcn_rcpf(1.f + __builtin_amdgcn_exp2f(-1.4426950408889634f * x)); }
DI int crow(int i, int h) { return (i & 3) + 8 * (i >> 2) + 4 * h; }
DI bf16x8 pack8(const f32x16& x, int s) { u32x4 p; p[0] = pk2(x[8 * s], x[8 * s + 1]); p[1] = pk2(x[8 * s + 2], x[8 * s + 3]); p[2] = pk2(x[8 * s + 4], x[8 * s + 5]); p[3] = pk2(x[8 * s + 6], x[8 * s + 7]); return __builtin_bit_cast(bf16x8, p); }
DI void unpack8(const bf16x8& b, f32x16& x, int s) { u32x4 p = __builtin_bit_cast(u32x4, b);
#pragma unroll
    for (int w = 0; w < 4; ++w) { x[8 * s + 2 * w] = bflo(p[w]); x[8 * s + 2 * w + 1] = bfhi(p[w]); } }
DI bf16x8 lds_b128(LAS unsigned char* p) { return *(LAS bf16x8*)p; }
DI bf16x8 lds_2b64(LAS unsigned char* p) { u32x2 a = *(LAS u32x2*)p, b = *(LAS u32x2*)(p + 16); u32x4 r; r[0] = a[0]; r[1] = a[1]; r[2] = b[0]; r[3] = b[1]; return __builtin_bit_cast(bf16x8, r); }
DI f32x16 zero16() { f32x16 z;
#pragma unroll
    for (int i = 0; i < 16; ++i) z[i] = 0.f;
    return z; }
DI float wave_sum(float v) {
#pragma unroll
    for (int o = 1; o < 64; o <<= 1) v += __shfl_xor(v, o);
    return v; }

struct TItem { const float* W; bf16_t* WT; const float* scale; int ld, K, mode, k0, n0; };
constexpr int TI_IN0 = 16 * 161, TI_OUT0 = 32 * 32, TI_G = 16 * 88, TI_DN = 44 * 32, TI_IN1 = 16 * 128, TI_OUT1 = 16 * 32;
constexpr int TI_SET1 = TI_IN0, TI_SET2A = TI_SET1 + TI_OUT0 + 2 * TI_G + TI_DN, TI_SET2 = TI_SET2A + TI_IN1, TI_ALL = TI_SET2 + TI_OUT1 + 2 * TI_G + TI_DN;
static_assert(TI_SET1 % 4 == 0 && TI_SET2A % 4 == 0 && TI_SET2 % 4 == 0 && TI_ALL % 4 == 0, "items go four per trip");
DI TItem p0_decode(const Args& a, int it) {
    unsigned char* ws = a.ws; TItem t; int r = it, nblk;
    if (r < TI_IN0) { t.W = a.in[6]; t.ld = 5152; t.K = 1024; t.WT = (bf16_t*)(ws + WS_WIN0); t.mode = 0; t.scale = a.in[5]; nblk = 161; }
    else { r -= TI_IN0; int layer = 0;
        if (r >= TI_OUT0 + 2 * TI_G + TI_DN) { r -= TI_OUT0 + 2 * TI_G + TI_DN;
            if (r < TI_IN1) { t.W = a.in[15]; t.ld = 4096; t.K = 1024; t.WT = (bf16_t*)(ws + WS_WIN1); t.mode = 0; t.scale = a.in[14]; nblk = 128; layer = -1; }
            else { r -= TI_IN1; layer = 1; } }
        if (layer >= 0) { const size_t woff = (size_t)layer * 1024 * FF; const int i_out = layer ? TI_OUT1 : TI_OUT0;
            if (r < i_out) { t.W = layer ? a.in[18] : a.in[13]; t.ld = 1024; t.K = layer ? 1024 : 2048; t.WT = (bf16_t*)(ws + (layer ? WS_WOUT1 : WS_WOUT0)); t.mode = 0; t.scale = nullptr; nblk = 32; }
            else if ((r -= i_out) < TI_G) { t.W = a.in[20] + woff; t.ld = FF; t.K = 1024; t.WT = (bf16_t*)(ws + (layer ? WS_WGU1 : WS_WGU0)); t.mode = 1; t.scale = a.in[19] + layer * 1024; nblk = 88; }
            else if ((r -= TI_G) < TI_G) { t.W = a.in[21] + woff; t.ld = FF; t.K = 1024; t.WT = (bf16_t*)(ws + (layer ? WS_WGU1 : WS_WGU0)); t.mode = 2; t.scale = a.in[19] + layer * 1024; nblk = 88; }
            else { r -= TI_G; t.W = a.in[22] + woff; t.ld = 1024; t.K = FF; t.WT = (bf16_t*)(ws + (layer ? WS_WDN1 : WS_WDN0)); t.mode = 0; t.scale = nullptr; nblk = 32; } } }
    t.k0 = 64 * (r / nblk); t.n0 = 32 * (r % nblk); return t;
}
DI void p0_load(const TItem& t, float (&v)[32], int lane) {
#pragma unroll
    for (int i = 0; i < 32; ++i) { const int kk = 2 * i + (lane >> 5); v[i] = t.W[(size_t)(t.k0 + kk) * t.ld + t.n0 + (lane & 31)]; }
    if (t.scale) {
#pragma unroll
        for (int i = 0; i < 32; ++i) v[i] *= t.scale[t.k0 + 2 * i + (lane >> 5)]; }
}
DI void p0_store(const TItem& t, const float (&v)[32], LAS float* scr, int lane) {
#pragma unroll
    for (int i = 0; i < 32; ++i) scr[(2 * i + (lane >> 5)) * 33 + (lane & 31)] = v[i];
    asm volatile("s_waitcnt lgkmcnt(0)" ::: "memory");
    const int c = lane & 7;
#pragma unroll
    for (int j = 0; j < 4; ++j) { const int n = (lane >> 3) + 8 * j; const LAS float* s = scr + (8 * c) * 33 + n;
        u32x4 o; o[0] = pk2(s[0 * 33], s[1 * 33]); o[1] = pk2(s[2 * 33], s[3 * 33]); o[2] = pk2(s[4 * 33], s[5 * 33]); o[3] = pk2(s[6 * 33], s[7 * 33]);
        const int nn = t.n0 + n; const int drow = t.mode == 0 ? nn : ((nn >> 7) * 256 + (nn & 127) + (t.mode == 2 ? 128 : 0));
        *(u32x4*)(t.WT + (size_t)drow * t.K + t.k0 + 8 * c) = o; }
    asm volatile("s_waitcnt lgkmcnt(0)" ::: "memory");
}

DI void convert_items(const Args& a, LAS unsigned char* lds, int lo, int hi, int gw, int NGW) {
    const int lane = threadIdx.x & 63, wave = threadIdx.x >> 6;
    LAS float* scr = (LAS float*)(lds + wave * 18432);
    for (int it = lo + 4 * gw; it < hi; it += 4 * NGW) {
        const TItem t0 = p0_decode(a, it), t1 = p0_decode(a, it + 1), t2 = p0_decode(a, it + 2), t3 = p0_decode(a, it + 3);
        float v0[32], v1[32], v2[32], v3[32];
        p0_load(t0, v0, lane); p0_load(t1, v1, lane); p0_load(t2, v2, lane); p0_load(t3, v3, lane);
        p0_store(t0, v0, scr, lane); p0_store(t1, v1, scr + 2112, lane); p0_store(t2, v2, scr, lane); p0_store(t3, v3, scr + 2112, lane);
    }
}
DI void p0_prologue(const Args& a, LAS unsigned char* lds) {
    const int tid = threadIdx.x, lane = tid & 63, wave = tid >> 6;
    const int gw = blockIdx.x * 8 + wave, NGW = gridDim.x * 8;
    unsigned char* ws = a.ws;
    convert_items(a, lds, 0, TI_SET1, gw, NGW);
    { u32x4* z = (u32x4*)(ws + WS_WIN0 + (size_t)5152 * 1024 * 2); const int n16 = 224 * 1024 * 2 / 16;
      for (int i = blockIdx.x * 512 + tid; i < n16; i += gridDim.x * 512) z[i] = (u32x4){0u, 0u, 0u, 0u}; }
    float* ssq = (float*)(ws + WS_SSQ); bf16_t* xb = (bf16_t*)a.out;
    for (int m0 = 4 * gw; m0 < M; m0 += 4 * NGW) {
        f32x4 v[4][4];
#pragma unroll
        for (int q = 0; q < 4; ++q) { const int m = m0 + q; const float* xr = m < MP ? a.in[0] + (size_t)m * 1024 : a.in[1] + (size_t)(m - MP) * 1024;
#pragma unroll
            for (int j = 0; j < 4; ++j) v[q][j] = *((const f32x4*)xr + lane + 64 * j); }
#pragma unroll
        for (int q = 0; q < 4; ++q) { const int m = m0 + q; float s = 0.f;
#pragma unroll
            for (int j = 0; j < 4; ++j) { const f32x4 x = v[q][j]; s += (x[0] * x[0] + x[1] * x[1]) + (x[2] * x[2] + x[3] * x[3]);
                u32x2 w; w[0] = pk2(x[0], x[1]); w[1] = pk2(x[2], x[3]); *((u32x2*)(xb + (size_t)m * 1024) + lane + 64 * j) = w; }
            s = wave_sum(s);
            if (lane == 0) { ssq[m] = s; ssq[M + m] = 0.f; ssq[2 * M + m] = 0.f; ssq[3 * M + m] = 0.f; ssq[4 * M + m] = 0.f; } }
    }
}

struct EpiIn0 { static constexpr bool PERM = true, AFTER_DRAIN = false;
    bf16_t* Z; bf16_t* XBC; float* dtraw; const float* ssq;
    DI void operator()(const f32x4 (&acc)[2][2][4][2], const pg8::Unit& u, int wr, int wc, int fr, int fq) const {
        const int row0 = u.pm * 256 + wr * 64 + fr;
#pragma unroll
        for (int ai = 0; ai < 2; ++ai)
#pragma unroll
            for (int m = 0; m < 4; ++m) { const int row = row0 + ai * 128 + m * 16; const float rs = rsqrtf(ssq[row] * (1.f / 1024.f) + EPS);
                if (u.pn < 20) { bf16_t* base; int ldc, colt; if (u.pn < 8) { base = Z; ldc = 2048; colt = u.pn * 256; } else { base = XBC; ldc = 3072; colt = (u.pn - 8) * 256; }
#pragma unroll
                    for (int bj = 0; bj < 2; ++bj) { const f32x4 v0 = acc[ai][bj][m][0] * rs, v1 = acc[ai][bj][m][1] * rs; u32x4 w; w[0] = pk2(v0[0], v0[1]); w[1] = pk2(v0[2], v0[3]); w[2] = pk2(v1[0], v1[1]); w[3] = pk2(v1[2], v1[3]);
                        *(u32x4*)(base + (size_t)row * ldc + colt + bj * 128 + wc * 32 + 8 * fq) = w; } }
                else if (wc == 0) { float* p = dtraw + (size_t)row * 32 + 8 * fq; *(f32x4*)p = acc[ai][0][m][0] * rs; *(f32x4*)(p + 4) = acc[ai][0][m][1] * rs; } }
    }
};
struct EpiRes { static constexpr bool PERM = false, AFTER_DRAIN = false;
    const float* base0; const float* base1; float* xf; bf16_t* xb; float* ssq_out;
    DI void operator()(const f32x4 (&acc)[2][2][4][2], const pg8::Unit& u, int wr, int wc, int fr, int fq) const {
        const int row0 = u.pm * 256 + wr * 64 + fr, col0 = u.pn * 256 + wc * 32 + 4 * fq;
#pragma unroll
        for (int ai = 0; ai < 2; ++ai)
#pragma unroll
            for (int m = 0; m < 4; ++m) { const int row = row0 + ai * 128 + m * 16; const float* bp = row < MP ? base0 + (size_t)row * 1024 : base1 + (size_t)(row - MP) * 1024; float s = 0.f;
#pragma unroll
                for (int bj = 0; bj < 2; ++bj)
#pragma unroll
                    for (int n = 0; n < 2; ++n) { const int col = col0 + bj * 128 + n * 16; const f32x4 v = *(const f32x4*)(bp + col) + acc[ai][bj][m][n];
                        *(f32x4*)(xf + (size_t)row * 1024 + col) = v; s += (v[0] * v[0] + v[1] * v[1]) + (v[2] * v[2] + v[3] * v[3]);
                        if (xb) { u32x2 w; w[0] = pk2(v[0], v[1]); w[1] = pk2(v[2], v[3]); *(u32x2*)(xb + (size_t)row * 1024 + col) = w; } }
                s += __shfl_xor(s, 16); s += __shfl_xor(s, 32);
                if (fq == 0) atomicAdd(ssq_out + row, s); }
    }
};
struct EpiGU { static constexpr bool PERM = true, AFTER_DRAIN = false;
    bf16_t* H; const float* ssq;
    DI void operator()(const f32x4 (&acc)[2][2][4][2], const pg8::Unit& u, int wr, int wc, int fr, int fq) const {
        const int row0 = u.pm * 256 + wr * 64 + fr, col0 = u.pn * 128 + wc * 32 + 8 * fq;
#pragma unroll
        for (int ai = 0; ai < 2; ++ai)
#pragma unroll
            for (int m = 0; m < 4; ++m) { const int row = row0 + ai * 128 + m * 16; const float rs = rsqrtf(ssq[row] * (1.f / 1024.f) + EPS); float h[8];
#pragma unroll
                for (int n = 0; n < 2; ++n)
#pragma unroll
                    for (int j = 0; j < 4; ++j) { const float g = acc[ai][0][m][n][j] * rs, up = acc[ai][1][m][n][j] * rs; h[4 * n + j] = siluf(g) * up; }
                u32x4 w; w[0] = pk2(h[0], h[1]); w[1] = pk2(h[2], h[3]); w[2] = pk2(h[4], h[5]); w[3] = pk2(h[6], h[7]);
                *(u32x4*)(H + (size_t)row * FF + col0) = w; }
    }
};
struct EpiIn1 { static constexpr bool PERM = true, AFTER_DRAIN = false;
    bf16_t* O4; const float* ssq; const float* lbraw;
    DI void operator()(const f32x4 (&acc)[2][2][4][2], const pg8::Unit& u, int wr, int wc, int fr, int fq) const {
        const int row0 = u.pm * 256 + wr * 64 + fr, type = u.pn >> 2, col0 = (u.pn & 3) * 256 + wc * 32 + 8 * fq;
        bf16_t* base = O4 + (size_t)type * M * 1024; const bool act = (type == 0 || type == 3);
#pragma unroll
        for (int ai = 0; ai < 2; ++ai)
#pragma unroll
            for (int m = 0; m < 4; ++m) { const int row = row0 + ai * 128 + m * 16; const float rs = rsqrtf(ssq[row] * (1.f / 1024.f) + EPS);
#pragma unroll
                for (int bj = 0; bj < 2; ++bj) { f32x4 v0 = acc[ai][bj][m][0] * rs, v1 = acc[ai][bj][m][1] * rs;
                    if (act) {
#pragma unroll
                        for (int j = 0; j < 4; ++j) { v0[j] = siluf(v0[j]); v1[j] = siluf(v1[j]); } }
                    if (type == 1) { const int cc = col0 + bj * 128;
#pragma unroll
                        for (int j = 0; j < 4; ++j) { const float lb0 = sigm(lbraw[1024 + cc + j] - lbraw[cc + j]), lb1 = sigm(lbraw[1024 + cc + 4 + j] - lbraw[cc + 4 + j]);
                            v0[j] = __builtin_amdgcn_logf(lb0 + (1.f - lb0) * sigm(v0[j])); v1[j] = __builtin_amdgcn_logf(lb1 + (1.f - lb1) * sigm(v1[j])); } }
                    u32x4 w; w[0] = pk2(v0[0], v0[1]); w[1] = pk2(v0[2], v0[3]); w[2] = pk2(v1[0], v1[1]); w[3] = pk2(v1[2], v1[3]);
                    *(u32x4*)(base + (size_t)row * 1024 + col0 + bj * 128) = w; } }
    }
};
#define XB_TMO      128
#define XB_XCNT(j)  (256  + 64 * (j))
#define XB_XSUB(j)  (1280 + 64 * (j))
#define XB_XGEN(j)  (2304 + 64 * (j))
#define XB_TOP      3328
#define XB_TOPGEN   3392
#define XCD_BAR_WORDS 3456
#define XB_SPIN_CAP (1u << 18)

__device__ __forceinline__ unsigned xb_ld(unsigned* p)              { return __hip_atomic_load(p, __ATOMIC_RELAXED, __HIP_MEMORY_SCOPE_AGENT); }
__device__ __forceinline__ unsigned xb_add(unsigned* p, unsigned v) { return __hip_atomic_fetch_add(p, v, __ATOMIC_RELAXED, __HIP_MEMORY_SCOPE_AGENT); }
__device__ __forceinline__ unsigned xb_xcc_id() { return (unsigned)__builtin_amdgcn_s_getreg((3 << 11) | 20) & 0xFu; }
#define XB_SPIN(cond, bar) do { unsigned _sp = 0; while (cond) { __builtin_amdgcn_s_sleep(1); \
    if ((++_sp & 255u) == 0u) { if (xb_ld(&(bar)[XB_TMO])) break; if (_sp > XB_SPIN_CAP) { atomicAdd(&(bar)[XB_TMO], 1u); break; } } } } while (0)

struct XcdBarrier {
    unsigned* bar; unsigned x;
    volatile LAS unsigned* st;
};

__device__ __forceinline__ XcdBarrier xcd_barrier_post(unsigned* bar, volatile LAS unsigned* st) {
    XcdBarrier b; b.bar = bar; b.x = xb_xcc_id(); b.st = st;
    if (threadIdx.x == 0) (void)xb_add(&bar[XB_XCNT(b.x)], 1u);
    return b;
}
__device__ __forceinline__ void xcd_barrier_complete(unsigned* bar, unsigned x, unsigned& nloc, unsigned& nx) {
    const unsigned G = gridDim.x * gridDim.y * gridDim.z;
    unsigned sum, cnt, mine, sp = 0u;
    for (;;) {
        sum = 0u; cnt = 0u; mine = 0u;
#pragma unroll
        for (unsigned j = 0; j < 16; ++j) { const unsigned c = xb_ld(&bar[XB_XCNT(j)]); sum += c; cnt += (c > 0u) ? 1u : 0u; mine = (j == x) ? c : mine; }
        if (sum == G) break;
        __builtin_amdgcn_s_sleep(1);
        if ((++sp & 255u) == 0u) { if (xb_ld(&bar[XB_TMO])) break; if (sp > XB_SPIN_CAP) { atomicAdd(&bar[XB_TMO], 1u); break; } }
    }
    nloc = mine > 0u ? mine : 1u; nx = cnt > 0u ? cnt : 1u;
}

__device__ __forceinline__ void xcd_barrier(const XcdBarrier& b) {
    asm volatile("s_waitcnt vmcnt(0)" ::: "memory");
    __syncthreads();
    if (threadIdx.x == 0) {
        unsigned* bar = b.bar;
        __builtin_amdgcn_s_waitcnt(0);
        unsigned nloc = b.st[0], nx = b.st[1];
        if (nloc == 0u) { xcd_barrier_complete(bar, b.x, nloc, nx); b.st[0] = nloc; b.st[1] = nx; }
        const unsigned old = xb_add(&bar[XB_XSUB(b.x)], 1u);
        const unsigned gen = old / nloc;
        if (old + 1u == (gen + 1u) * nloc) {
            __builtin_amdgcn_fence(__ATOMIC_RELEASE, "agent");
            asm volatile("s_waitcnt vmcnt(0)" ::: "memory");
            const unsigned og = xb_add(&bar[XB_TOP], 1u);
            const unsigned tg = og / nx;
            if (og + 1u == (tg + 1u) * nx) xb_add(&bar[XB_TOPGEN], 1u);
            else XB_SPIN(xb_ld(&bar[XB_TOPGEN]) == tg, bar);
            __builtin_amdgcn_fence(__ATOMIC_ACQUIRE, "agent");
            xb_add(&bar[XB_XGEN(b.x)], 1u);
            asm volatile("s_waitcnt vmcnt(0)" ::: "memory");
        } else {
            XB_SPIN(xb_ld(&bar[XB_XGEN(b.x)]) == gen, bar);
            __builtin_amdgcn_fence(__ATOMIC_ACQUIRE, "agent");
            asm volatile("s_waitcnt vmcnt(0)" ::: "memory");
        }
    }
    __syncthreads();
}
constexpr int L_XT = 0, L_BN = 73728, L_CN = 91136, L_BT = 108544, L_SDT = 126976, L_SCUM = 129024, L_SW = 131072, L_RED = 133120, L_GW = 135168;
template <bool OUT> DI void ssd_unit(const Args& a, LAS unsigned char* L, int unit) {
    const int tid = threadIdx.x, lane = tid & 63, wid = tid >> 6, r = lane & 31, h = lane >> 5;
    unsigned char* ws = a.ws;
    bf16_t* Z = (bf16_t*)(ws + WS_BIG); const bf16_t* XBC = (const bf16_t*)(ws + WS_BIG + BIG_XBC);
    const float* dtraw = (const float*)(ws + WS_DTRAW); float* cdec = (float*)(ws + WS_CDEC);
    bf16_t* LBUF = (bf16_t*)a.out;
    const bool prompt = unit < 256;
    int b, sc, g, row_base, nch, len;
    if (prompt) { b = unit >> 7; sc = (unit >> 2) & 31; g = unit & 3; row_base = b * 8192 + sc * 256; nch = 4; len = 64; }
    else { const int u2 = unit - 256; b = u2 >> 2; sc = 0; g = u2 & 3; row_base = MP + b * 32; nch = 1; len = 32; }
    const int hh = wid, head = g * 8 + hh;
    LAS float* SDT = (LAS float*)(L + L_SDT); LAS float* SCUM = (LAS float*)(L + L_SCUM); LAS float* SW = (LAS float*)(L + L_SW); LAS float* RED = (LAS float*)(L + L_RED);
    const float Dh = a.in[11][head];
    bf16x8 stp[4][2][2];
    const float* sprev = a.in[2] + (size_t)(b * 32 + head) * 8192; const bf16_t* sprevb = LBUF + (size_t)((b * 32 + sc) * 32 + head) * 8192;
#pragma unroll
    for (int nt = 0; nt < 4; ++nt)
#pragma unroll
        for (int pt = 0; pt < 2; ++pt) { f32x16 t = zero16();
            if (OUT && prompt) {
#pragma unroll
                for (int q = 0; q < 2; ++q) { const u32x2 lo = *(const u32x2*)(sprevb + (32 * pt + r) * 128 + 32 * nt + 16 * q + 4 * h), hi = *(const u32x2*)(sprevb + (32 * pt + r) * 128 + 32 * nt + 16 * q + 8 + 4 * h);
                    u32x4 wq; wq[0] = lo[0]; wq[1] = lo[1]; wq[2] = hi[0]; wq[3] = hi[1]; stp[nt][pt][q] = __builtin_bit_cast(bf16x8, wq); }
                if (pt == 1 && (nt & 1)) __builtin_amdgcn_sched_barrier(0);
                continue; }
            if (OUT) {
#pragma unroll
                for (int g4 = 0; g4 < 4; ++g4) { const f32x4 v = *(const f32x4*)(sprev + (32 * pt + r) * 128 + 32 * nt + 8 * g4 + 4 * h); t[4 * g4] = v[0]; t[4 * g4 + 1] = v[1]; t[4 * g4 + 2] = v[2]; t[4 * g4 + 3] = v[3]; } }
            stp[nt][pt][0] = pack8(t, 0); stp[nt][pt][1] = pack8(t, 1); if (pt == 1 && (nt & 1)) __builtin_amdgcn_sched_barrier(0); }
    float dsum = 0.f;
    if (OUT) __syncthreads();
    if (OUT && tid < 128) *(LAS f32x4*)(L + L_GW + tid * 16) = *(const f32x4*)(a.in[12] + g * 512 + tid * 4);
    for (int c = 0; c < nch; ++c) {
        int r_s = r, h_s = h, tid_s = tid; asm volatile("" : "+v"(r_s), "+v"(h_s), "+v"(tid_s));
        const int r = r_s, h = h_s, tid = tid_s;
        const int row0 = row_base + c * 64;
        __syncthreads();
        { const int s = tid >> 3, h8 = tid & 7, hd = g * 8 + h8; float dtv = 0.f;
          if (s < len) { const float xr = dtraw[(size_t)(row0 + s) * 32 + hd] + a.in[9][hd]; dtv = xr > 20.f ? xr : log1pf(__expf(xr)); }
          SDT[s * 8 + h8] = dtv; SCUM[s * 8 + h8] = -dtv * __expf(a.in[10][hd]); }
        __syncthreads();
        if (tid >= 448 && tid < 456) { const int h8 = tid - 448; float run = 0.f;
#pragma unroll 8
            for (int s2 = 0; s2 < 64; ++s2) { run += SCUM[s2 * 8 + h8]; SCUM[s2 * 8 + h8] = run; }
#pragma unroll 8
            for (int s2 = 0; s2 < 64; ++s2) SW[h8 * 64 + s2] = SDT[s2 * 8 + h8] * __expf(run - SCUM[s2 * 8 + h8]); }
        {
            const bool first_chunk = prompt ? (sc == 0 && c == 0) : true;
            const bool last_chunk = prompt ? (sc == 31 && c == 3) : true;
#pragma unroll 1
            for (int it = 0; it < 3; ++it) {
                const int id = tid + 512 * it, cg4 = id % 192, s0 = (id / 192) * 8; int kind, lc, col;
                if (cg4 < 128) { kind = 0; lc = cg4 * 4; col = g * 512 + lc; } else if (cg4 < 160) { kind = 1; lc = (cg4 - 128) * 4; col = 2048 + g * 128 + lc; } else { kind = 2; lc = (cg4 - 160) * 4; col = 2560 + g * 128 + lc; }
                u32x2 raw[11]; f32x4 w[4];
                const bf16_t* rp = XBC + (size_t)(row0 + s0 - 3) * 3072 + col;
#pragma unroll
                for (int i = 0; i < 11; ++i) { const int s = s0 - 3 + i; raw[i] = (u32x2){0u, 0u};
                    if (s >= 0 ? (s < len) : !first_chunk) raw[i] = *(const u32x2*)(rp + (size_t)i * 3072); }
#pragma unroll
                for (int t4 = 0; t4 < 4; ++t4) w[t4] = *(const f32x4*)(a.in[7] + t4 * 3072 + col);
                const f32x4 bias = *(const f32x4*)(a.in[8] + col);
                if (!prompt && s0 == 0) {
#pragma unroll
                    for (int i = 0; i < 3; ++i) { const f32x4 hv = *(const f32x4*)(a.in[3] + (size_t)(b * 3 + i) * 3072 + col); raw[i][0] = pk2(hv[0], hv[1]); raw[i][1] = pk2(hv[2], hv[3]); } }
                float* convout = a.out + (prompt ? O_CONVP : O_CONVS) + (size_t)b * 3 * 3072 + col;
                f32x4 win[3]; unsigned vbp[4][4]; f32x4 vprev = (f32x4){0.f, 0.f, 0.f, 0.f};
#pragma unroll
                for (int i = 0; i < 11; ++i) { const int s = s0 - 3 + i;
                    const f32x4 cur = (f32x4){bflo(raw[i][0]), bfhi(raw[i][0]), bflo(raw[i][1]), bfhi(raw[i][1])};
                    if (i < 3) { win[i] = cur; }
                    else { const int j8 = i - 3;
                        if (!OUT && last_chunk && s >= len - 3 && s < len) *(f32x4*)(convout + (size_t)(s - (len - 3)) * 3072) = cur;
                        f32x4 v = bias + w[0] * win[0] + w[1] * win[1] + w[2] * win[2] + w[3] * cur;
#pragma unroll
                        for (int j = 0; j < 4; ++j) v[j] = (s < len) ? siluf(v[j]) : 0.f;
                        if (kind != 0) { u32x2 o; o[0] = pk2(v[0], v[1]); o[1] = pk2(v[2], v[3]); *(LAS u32x2*)(L + (kind == 1 ? L_BN : L_CN) + (s * 136 + lc) * 2) = o; }
                        if (j8 & 1) {
#pragma unroll
                            for (int j = 0; j < 4; ++j) vbp[j][j8 >> 1] = pk2(vprev[j], v[j]); }
                        else vprev = v;
                        win[0] = win[1]; win[1] = win[2]; win[2] = cur;
                    }
                }
                if (kind != 2) { LAS unsigned char* tb = L + (kind == 0 ? L_XT : L_BT);
#pragma unroll
                    for (int j = 0; j < 4; ++j) { u32x4 o; o[0] = vbp[j][0]; o[1] = vbp[j][1]; o[2] = vbp[j][2]; o[3] = vbp[j][3]; *(LAS u32x4*)(tb + ((lc + j) * 72 + s0) * 2) = o; } }
            }
        }
        __syncthreads();
        const float clast = SCUM[63 * 8 + hh];
        if (OUT) {
#pragma unroll
            for (int tt = 0; tt < 2; ++tt) {
                if (32 * tt >= len) continue;
                f32x16 y[2] = {zero16(), zero16()};
                const bool valid = (32 * tt + r) < len; const size_t rowoff = (size_t)(row0 + 32 * tt + r) * 2048 + head * 64;
                u32x2 zpre[2][4];
#pragma unroll
                for (int pt = 0; pt < 2; ++pt)
#pragma unroll
                    for (int g4 = 0; g4 < 4; ++g4) { zpre[pt][g4] = (u32x2){0u, 0u}; if (valid) zpre[pt][g4] = *(const u32x2*)(Z + rowoff + 32 * pt + 8 * g4 + 4 * h); }
#pragma unroll
                for (int nt = 0; nt < 4; ++nt)
#pragma unroll
                    for (int q = 0; q < 2; ++q) { const bf16x8 pb = lds_2b64(L + L_CN + ((32 * tt + r) * 136 + 32 * nt + 16 * q + 4 * h) * 2);
#pragma unroll
                        for (int pt = 0; pt < 2; ++pt) y[pt] = MFMA32(stp[nt][pt][q], pb, y[pt]); }
                const float ct = SCUM[(32 * tt + r) * 8 + hh]; { const float e = __expf(ct); y[0] = y[0] * e; y[1] = y[1] * e; }
#pragma unroll
                for (int st = 0; st <= tt; ++st) {
                    f32x16 gm = zero16();
#pragma unroll
                    for (int ks = 0; ks < 8; ++ks) { const bf16x8 fa = lds_b128(L + L_BN + ((32 * st + r) * 136 + 16 * ks + 8 * h) * 2), fb = lds_b128(L + L_CN + ((32 * tt + r) * 136 + 16 * ks + 8 * h) * 2);
                        gm = MFMA32(fa, fb, gm); }
                    const int t = 32 * tt + r;
#pragma unroll
                    for (int i = 0; i < 16; ++i) { const int s = 32 * st + crow(i, h); const float cs = SCUM[s * 8 + hh], ds = SDT[s * 8 + hh];
                        float val = (s <= t) ? gm[i] * __expf(fminf(ct - cs, 0.f)) * ds : 0.f; if (s == t) val += Dh; gm[i] = val; }
#pragma unroll
                    for (int q = 0; q < 2; ++q) { const bf16x8 xs = pack8(gm, q);
#pragma unroll
                        for (int pt = 0; pt < 2; ++pt) { const bf16x8 pa = lds_2b64(L + L_XT + ((hh * 64 + 32 * pt + r) * 72 + 32 * st + 16 * q + 4 * h) * 2); y[pt] = MFMA32(pa, xs, y[pt]); } }
                }
                float ssum = 0.f;
#pragma unroll
                for (int pt = 0; pt < 2; ++pt)
#pragma unroll
                    for (int g4 = 0; g4 < 4; ++g4) { const u32x2 zz = zpre[pt][g4];
                        y[pt][4 * g4] *= siluf(bflo(zz[0])); y[pt][4 * g4 + 1] *= siluf(bfhi(zz[0])); y[pt][4 * g4 + 2] *= siluf(bflo(zz[1])); y[pt][4 * g4 + 3] *= siluf(bfhi(zz[1]));
#pragma unroll
                        for (int j = 0; j < 4; ++j) { const float v = valid ? y[pt][4 * g4 + j] : 0.f; ssum += v * v; } }
                ssum += __shfl_xor(ssum, 32);
                if (h == 0) RED[hh * 64 + 32 * tt + r] = ssum;
                __syncthreads();
                float tot = 0.f;
#pragma unroll
                for (int w8 = 0; w8 < 8; ++w8) tot += RED[w8 * 64 + 32 * tt + r];
                const float rstd = rsqrtf(tot * (1.f / 512.f) + EPS);
                if (valid) {
#pragma unroll
                    for (int pt = 0; pt < 2; ++pt)
#pragma unroll
                        for (int g4 = 0; g4 < 4; ++g4) { const int p0 = 32 * pt + 8 * g4 + 4 * h; const f32x4 gw = *(LAS f32x4*)(L + L_GW + (hh * 64 + p0) * 4);
                            u32x2 o; o[0] = pk2(y[pt][4 * g4] * rstd * gw[0], y[pt][4 * g4 + 1] * rstd * gw[1]); o[1] = pk2(y[pt][4 * g4 + 2] * rstd * gw[2], y[pt][4 * g4 + 3] * rstd * gw[3]);
                            *(u32x2*)(Z + rowoff + p0) = o; } }
            }
        }
        dsum += clast;
        if (!OUT || c + 1 < nch) {
            const float dec = __expf(clast);
            bf16x8 xs[2][4];
#pragma unroll
            for (int ks = 0; ks < 4; ++ks) { const f32x4 s0 = *(LAS f32x4*)(SW + hh * 64 + 16 * ks + 8 * h), s1 = *(LAS f32x4*)(SW + hh * 64 + 16 * ks + 8 * h + 4);
#pragma unroll
                for (int pt = 0; pt < 2; ++pt) { const u32x4 raw = *(LAS u32x4*)(L + L_XT + ((hh * 64 + 32 * pt + r) * 72 + 16 * ks + 8 * h) * 2);
                    u32x4 o; o[0] = pk2(bflo(raw[0]) * s0[0], bfhi(raw[0]) * s0[1]); o[1] = pk2(bflo(raw[1]) * s0[2], bfhi(raw[1]) * s0[3]); o[2] = pk2(bflo(raw[2]) * s1[0], bfhi(raw[2]) * s1[1]); o[3] = pk2(bflo(raw[3]) * s1[2], bfhi(raw[3]) * s1[3]);
                    xs[pt][ks] = __builtin_bit_cast(bf16x8, o); } }
#pragma unroll
            for (int nt = 0; nt < 4; ++nt) { bf16x8 af[4];
#pragma unroll
                for (int ks = 0; ks < 4; ++ks) af[ks] = lds_b128(L + L_BT + ((32 * nt + r) * 72 + 16 * ks + 8 * h) * 2);
#pragma unroll
                for (int pt = 0; pt < 2; ++pt) { f32x16 t; unpack8(stp[nt][pt][0], t, 0); unpack8(stp[nt][pt][1], t, 1); t = t * dec;
#pragma unroll
                    for (int ks = 0; ks < 4; ++ks) t = MFMA32(af[ks], xs[pt][ks], t);
                    stp[nt][pt][0] = pack8(t, 0); stp[nt][pt][1] = pack8(t, 1); } }
        }
    }
    if (!OUT) {
        const float dect = __expf(dsum);
        int loff = r * 128 + 4 * h; asm volatile("" : "+v"(loff) :: "memory");
        float* dstp = a.out + O_SSDS + (size_t)(prompt ? 0 : (b * 32 + head)) * 8192 + loff; bf16_t* lbp = LBUF + (size_t)((b * 32 + (prompt ? sc : 0)) * 32 + head) * 8192 + loff;
        const float* s0p = a.in[2] + (size_t)(prompt ? 0 : (b * 32 + head)) * 8192 + loff;
#pragma unroll
        for (int nt = 0; nt < 4; ++nt)
#pragma unroll
            for (int pt = 0; pt < 2; ++pt) { f32x16 t; unpack8(stp[nt][pt][0], t, 0); unpack8(stp[nt][pt][1], t, 1);
#pragma unroll
                for (int g4 = 0; g4 < 4; ++g4) { const int co = (32 * pt) * 128 + 32 * nt + 8 * g4; f32x4 v = (f32x4){t[4 * g4], t[4 * g4 + 1], t[4 * g4 + 2], t[4 * g4 + 3]};
                    if (!prompt) { const f32x4 s0 = *(const f32x4*)(s0p + co); v = s0 * dect + v; *(f32x4*)(dstp + co) = v; }
                    else { u32x2 o; o[0] = pk2(v[0], v[1]); o[1] = pk2(v[2], v[3]); *(u32x2*)(lbp + co) = o; } }
                __builtin_amdgcn_sched_barrier(0); }
        if (prompt && lane == 0) cdec[(b * 32 + sc) * 32 + head] = dect;
    }
}
DI void ssd_pass(const Args& a) {
    bf16_t* LBUF = (bf16_t*)a.out; const float* cdec = (const float*)(a.ws + WS_CDEC);
    for (int item = blockIdx.x * 512 + threadIdx.x; item < 131072; item += gridDim.x * 512) { const int b = item >> 16, head = (item >> 11) & 31, e4 = item & 2047;
        bf16_t* base = LBUF + (size_t)(b * 32 * 32 + head) * 8192 + e4 * 4; f32x4 run = (f32x4){0.f, 0.f, 0.f, 0.f};
#pragma unroll 1
        for (int sc0 = 0; sc0 < 32; sc0 += 8) { u32x2 l[8]; float dc[8];
#pragma unroll
            for (int j = 0; j < 8; ++j) { l[j] = *(const u32x2*)(base + (size_t)(sc0 + j) * 32 * 8192); dc[j] = cdec[(b * 32 + sc0 + j) * 32 + head]; }
#pragma unroll
            for (int j = 0; j < 8; ++j) { u32x2 o; o[0] = pk2(run[0], run[1]); o[1] = pk2(run[2], run[3]); *(u32x2*)(base + (size_t)(sc0 + j) * 32 * 8192) = o;
                run = run * dc[j] + (f32x4){bflo(l[j][0]), bfhi(l[j][0]), bflo(l[j][1]), bfhi(l[j][1])}; } }
        *(f32x4*)(a.out + O_SSDP + (size_t)(b * 32 + head) * 8192 + e4 * 4) = run; }
}

constexpr int G_QE = 0, G_KE = 17408, G_KDT = 34816, G_VT = 53248, G_HEAD = 71680, G_SDEC = 143360, G_RED = 144384, G_HT = 146432;
template <bool OUT> DI void gla_unit(const Args& a, LAS unsigned char* L, int unit) {
    const int tid = threadIdx.x, lane = tid & 63, wid = tid >> 6, r = lane & 31, h = lane >> 5;
    unsigned char* ws = a.ws;
    bf16_t* QS = (bf16_t*)(ws + WS_BIG); const bf16_t* FR = QS + (size_t)M * 1024; const bf16_t* VV = QS + (size_t)2 * M * 1024; const bf16_t* GS = QS + (size_t)3 * M * 1024;
    bf16_t* LBUF = (bf16_t*)(ws + WS_BIG + BIG_XB); float* cdec = (float*)(ws + WS_CDEC);
    const bool prompt = unit < 256;
    int b, sc, pr, row_base, nch, len;
    if (prompt) { b = unit >> 7; sc = (unit >> 2) & 31; pr = unit & 3; row_base = b * 8192 + sc * 256; nch = 4; len = 64; }
    else { const int u2 = unit - 256; b = u2 >> 2; sc = 0; pr = u2 & 3; row_base = MP + b * 32; nch = 1; len = 32; }
    const int hl = wid >> 2, vt = wid & 3, head = pr * 2 + hl;
    LAS unsigned char* LH = L + hl * G_HEAD;
    LAS float* SDEC = (LAS float*)(L + G_SDEC) + hl * 128; LAS float* RED = (LAS float*)(L + G_RED);
    const int phl = tid >> 8, ptt = tid & 255, phead = pr * 2 + phl; LAS unsigned char* PH = L + phl * G_HEAD;
    float bsum0 = 0.f, bsum1 = 0.f;
    bf16x8 stp[4][2];
    const float* sprev = a.in[4] + (size_t)(b * 8 + head) * 16384; const bf16_t* sprevb = LBUF + (size_t)((b * 32 + sc) * 8 + head) * 16384;
#pragma unroll
    for (int kt = 0; kt < 4; ++kt) { f32x16 t = zero16();
        if (OUT) {
#pragma unroll
            for (int i = 0; i < 16; ++i) t[i] = prompt ? bflo((unsigned)sprevb[(32 * kt + crow(i, h)) * 128 + 32 * vt + r]) : sprev[(32 * kt + crow(i, h)) * 128 + 32 * vt + r]; }
        stp[kt][0] = pack8(t, 0); stp[kt][1] = pack8(t, 1); }
    for (int c = 0; c < nch; ++c) {
        const int row0 = row_base + c * 64;
        __syncthreads();
        {
            const int cp = ptt & 63, rq = ptt >> 6, kc = 2 * cp; const size_t cb = (size_t)(row0 + 16 * rq) * 1024 + phead * 128 + kc;
            LAS float* HT = (LAS float*)(L + G_HT) + phl * 512;
            unsigned rf[16], rv[16], rqs[16];
#pragma unroll
            for (int j = 0; j < 16; ++j) { const bool ok = (16 * rq + j) < len; rf[j] = 0u; rv[j] = 0u; rqs[j] = 0u;
                if (ok) { rf[j] = *(const unsigned*)(FR + cb + (size_t)j * 1024); rv[j] = *(const unsigned*)(VV + cb + (size_t)j * 1024); rqs[j] = *(const unsigned*)(QS + cb + (size_t)j * 1024); } }
            float b0[16], b1[16]; float c0 = 0.f, c1 = 0.f;
#pragma unroll
            for (int j = 0; j < 16; ++j) { c0 += bflo(rf[j]); c1 += bfhi(rf[j]); b0[j] = c0; b1[j] = c1; }
            HT[rq * 128 + kc] = c0; HT[rq * 128 + kc + 1] = c1;
#pragma unroll
            for (int hf = 0; hf < 2; ++hf) { u32x4 o0, o1;
#pragma unroll
                for (int w2 = 0; w2 < 4; ++w2) { const unsigned x0 = rv[8 * hf + 2 * w2], x1 = rv[8 * hf + 2 * w2 + 1]; o0[w2] = (x0 & 0xffffu) | (x1 << 16); o1[w2] = (x0 >> 16) | (x1 & 0xffff0000u); }
                *(LAS u32x4*)(PH + G_VT + (kc * 72 + 16 * rq + 8 * hf) * 2) = o0; *(LAS u32x4*)(PH + G_VT + ((kc + 1) * 72 + 16 * rq + 8 * hf) * 2) = o1; }
            __syncthreads();
            float off0 = 0.f, off1 = 0.f, bl0 = 0.f, bl1 = 0.f;
#pragma unroll
            for (int q4 = 0; q4 < 4; ++q4) { const float t0 = HT[q4 * 128 + kc], t1 = HT[q4 * 128 + kc + 1]; bl0 += t0; bl1 += t1; if (q4 < rq) { off0 += t0; off1 += t1; } }
            const float ebl0 = __builtin_amdgcn_exp2f(bl0), ebl1 = __builtin_amdgcn_exp2f(bl1);
            if (rq == 0) { bsum0 += bl0; bsum1 += bl1; ((LAS float*)(L + G_SDEC))[phl * 128 + kc] = ebl0; ((LAS float*)(L + G_SDEC))[phl * 128 + kc + 1] = ebl1; }
#pragma unroll
            for (int hf = 0; hf < 2; ++hf) { u32x4 o0, o1; float kd0[8], kd1[8];
#pragma unroll
                for (int j = 0; j < 8; ++j) { const int jj = 8 * hf + j, s = 16 * rq + jj; const bool ok = s < len;
                    const float k0 = ok ? 1.f - __builtin_amdgcn_exp2f(bflo(rf[jj])) : 0.f, k1 = ok ? 1.f - __builtin_amdgcn_exp2f(bfhi(rf[jj])) : 0.f;
                    const float e0 = __builtin_amdgcn_exp2f(b0[jj] + off0), e1 = __builtin_amdgcn_exp2f(b1[jj] + off1), r0 = __builtin_amdgcn_rcpf(e0), r1 = __builtin_amdgcn_rcpf(e1);
                    const float ke0 = k0 * r0, ke1 = k1 * r1; kd0[j] = ke0 * ebl0; kd1[j] = ke1 * ebl1;
                    *(LAS unsigned*)(PH + G_QE + (s * 136 + kc) * 2) = pk2(bflo(rqs[jj]) * e0, bfhi(rqs[jj]) * e1); *(LAS unsigned*)(PH + G_KE + (s * 136 + kc) * 2) = pk2(ke0, ke1); }
                o0[0] = pk2(kd0[0], kd0[1]); o0[1] = pk2(kd0[2], kd0[3]); o0[2] = pk2(kd0[4], kd0[5]); o0[3] = pk2(kd0[6], kd0[7]);
                o1[0] = pk2(kd1[0], kd1[1]); o1[1] = pk2(kd1[2], kd1[3]); o1[2] = pk2(kd1[4], kd1[5]); o1[3] = pk2(kd1[6], kd1[7]);
                *(LAS u32x4*)(PH + G_KDT + (kc * 72 + 16 * rq + 8 * hf) * 2) = o0; *(LAS u32x4*)(PH + G_KDT + ((kc + 1) * 72 + 16 * rq + 8 * hf) * 2) = o1; }
        }
        __syncthreads();
        if (OUT) {
            f32x16 o[2] = {zero16(), zero16()};
            u32x2 gpre[2][4]; f32x4 gwv[4];
#pragma unroll
            for (int g4 = 0; g4 < 4; ++g4) { gwv[g4] = *(const f32x4*)(a.in[17] + 32 * vt + 8 * g4 + 4 * h);
#pragma unroll
                for (int tt = 0; tt < 2; ++tt) { gpre[tt][g4] = (u32x2){0u, 0u}; if ((32 * tt + r) < len) gpre[tt][g4] = *(const u32x2*)(GS + (size_t)(row0 + 32 * tt + r) * 1024 + head * 128 + 32 * vt + 8 * g4 + 4 * h); } }
#pragma unroll
            for (int kt = 0; kt < 4; ++kt)
#pragma unroll
                for (int q = 0; q < 2; ++q)
#pragma unroll
                    for (int tt = 0; tt < 2; ++tt) { if (32 * tt >= len) continue; const bf16x8 pb = lds_2b64(LH + G_QE + ((32 * tt + r) * 136 + 32 * kt + 16 * q + 4 * h) * 2); o[tt] = MFMA32(stp[kt][q], pb, o[tt]); }
#pragma unroll
            for (int cmb = 0; cmb < 3; ++cmb) { const int st = cmb >> 1, tt = (cmb + 1) >> 1;
                if (32 * tt >= len) continue;
                f32x16 gm = zero16();
#pragma unroll
                for (int ks = 0; ks < 8; ++ks) { const bf16x8 fa = lds_b128(LH + G_KE + ((32 * st + r) * 136 + 16 * ks + 8 * h) * 2), fb = lds_b128(LH + G_QE + ((32 * tt + r) * 136 + 16 * ks + 8 * h) * 2);
                    gm = MFMA32(fa, fb, gm); }
                const int t = 32 * tt + r;
#pragma unroll
                for (int i = 0; i < 16; ++i) { const int s = 32 * st + crow(i, h); gm[i] = (s <= t) ? gm[i] : 0.f; }
#pragma unroll
                for (int q = 0; q < 2; ++q) { const bf16x8 xs = pack8(gm, q); const bf16x8 pa = lds_2b64(LH + G_VT + ((32 * vt + r) * 72 + 32 * st + 16 * q + 4 * h) * 2); o[tt] = MFMA32(pa, xs, o[tt]); }
            }
#pragma unroll
            for (int tt = 0; tt < 2; ++tt) { float ss = 0.f;
#pragma unroll
                for (int i = 0; i < 16; ++i) ss += o[tt][i] * o[tt][i];
                ss += __shfl_xor(ss, 32); if (h == 0) RED[wid * 64 + 32 * tt + r] = ss; }
            __syncthreads();
#pragma unroll
            for (int tt = 0; tt < 2; ++tt) { const bool valid = (32 * tt + r) < len; float tot = 0.f;
#pragma unroll
                for (int w4 = 0; w4 < 4; ++w4) tot += RED[(hl * 4 + w4) * 64 + 32 * tt + r];
                const float rstd = rsqrtf(tot * (1.f / 128.f) + EPS); const size_t rowoff = (size_t)(row0 + 32 * tt + r) * 1024 + head * 128;
                if (valid) {
#pragma unroll
                    for (int g4 = 0; g4 < 4; ++g4) { const int v0 = 32 * vt + 8 * g4 + 4 * h; const f32x4 gw = gwv[g4]; const u32x2 gg = gpre[tt][g4];
                        u32x2 w; w[0] = pk2(o[tt][4 * g4] * rstd * gw[0] * bflo(gg[0]), o[tt][4 * g4 + 1] * rstd * gw[1] * bfhi(gg[0])); w[1] = pk2(o[tt][4 * g4 + 2] * rstd * gw[2] * bflo(gg[1]), o[tt][4 * g4 + 3] * rstd * gw[3] * bfhi(gg[1]));
                        *(u32x2*)(QS + rowoff + v0) = w; } } }
        }
        if (!OUT || c + 1 < nch) {
#pragma unroll
            for (int kt = 0; kt < 4; ++kt) { f32x16 t; unpack8(stp[kt][0], t, 0); unpack8(stp[kt][1], t, 1);
#pragma unroll
                for (int i = 0; i < 16; ++i) t[i] *= SDEC[32 * kt + crow(i, h)];
#pragma unroll
                for (int ks = 0; ks < 4; ++ks) { const bf16x8 fa = lds_b128(LH + G_KDT + ((32 * kt + r) * 72 + 16 * ks + 8 * h) * 2), fb = lds_b128(LH + G_VT + ((32 * vt + r) * 72 + 16 * ks + 8 * h) * 2); t = MFMA32(fa, fb, t); }
                stp[kt][0] = pack8(t, 0); stp[kt][1] = pack8(t, 1); }
        }
    }
    if (!OUT) {
#pragma unroll
        for (int kt = 0; kt < 4; ++kt) { f32x16 t; unpack8(stp[kt][0], t, 0); unpack8(stp[kt][1], t, 1);
#pragma unroll
            for (int i = 0; i < 16; ++i) { const int k = 32 * kt + crow(i, h); const size_t off = (size_t)k * 128 + 32 * vt + r;
                if (prompt) LBUF[(size_t)((b * 32 + sc) * 8 + head) * 16384 + off] = (bf16_t)(__float_as_uint(t[i]) >> 16);
                else a.out[O_HGS + (size_t)(b * 8 + head) * 16384 + off] = SDEC[k] * a.in[4][(size_t)(b * 8 + head) * 16384 + off] + t[i]; } }
        if (prompt && ptt < 64) { cdec[((b * 32 + sc) * 8 + phead) * 128 + 2 * ptt] = __builtin_amdgcn_exp2f(bsum0); cdec[((b * 32 + sc) * 8 + phead) * 128 + 2 * ptt + 1] = __builtin_amdgcn_exp2f(bsum1); }
    }
}
DI void gla_pass(const Args& a) {
    bf16_t* LBUF = (bf16_t*)(a.ws + WS_BIG + BIG_XB); const float* cdec = (const float*)(a.ws + WS_CDEC);
    for (int item = blockIdx.x * 512 + threadIdx.x; item < 65536; item += gridDim.x * 512) { const int b = item >> 15, head = (item >> 12) & 7, e4 = item & 4095, k = e4 >> 5;
        bf16_t* base = LBUF + (size_t)(b * 32 * 8 + head) * 16384 + e4 * 4; f32x4 run = (f32x4){0.f, 0.f, 0.f, 0.f};
#pragma unroll 1
        for (int sc0 = 0; sc0 < 32; sc0 += 8) { u32x2 l[8]; float dc[8];
#pragma unroll
            for (int j = 0; j < 8; ++j) { l[j] = *(const u32x2*)(base + (size_t)(sc0 + j) * 8 * 16384); dc[j] = cdec[((b * 32 + sc0 + j) * 8 + head) * 128 + k]; }
#pragma unroll
            for (int j = 0; j < 8; ++j) { u32x2 o; o[0] = pk2(run[0], run[1]); o[1] = pk2(run[2], run[3]); *(u32x2*)(base + (size_t)(sc0 + j) * 8 * 16384) = o;
                run = run * dc[j] + (f32x4){bflo(l[j][0]), bfhi(l[j][0]), bflo(l[j][1]), bfhi(l[j][1])}; } }
        *(f32x4*)(a.out + O_HGP + (size_t)(b * 8 + head) * 16384 + e4 * 4) = run; }
}
DI void final_norm(const Args& a) {
    const int lane = threadIdx.x & 63, gw = blockIdx.x * 8 + (threadIdx.x >> 6), NGW = gridDim.x * 8; const float* ssq = (const float*)(a.ws + WS_SSQ) + 4 * (size_t)M;
    for (int m = gw; m < M; m += NGW) { const float rs = rsqrtf(ssq[m] * (1.f / 1024.f) + EPS); f32x4* row = (f32x4*)(a.out + (size_t)m * 1024);
#pragma unroll
        for (int j = 0; j < 4; ++j) { const f32x4 w = *((const f32x4*)a.in[23] + lane + 64 * j); row[lane + 64 * j] = row[lane + 64 * j] * rs * w; } }
}


DI void sample_gemm_res(const bf16_t* A, const bf16_t* Bt, int K, const float* base, float* xf, bf16_t* xb, float* ssq_out) {
    const int lane = threadIdx.x & 63, wid = threadIdx.x >> 6, c16 = lane & 15, q = lane >> 4;
    for (int tile = blockIdx.x * 8 + wid; tile < 2048; tile += gridDim.x * 8) { const int rt = tile >> 6, ct = tile & 63;
        const bf16_t* ap = A + (size_t)(MP + rt * 16 + c16) * K + 8 * q; const bf16_t* bp = Bt + (size_t)(ct * 16 + c16) * K + 8 * q;
        f32x4 acc0 = (f32x4){0.f, 0.f, 0.f, 0.f}, acc1 = acc0;
#pragma unroll 8
        for (int k = 0; k < K; k += 64) { const bf16x8 a0 = *(const bf16x8*)(ap + k), b0 = *(const bf16x8*)(bp + k), a1 = *(const bf16x8*)(ap + k + 32), b1 = *(const bf16x8*)(bp + k + 32);
            acc0 = __builtin_amdgcn_mfma_f32_16x16x32_bf16(a0, b0, acc0, 0, 0, 0); acc1 = __builtin_amdgcn_mfma_f32_16x16x32_bf16(a1, b1, acc1, 0, 0, 0); }
        const f32x4 acc = acc0 + acc1; const int col = ct * 16 + c16;
#pragma unroll
        for (int i = 0; i < 4; ++i) { const int rl = rt * 16 + 4 * q + i; const size_t o = (size_t)(MP + rl) * 1024 + col; const float v = base[(size_t)rl * 1024 + col] + acc[i];
            xf[o] = v; if (xb) xb[o] = (bf16_t)(pk2(v, 0.f) & 0xffffu);
            float s = v * v; s += __shfl_xor(s, 1); s += __shfl_xor(s, 2); s += __shfl_xor(s, 4); s += __shfl_xor(s, 8);
            if (c16 == 0) atomicAdd(ssq_out + MP + rl, s); } }
}
__global__ void __launch_bounds__(512, 2) mk_fwd(Args a) {
    extern __shared__ __attribute__((aligned(16))) unsigned char lds_raw[];
    LAS unsigned char* lds = (LAS unsigned char*)lds_raw;
    unsigned char* ws = a.ws; float* ssq = (float*)(ws + WS_SSQ);
    if (threadIdx.x < 16) ((LAS unsigned*)(lds + LDS_MISC))[threadIdx.x] = 0u;
    __syncthreads();
    XcdBarrier xbar; xbar.bar = (unsigned*)(ws + WS_BAR); xbar.x = 0; xbar.st = nullptr;
    if (a.ph_hi - a.ph_lo > 1) xbar = xcd_barrier_post((unsigned*)(ws + WS_BAR), (volatile LAS unsigned*)(lds + LDS_MISC));
    const int lo = a.ph_lo, hi = a.ph_hi, G = gridDim.x, bx = blockIdx.x;
    if (lo < 0) cg::this_grid().sync();
#ifndef DUPMASK
#define DUPMASK 0
#endif
#define REP(k) for (int rep_ = 0; rep_ < 1 + ((DUPMASK >> (k)) & 1); ++rep_)
#ifdef ONLY
#define IN(k) ((k) == ONLY && lo <= (k) && (k) < hi)
#else
#define IN(k) (lo <= (k) && (k) < hi)
#endif
#ifndef DUPSYNC
#define DUPSYNC 0
#endif
#define SEAM(k) do { if (IN((k) + 1)) { xcd_barrier(xbar); if (DUPSYNC) xcd_barrier(xbar); } } while (0)
    bf16_t* BIG = (bf16_t*)(ws + WS_BIG); bf16_t* XB = (bf16_t*)(ws + WS_BIG + BIG_XB);
    if (IN(0)) { REP(0) p0_prologue(a, lds); SEAM(0); }
    if (IN(1)) { pg8::Gemm g{(const bf16_t*)a.out, (const bf16_t*)(ws + WS_WIN0), M, NIN0, 1024}; pg8::StaticOrder S; S.init(M, NIN0, G, bx);
        EpiIn0 E{BIG, (bf16_t*)(ws + WS_BIG + BIG_XBC), (float*)(ws + WS_DTRAW), ssq};
        REP(1) pg8::gemm_phase<EpiIn0, pg8::StaticOrder, true, true>(lds, g, S, E);
        { const int nfull = (M / 256) * (NIN0 / 256) - 5 * G;
          if (G == 256 && nfull > 0 && nfull < G) { if (bx >= nfull) convert_items(a, lds, TI_SET1, TI_SET2A, (bx - nfull) * 8 + (int)(threadIdx.x >> 6), (G - nfull) * 8); }
          else convert_items(a, lds, TI_SET1, TI_SET2A, bx * 8 + (int)(threadIdx.x >> 6), G * 8); }
        SEAM(1); }
    if (IN(2)) { REP(2) for (int u = bx; u < 320; u += G) ssd_unit<false>(a, lds, u);
        if (bx >= 64 && bx < 128) ssd_unit<true>(a, lds, 192 + bx);
        SEAM(2); }
    if (IN(3)) { ssd_pass(a); SEAM(3); }
    if (IN(4)) { for (int u = bx; u < 256; u += G) ssd_unit<true>(a, lds, u); SEAM(4); }
    if (IN(5)) { pg8::Gemm g{BIG, (const bf16_t*)(ws + WS_WOUT0), MP, 1024, 2048}; pg8::StaticOrder S; S.init(MP, 1024, G, bx);
        EpiRes E{a.in[0], a.in[1], a.out, XB, ssq + M};
        pg8::gemm_phase<EpiRes, pg8::StaticOrder, true, true>(lds, g, S, E);
        sample_gemm_res(BIG, (const bf16_t*)(ws + WS_WOUT0), 2048, a.in[1], a.out, XB, ssq + M); SEAM(5); }
    if (IN(6)) { pg8::Gemm g{XB, (const bf16_t*)(ws + WS_WGU0), M, NGU, 1024}; pg8::StaticOrder S; S.init(M, NGU, G, bx);
        EpiGU E{BIG, ssq + M};
        REP(6) pg8::gemm_phase<EpiGU, pg8::StaticOrder, true, true>(lds, g, S, E);
        { const int nfull = (M / 256) * (NGU / 256) - 5 * G;
          if (G == 256 && nfull > 0 && nfull < G) { if (bx >= nfull) convert_items(a, lds, TI_SET2A, TI_SET2, (bx - nfull) * 8 + (int)(threadIdx.x >> 6), (G - nfull) * 8); }
          else convert_items(a, lds, TI_SET2A, TI_SET2, bx * 8 + (int)(threadIdx.x >> 6), G * 8); }
        SEAM(6); }
    if (IN(7)) { pg8::Gemm g{BIG, (const bf16_t*)(ws + WS_WDN0), MP, 1024, FF}; pg8::StaticOrder S; S.init(MP, 1024, G, bx);
        EpiRes E{a.out, a.out + (size_t)MP * 1024, a.out, XB, ssq + 2 * M};
        pg8::gemm_phase<EpiRes, pg8::StaticOrder, true, true>(lds, g, S, E);
        sample_gemm_res(BIG, (const bf16_t*)(ws + WS_WDN0), FF, a.out + (size_t)MP * 1024, a.out, XB, ssq + 2 * M); SEAM(7); }
    if (IN(8)) { pg8::Gemm g{XB, (const bf16_t*)(ws + WS_WIN1), M, NIN1, 1024}; pg8::StaticOrder S; S.init(M, NIN1, G, bx);
        EpiIn1 E{BIG, ssq + 2 * M, a.in[16]};
        REP(8) pg8::gemm_phase<EpiIn1, pg8::StaticOrder, true, true>(lds, g, S, E);
        { const int nfull = (M / 256) * (NIN1 / 256) - 4 * G;
          if (G == 256 && nfull > 0 && nfull < G) { if (bx >= nfull) convert_items(a, lds, TI_SET2, TI_ALL, (bx - nfull) * 8 + (int)(threadIdx.x >> 6), (G - nfull) * 8); }
          else convert_items(a, lds, TI_SET2, TI_ALL, bx * 8 + (int)(threadIdx.x >> 6), G * 8); }
        SEAM(8); }
    if (IN(9)) { REP(9) for (int u = bx; u < 320; u += G) gla_unit<false>(a, lds, u);
        if (bx >= 64 && bx < 128) gla_unit<true>(a, lds, 192 + bx);
        SEAM(9); }
    if (IN(10)) { gla_pass(a); SEAM(10); }
    if (IN(11)) { for (int u = bx; u < 256; u += G) gla_unit<true>(a, lds, u); SEAM(11); }
    if (IN(12)) { pg8::Gemm g{BIG, (const bf16_t*)(ws + WS_WOUT1), MP, 1024, 1024}; pg8::StaticOrder S; S.init(MP, 1024, G, bx);
        EpiRes E{a.out, a.out + (size_t)MP * 1024, a.out, XB, ssq + 3 * M};
        pg8::gemm_phase<EpiRes, pg8::StaticOrder, true, true>(lds, g, S, E);
        sample_gemm_res(BIG, (const bf16_t*)(ws + WS_WOUT1), 1024, a.out + (size_t)MP * 1024, a.out, XB, ssq + 3 * M); SEAM(12); }
    if (IN(13)) { pg8::Gemm g{XB, (const bf16_t*)(ws + WS_WGU1), M, NGU, 1024}; pg8::StaticOrder S; S.init(M, NGU, G, bx);
        EpiGU E{BIG, ssq + 3 * M};
        pg8::gemm_phase<EpiGU, pg8::StaticOrder, true, true>(lds, g, S, E); SEAM(13); }
    if (IN(14)) { pg8::Gemm g{BIG, (const bf16_t*)(ws + WS_WDN1), MP, 1024, FF}; pg8::StaticOrder S; S.init(MP, 1024, G, bx);
        EpiRes E{a.out, a.out + (size_t)MP * 1024, a.out, nullptr, ssq + 4 * M};
        pg8::gemm_phase<EpiRes, pg8::StaticOrder, true, true>(lds, g, S, E);
        sample_gemm_res(BIG, (const bf16_t*)(ws + WS_WDN1), FF, a.out + (size_t)MP * 1024, a.out, nullptr, ssq + 4 * M); SEAM(14); }
    if (IN(15)) { final_norm(a); }
#undef IN
#undef SEAM
}

#ifndef MK_MULTI
#define MK_MULTI 0
#endif
extern "C" void kernel_launch(void* const* d_in, const int* in_sizes, int n_in, void* d_out, int out_size, void* d_ws, size_t ws_size, hipStream_t stream) {
    static int grid = 0;
    if (grid == 0) {
        if (n_in != 24 || ws_size < WS_END) { fprintf(stderr, "kernel_launch: unexpected n_in %d / ws_size %zu (need %zu)\n", n_in, ws_size, (size_t)WS_END); grid = -1; return; }
        int dev = 0, cus = 0, per_cu = 0;
        hipGetDevice(&dev); hipDeviceGetAttribute(&cus, hipDeviceAttributeMultiprocessorCount, dev);
        if (hipFuncSetAttribute((const void*)mk_fwd, hipFuncAttributeMaxDynamicSharedMemorySize, LDS_BYTES) != hipSuccess) { fprintf(stderr, "kernel_launch: hipFuncSetAttribute failed\n"); grid = -1; return; }
        if (hipOccupancyMaxActiveBlocksPerMultiprocessor(&per_cu, (const void*)mk_fwd, 512, LDS_BYTES) != hipSuccess || per_cu < 1) { fprintf(stderr, "kernel_launch: occupancy query says %d\n", per_cu); per_cu = 1; }
        (void)hipGetLastError();
        grid = cus * 1;
        fprintf(stderr, "kernel_launch: grid %d (cus %d, per_cu %d)\n", grid, cus, per_cu);
    }
    if (grid < 0) return;
    Args a{};
    for (int i = 0; i < 24; ++i) a.in[i] = (const float*)d_in[i];
    a.out = (float*)d_out; a.ws = (unsigned char*)d_ws;
#if MK_MULTI
    for (int ph = 0; ph < NPH; ++ph) { a.ph_lo = ph; a.ph_hi = ph + 1; hipLaunchKernelGGL(mk_fwd, dim3(grid), dim3(512), LDS_BYTES, stream, a); }
#else
    a.ph_lo = 0; a.ph_hi = NPH;
    if (hipMemsetAsync((char*)d_ws + WS_BAR, 0, 65536, stream) != hipSuccess) { fprintf(stderr, "kernel_launch: memset of barrier words failed\n"); return; }
    void* args[] = {&a};
    hipError_t e = hipLaunchCooperativeKernel((const void*)mk_fwd, dim3(grid), dim3(512), args, LDS_BYTES, stream);
    if (e != hipSuccess) fprintf(stderr, "cooperative launch failed: %s (grid %d)\n", hipGetErrorString(e), grid);
#endif
}
```
